# Optimizing an MI355X kernel written in HIP

```python
import jax, jax.numpy as jnp
from jax import lax
import numpy as np

D_MODEL = 2048
BATCH = 4
SEQ = 4096
DEPTH = 4

GRID_W = 64
CTX_LEN = 256
EPS = 1e-6
N_MOD = 6

MLA_HEADS = 8
MLA_NOPE = 128
MLA_ROPE = 64
MLA_V = 128
MLA_QK = MLA_NOPE + MLA_ROPE
Q_LORA = 512
KV_LORA = 256
MLA_WIDTH = MLA_HEADS * MLA_V
ATTN_BLOCK = 128
ROPE_THETA = 10000.0
ROPE_HALF = MLA_ROPE // 2
ROPE_AXIS = MLA_ROPE // 2

GLA_HEADS = 4
GLA_HEAD_K = 128
GLA_HEAD_V = 256
GLA_KEY = GLA_HEADS * GLA_HEAD_K
GLA_WIDTH = GLA_HEADS * GLA_HEAD_V
GK_RANK = 16
GK_NORMALIZER = 16.0
GLA_CHUNK = 64

MIX_WIDTH = MLA_WIDTH + GLA_WIDTH
IN_SPLITS = (Q_LORA, KV_LORA, MLA_ROPE, GLA_KEY, GLA_KEY, GLA_WIDTH, GLA_WIDTH, GK_RANK, GK_RANK)
IN_COLS = sum(IN_SPLITS)

PEER_HEADS = 8
PEER_DKEY = 256
N_KEYS = 128
N_EXPERTS = N_KEYS * N_KEYS
PEER_TOPK = 16
PEER_BLOCK = 128

kernel_name = 'hybrid_mla_gla_peer_dit'


def rmsnorm(x, g):
    xf = x.astype(jnp.float32)
    y = xf * lax.rsqrt(jnp.mean(xf * xf, axis=-1, keepdims=True) + EPS)
    return (y * g.astype(jnp.float32)).astype(x.dtype)


def modulate(x, g, shift, scale):
    return rmsnorm(x, g) * (1 + scale) + shift


def axial_rope_tables(t, dtype):
    rows = t // GRID_W
    row = jnp.repeat(jnp.arange(rows, dtype=jnp.float32), GRID_W)
    col = jnp.tile(jnp.arange(GRID_W, dtype=jnp.float32), rows)
    inv_freq = 1.0 / (ROPE_THETA ** (jnp.arange(0, ROPE_AXIS, 2, dtype=jnp.float32) / ROPE_AXIS))
    ang = jnp.concatenate([row[:, None] * inv_freq, col[:, None] * inv_freq], axis=-1)
    return jnp.cos(ang).astype(dtype), jnp.sin(ang).astype(dtype)


def apply_rope(x, cos, sin):
    x1, x2 = x[..., :ROPE_HALF], x[..., ROPE_HALF:]
    cos = cos[None, :, None, :]
    sin = sin[None, :, None, :]
    return jnp.concatenate([x1 * cos - x2 * sin, x1 * sin + x2 * cos], axis=-1)


def mixer_projections(h, w_in, q_norm_g, kv_norm_g, w_uq, w_ukv, w_gk2, b_gk, rope):
    b, t, _ = h.shape
    splits = [int(i) for i in np.cumsum(IN_SPLITS[:-1])]
    c_q, c_kv, k_r, gq, gk, gv, gg, lr_f, lr_b = jnp.split(h @ w_in, splits, axis=-1)
    q = (rmsnorm(c_q, q_norm_g) @ w_uq).reshape(b, t, MLA_HEADS, MLA_QK)
    kv = (rmsnorm(c_kv, kv_norm_g) @ w_ukv).reshape(b, t, MLA_HEADS, MLA_NOPE + MLA_V)
    q_nope, q_rope = q[..., :MLA_NOPE], q[..., MLA_NOPE:]
    k_nope, v = kv[..., :MLA_NOPE], kv[..., MLA_NOPE:]
    k_rope = k_r[:, :, None, :]
    if rope is not None:
        cos, sin = rope
        q_rope = apply_rope(q_rope, cos, sin)
        k_rope = apply_rope(k_rope, cos, sin)
    q = jnp.concatenate([q_nope, q_rope], axis=-1)
    k = jnp.concatenate([k_nope, jnp.broadcast_to(k_rope, (b, t, MLA_HEADS, MLA_ROPE))], axis=-1)

    def heads(z, d):
        return z.reshape(b, t, GLA_HEADS, d).transpose(0, 2, 1, 3)

    def log_decay(lr, i):
        z = (lr @ w_gk2[i] + b_gk[i]).astype(jnp.float32)
        return heads(jax.nn.log_sigmoid(z) / GK_NORMALIZER, GLA_HEAD_K)

    gla = (heads(gq, GLA_HEAD_K) * (GLA_HEAD_K ** -0.5), heads(gk, GLA_HEAD_K), heads(gv, GLA_HEAD_V),
           log_decay(lr_f, 0), log_decay(lr_b, 1), gg)
    return (q, k, v), gla


def attend(q, k, v):
    s = jnp.einsum('bqhd,bkhd->bhqk', q, k).astype(jnp.float32) * (MLA_QK ** -0.5)
    p = jax.nn.softmax(s, axis=-1).astype(v.dtype)
    return jnp.einsum('bhqk,bkhd->bqhd', p, v)


def latent_attention(q, k_all, v_all):
    b, t, h, d = q.shape
    nb = t // ATTN_BLOCK
    qb = q.reshape(b, nb, ATTN_BLOCK, h, d).transpose(1, 0, 2, 3, 4)
    ob = lax.map(lambda blk: attend(blk, k_all, v_all), qb)
    return ob.transpose(1, 0, 2, 3, 4).reshape(b, t, h * MLA_V)


def gla_chunked(q, k, v, loga, s0):
    b, h, t, dk = q.shape
    dv = v.shape[-1]
    n = t // GLA_CHUNK
    f32 = jnp.float32
    qc = q.reshape(b, h, n, GLA_CHUNK, dk).astype(f32)
    kc = k.reshape(b, h, n, GLA_CHUNK, dk).astype(f32)
    vc = v.reshape(b, h, n, GLA_CHUNK, dv).astype(f32)
    cum = jnp.cumsum(loga.reshape(b, h, n, GLA_CHUNK, dk).astype(f32), axis=3)
    last = cum[..., -1:, :]
    q_dec = qc * jnp.exp(cum)
    k_dec = kc * jnp.exp(-cum)
    k_end = kc * jnp.exp(last - cum)
    mask = jnp.tril(jnp.ones((GLA_CHUNK, GLA_CHUNK), dtype=bool))
    a = jnp.where(mask, jnp.einsum('bhncd,bhnjd->bhncj', q_dec, k_dec), 0.0)
    o_intra = jnp.einsum('bhncj,bhnje->bhnce', a, vc)
    ds = jnp.einsum('bhncd,bhnce->bhnde', k_end, vc)
    decay = jnp.exp(last[..., 0, :])

    def step(s, inp):
        dec_n, ds_n = inp
        return dec_n[..., None] * s + ds_n, s

    s_final, s_enter = lax.scan(step, s0.astype(f32), (jnp.moveaxis(decay, 2, 0), jnp.moveaxis(ds, 2, 0)))
    s_enter = jnp.moveaxis(s_enter, 0, 2)
    o = o_intra + jnp.einsum('bhncd,bhnde->bhnce', q_dec, s_enter)
    return o.reshape(b, h, t, dv), s_final


def gla_bidirectional(q, k, v, loga_f, loga_b, s0_f, s0_b):
    o_f, s_f = gla_chunked(q, k, v, loga_f, s0_f)
    flip = lambda z: jnp.flip(z, axis=2)
    o_b, s_b = gla_chunked(flip(q), flip(k), flip(v), flip(loga_b), s0_b)
    return o_f + flip(o_b), s_f, s_b


def gla_output(o, gg, norm_g):
    b, h, t, dv = o.shape
    o = rmsnorm(o.transpose(0, 2, 1, 3), norm_g).reshape(b, t, GLA_WIDTH)
    return (o * jax.nn.silu(gg)).astype(gg.dtype)


def token_mixer(h_lat, h_ctx, rope, w_in, q_norm_g, kv_norm_g, w_uq, w_ukv, w_gk2, b_gk,
                gla_norm_g, w_out, ctx_out):
    b, t, _ = h_lat.shape
    (q_l, k_l, v_l), gla_l = mixer_projections(h_lat, w_in, q_norm_g, kv_norm_g, w_uq, w_ukv, w_gk2, b_gk, rope)
    (q_c, k_c, v_c), gla_c = mixer_projections(h_ctx, w_in, q_norm_g, kv_norm_g, w_uq, w_ukv, w_gk2, b_gk, None)
    k_all = jnp.concatenate([k_c, k_l], axis=1)
    v_all = jnp.concatenate([v_c, v_l], axis=1)
    mla_l = latent_attention(q_l, k_all, v_all)
    zeros = jnp.zeros((b, GLA_HEADS, GLA_HEAD_K, GLA_HEAD_V), jnp.float32)
    o_c, s_f, s_b = gla_bidirectional(*gla_c[:5], zeros, zeros)
    o_l, _, _ = gla_bidirectional(*gla_l[:5], s_f, s_b)
    y_lat = jnp.concatenate([mla_l, gla_output(o_l, gla_l[5], gla_norm_g)], axis=-1) @ w_out
    if not ctx_out:
        return y_lat, None
    mla_c = attend(q_c, k_c, v_c).reshape(b, h_ctx.shape[1], MLA_WIDTH)
    y_ctx = jnp.concatenate([mla_c, gla_output(o_c, gla_c[5], gla_norm_g)], axis=-1) @ w_out
    return y_lat, y_ctx


def peer_block(h, w_query, sub_keys, expert_u, expert_v):
    m = h.shape[0]
    q = (h @ w_query).reshape(m, PEER_HEADS, 2, PEER_DKEY // 2)
    s1 = jnp.einsum('mhd,hkd->mhk', q[:, :, 0], sub_keys[0]).astype(jnp.float32)
    s2 = jnp.einsum('mhd,hkd->mhk', q[:, :, 1], sub_keys[1]).astype(jnp.float32)
    s1t, i1 = lax.top_k(s1, PEER_TOPK)
    s2t, i2 = lax.top_k(s2, PEER_TOPK)
    cand = (s1t[..., :, None] + s2t[..., None, :]).reshape(m, PEER_HEADS, PEER_TOPK * PEER_TOPK)
    cand_idx = (i1[..., :, None] * N_KEYS + i2[..., None, :]).reshape(m, PEER_HEADS, PEER_TOPK * PEER_TOPK)
    top_s, pos = lax.top_k(cand, PEER_TOPK)
    idx = jnp.take_along_axis(cand_idx, pos, axis=-1)
    gate = jax.nn.softmax(top_s, axis=-1).astype(h.dtype)
    act = jax.nn.gelu(jnp.einsum('mhkd,md->mhk', expert_u[idx], h)) * gate
    return jnp.einsum('mhk,mhkd->md', act, expert_v[idx])


def peer(h, w_query, sub_keys, expert_u, expert_v):
    b, t, d = h.shape
    hb = h.reshape(-1, PEER_BLOCK, d)
    out = lax.map(lambda blk: peer_block(blk, w_query, sub_keys, expert_u, expert_v), hb)
    return out.reshape(b, t, d)


def setup_inputs(seed: int = 0) -> dict:
    key = jax.random.key(seed)
    ks = jax.random.split(key, 22)
    f32 = jnp.float32
    nrm = lambda k, shape, s: jax.random.normal(k, shape, f32) * s
    gain = lambda k, shape: 1.0 + 0.02 * jax.random.normal(k, shape, f32)
    L, D = DEPTH, D_MODEL
    return {
        'x': nrm(ks[0], (BATCH, SEQ, D), 1.0),
        'c': nrm(ks[1], (BATCH, D), 1.0),
        'ctx': nrm(ks[2], (BATCH, CTX_LEN, D), 1.0),
        'c_ctx': nrm(ks[3], (D,), 1.0),
        'w_ada': nrm(ks[4], (L, D, N_MOD * D), 0.5 * D ** -0.5),
        'b_ada': nrm(ks[5], (L, N_MOD * D), 0.02),
        'norm_mix_g': gain(ks[6], (L, D)),
        'norm_ffn_g': gain(ks[7], (L, D)),
        'w_in': nrm(ks[8], (L, D, IN_COLS), D ** -0.5),
        'q_norm_g': gain(ks[9], (L, Q_LORA)),
        'kv_norm_g': gain(ks[10], (L, KV_LORA)),
        'w_uq': nrm(ks[11], (L, Q_LORA, MLA_HEADS * MLA_QK), Q_LORA ** -0.5),
        'w_ukv': nrm(ks[12], (L, KV_LORA, MLA_HEADS * (MLA_NOPE + MLA_V)), KV_LORA ** -0.5),
        'w_gk2': nrm(ks[13], (L, 2, GK_RANK, GLA_KEY), GK_RANK ** -0.5),
        'b_gk': nrm(ks[14], (L, 2, GLA_KEY), 0.1),
        'gla_norm_g': gain(ks[15], (L, GLA_HEAD_V)),
        'w_out': nrm(ks[16], (L, MIX_WIDTH, D), MIX_WIDTH ** -0.5),
        'w_query': nrm(ks[17], (L, D, PEER_HEADS * PEER_DKEY), D ** -0.5),
        'sub_keys': nrm(ks[18], (L, 2, PEER_HEADS, N_KEYS, PEER_DKEY // 2), (PEER_DKEY // 2) ** -0.5),
        'expert_u': nrm(ks[19], (L, N_EXPERTS, D), D ** -0.5),
        'expert_v': nrm(ks[20], (L, N_EXPERTS, D), D ** -0.5),
        'final_norm_g': gain(ks[21], (D,)),
    }


def reference(x, c, ctx, c_ctx, w_ada, b_ada, norm_mix_g, norm_ffn_g, w_in, q_norm_g, kv_norm_g,
              w_uq, w_ukv, w_gk2, b_gk, gla_norm_g, w_out, w_query, sub_keys, expert_u, expert_v,
              final_norm_g):
    t = x.shape[1]
    rope = axial_rope_tables(t, x.dtype)
    x_lat, x_ctx = x, ctx
    for l in range(DEPTH):
        ctx_out = l < DEPTH - 1
        sh_a, sc_a, g_a, sh_f, sc_f, g_f = jnp.split((jax.nn.silu(c) @ w_ada[l] + b_ada[l])[:, None, :], N_MOD, axis=-1)
        csh_a, csc_a, cg_a, csh_f, csc_f, cg_f = jnp.split(jax.nn.silu(c_ctx) @ w_ada[l] + b_ada[l], N_MOD, axis=-1)
        y_lat, y_ctx = token_mixer(modulate(x_lat, norm_mix_g[l], sh_a, sc_a),
                                   modulate(x_ctx, norm_mix_g[l], csh_a, csc_a), rope,
                                   w_in[l], q_norm_g[l], kv_norm_g[l], w_uq[l], w_ukv[l], w_gk2[l], b_gk[l],
                                   gla_norm_g[l], w_out[l], ctx_out)
        x_lat = x_lat + g_a * y_lat
        x_lat = x_lat + g_f * peer(modulate(x_lat, norm_ffn_g[l], sh_f, sc_f),
                                   w_query[l], sub_keys[l], expert_u[l], expert_v[l])
        if ctx_out:
            x_ctx = x_ctx + cg_a * y_ctx
            x_ctx = x_ctx + cg_f * peer(modulate(x_ctx, norm_ffn_g[l], csh_f, csc_f),
                                        w_query[l], sub_keys[l], expert_u[l], expert_v[l])
    return rmsnorm(x_lat, final_norm_g)
```

```cpp
#include <hip/hip_runtime.h>
#include <cstdio>
#include <cstdint>

#ifndef MK_MULTI
#define MK_MULTI 0
#endif

#define GAS __attribute__((address_space(1)))
#define LAS __attribute__((address_space(3)))
typedef unsigned short bf16_t;
typedef short bf16x8 __attribute__((ext_vector_type(8)));
typedef short s16x4 __attribute__((ext_vector_type(4)));
typedef float f32x2 __attribute__((ext_vector_type(2)));
typedef float f32x4 __attribute__((ext_vector_type(4)));
typedef float f32x16 __attribute__((ext_vector_type(16)));
typedef unsigned u32x2 __attribute__((ext_vector_type(2)));
typedef unsigned u32x4 __attribute__((ext_vector_type(4)));
typedef __bf16 bf16v2 __attribute__((ext_vector_type(2)));
typedef unsigned u32x6 __attribute__((ext_vector_type(6)));
typedef float f32x32 __attribute__((ext_vector_type(32)));
typedef __bf16 bf16x32v __attribute__((ext_vector_type(32)));
typedef unsigned u32x16 __attribute__((ext_vector_type(16)));

constexpr int DM = 2048, NB = 4, SEQ = 4096, CTX = 256, RPB = SEQ + CTX, NTOK = NB * RPB, DEPTH = 4;
constexpr int NMOD = 6 * DM;
constexpr int PW = 3840;
constexpr int P_CQ = 0, P_CKV = 512, P_GQ = 768, P_GK = 1280, P_GV = 1792, P_GG = 2816;
constexpr int SIDEW = 96;
constexpr int NCH = RPB / 64;
constexpr int NGU = NB * 4 * NCH;
constexpr int NEXP = 16384;
constexpr float EPS = 1e-6f;
constexpr int NTHR = 512, NWAVES = 8;

constexpr size_t al256(size_t x) { return (x + 255) & ~(size_t)255; }
constexpr size_t WS_CTL = 0, CTL_BYTES = 1u << 20;
constexpr size_t WS_MOD = WS_CTL + CTL_BYTES;
constexpr size_t WS_ROPE = WS_MOD + al256((size_t)DEPTH * 5 * NMOD * 4);
constexpr size_t WS_WIN = WS_ROPE + al256((size_t)2 * SEQ * 32 * 4);
constexpr size_t WS_WSIDE = WS_WIN + (size_t)DEPTH * PW * DM * 2;
constexpr size_t WS_WUQ = WS_WSIDE + (size_t)DEPTH * SIDEW * DM * 2;
constexpr size_t WS_WUKV = WS_WUQ + (size_t)DEPTH * 1536 * 512 * 2;
constexpr size_t WS_WOUT = WS_WUKV + (size_t)DEPTH * 2048 * 256 * 2;
constexpr size_t WS_WQRY = WS_WOUT + (size_t)DEPTH * DM * DM * 2;
constexpr size_t WS_SUBK = WS_WQRY + (size_t)DEPTH * DM * DM * 2;
constexpr int EROW = 1024;
constexpr size_t WS_EU = WS_SUBK + (size_t)DEPTH * 2 * 8 * 128 * 128 * 2;
constexpr size_t WS_EV = WS_EU + (size_t)DEPTH * NEXP * EROW;
constexpr size_t WS_SU = WS_EV + (size_t)DEPTH * NEXP * EROW;
constexpr size_t WS_SV = WS_SU + (size_t)DEPTH * NEXP * 4;
constexpr size_t WS_XRES = WS_SV + (size_t)DEPTH * NEXP * 4;
constexpr size_t WS_H = WS_XRES + (size_t)NTOK * DM * 4;
constexpr size_t WS_P = WS_H + (size_t)NTOK * DM * 2;
constexpr size_t WS_SIDE = WS_P + (size_t)NTOK * PW * 2;
constexpr size_t WS_Q = WS_SIDE + (size_t)NTOK * SIDEW * 4;
constexpr size_t WS_KV = WS_Q + (size_t)NTOK * 1536 * 2;
constexpr size_t WS_KR = WS_KV + (size_t)NTOK * 2048 * 2;
constexpr size_t WS_MIX = WS_KR + (size_t)NTOK * 64 * 2;
constexpr size_t WS_QDEC = WS_MIX + (size_t)NTOK * DM * 2;
constexpr size_t WS_OINTRA = WS_QDEC + (size_t)NGU * 2 * 64 * 128 * 2;
constexpr size_t WS_DS = WS_OINTRA + (size_t)NTOK * 1024 * 4;
constexpr size_t WS_DEC = WS_DS + (size_t)2 * 16 * NCH * 32768 * 2;
constexpr size_t WS_SENT = WS_DEC + al256((size_t)2 * 16 * NCH * 128 * 4);
constexpr size_t WS_QP = WS_SENT + (size_t)2 * 16 * NCH * 32768 * 2;
constexpr size_t WS_IDX = WS_QP + (size_t)NTOK * DM * 2;
constexpr size_t WS_GATE = WS_IDX + (size_t)NTOK * 128 * 4;
constexpr size_t WS_END = WS_GATE + (size_t)NTOK * 128 * 4;

constexpr int CW_DBG = 8;
constexpr int CW_BAR = 4096;
constexpr int CW_RND = 8192;

constexpr int LDS_BYTES = 163840;
constexpr int LDS_CTL_OFF = LDS_BYTES - 256;

__device__ __forceinline__ unsigned cvt_pk(float lo, float hi) { unsigned r; asm volatile("v_cvt_pk_bf16_f32 %0, %1, %2" : "=v"(r) : "v"(lo), "v"(hi)); return r; }
__device__ __forceinline__ unsigned cvt_pk_safe(float lo, float hi) { const f32x2 v = {lo, hi}; const bf16v2 b = __builtin_convertvector(v, bf16v2); return __builtin_bit_cast(unsigned, b); }
__device__ __forceinline__ unsigned cvt_pk_asm(float lo, float hi) { unsigned r; asm volatile("v_cvt_pk_bf16_f32 %0, %1, %2" : "=v"(r) : "v"(lo), "v"(hi)); return r; }
__device__ __forceinline__ float bflo(unsigned w) { return __builtin_bit_cast(float, w << 16); }
__device__ __forceinline__ float bfhi(unsigned w) { return __builtin_bit_cast(float, w & 0xffff0000u); }
__device__ __forceinline__ float bf2f(bf16_t b) { return __builtin_bit_cast(float, (unsigned)b << 16); }
__device__ __forceinline__ bf16_t f2bf_safe(float f) { return (bf16_t)(cvt_pk_safe(f, 0.f) & 0xffffu); }
__device__ __forceinline__ bf16_t f2bf(float f) { return (bf16_t)(cvt_pk(f, 0.f) & 0xffffu); }
#define DPP_I(v, ctrl) __builtin_amdgcn_update_dpp(0, (v), (ctrl), 0xF, 0xF, true)
__device__ __forceinline__ int shx_i(int v, int o) {
    switch (o) {
    case 1: return DPP_I(v, 0xB1);
    case 2: return DPP_I(v, 0x4E);
    case 4: return DPP_I(DPP_I(v, 0x1B), 0x141);
    case 8: return DPP_I(v, 0x128);
    default: return __shfl_xor(v, o);
    }
}
__device__ __forceinline__ float shx_f(float v, int o) { return __builtin_bit_cast(float, shx_i(__builtin_bit_cast(int, v), o)); }
#define DPP_F(v, ctrl) __builtin_bit_cast(float, DPP_I(__builtin_bit_cast(int, (v)), (ctrl)))
#define RL_F(v, l) __builtin_bit_cast(float, __builtin_amdgcn_readlane(__builtin_bit_cast(int, (v)), (l)))
__device__ __forceinline__ float wave_sum(float v) {
    v += DPP_F(v, 0xB1); v += DPP_F(v, 0x4E); v += DPP_F(v, 0x141); v += DPP_F(v, 0x140);
    return (RL_F(v, 0) + RL_F(v, 16)) + (RL_F(v, 32) + RL_F(v, 48));
}
__device__ __forceinline__ float wave_max(float v) {
    v = fmaxf(v, DPP_F(v, 0xB1)); v = fmaxf(v, DPP_F(v, 0x4E)); v = fmaxf(v, DPP_F(v, 0x141)); v = fmaxf(v, DPP_F(v, 0x140));
    return fmaxf(fmaxf(RL_F(v, 0), RL_F(v, 16)), fmaxf(RL_F(v, 32), RL_F(v, 48)));
}
__device__ __forceinline__ int wave_sum_i(int v) {
    v += DPP_I(v, 0xB1); v += DPP_I(v, 0x4E); v += DPP_I(v, 0x141); v += DPP_I(v, 0x140);
    return (__builtin_amdgcn_readlane(v, 0) + __builtin_amdgcn_readlane(v, 16)) + (__builtin_amdgcn_readlane(v, 32) + __builtin_amdgcn_readlane(v, 48));
}
__device__ __forceinline__ int crow(int r, int hi) { return (r & 3) + 8 * (r >> 2) + 4 * hi; }
__device__ __forceinline__ int modrow(int r) { const int b = r / RPB; return (r - b * RPB) < CTX ? 4 : b; }
__device__ __forceinline__ int lane_id() { int l; asm volatile("v_mbcnt_lo_u32_b32 %0, -1, 0\n\tv_mbcnt_hi_u32_b32 %0, -1, %0" : "=&v"(l)); return l; }
#define LDS_WAIT() asm volatile("s_waitcnt lgkmcnt(0)" ::: "memory")
#define VM_WAIT() asm volatile("s_waitcnt vmcnt(0)" ::: "memory")
#define SBAR() __builtin_amdgcn_sched_barrier(0)
#define LAUNDER_G(p) do { GAS unsigned char* _g = (GAS unsigned char*)(p); asm volatile("" : "+s"(_g)); (p) = (unsigned char*)_g; } while (0)

namespace pg8 {
#define PG8_LAS __attribute__((address_space(3)))
typedef unsigned short bf16_t;
typedef short bf16x8 __attribute__((ext_vector_type(8)));
typedef float f32x4 __attribute__((ext_vector_type(4)));
typedef unsigned u32x4 __attribute__((ext_vector_type(4)));
constexpr int BM = 256, BK = 64, HALF = 128, HTB = HALF * BK * 2  , STAGE_BYTES = 8 * HTB, NXCD = 8, WGM = 8;

__host__ __device__ __forceinline__ int lds_byte(int r, int c) { const int st = (r >> 4) * 2 + (c >> 5), rr = r & 15, cc = c & 31, ob = rr * 64 + cc * 2; return st * 1024 + (ob ^ (((ob >> 9) & 1) << 5)); }
__host__ __device__ __forceinline__ void stage_rc(int b, int& R, int& C) { const int st = b / 1024, sb = b % 1024, swz = sb ^ (((sb >> 9) & 1) << 5); R = (st >> 1) * 16 + swz / 64; C = (st & 1) * 32 + (swz % 64) / 2; }
__host__ __device__ __forceinline__ int perm32(int rho) { const int n = rho >> 4, i = rho & 15; return 8 * (i >> 2) + 4 * n + (i & 3); }

struct Unit { int pm, pn; };
struct Gemm { const bf16_t* A; const bf16_t* Bt; int M, N, K, lda, ldb; };

struct StaticOrder {
    int nM, nN, nwg, G, c;
    __host__ __device__ void init(int M, int N, int G_, int c_) { nM = M / BM; nN = N / BM; nwg = nM * nN; G = G_; c = c_; }
    __host__ __device__ bool next(int i, Unit& u) const {
        const long L = (long)i * G + c; if (L >= nwg) return false;
        int wgid = (int)L; { const int q = nwg / NXCD, r = nwg % NXCD, xcd = wgid % NXCD, off = wgid / NXCD; wgid = (xcd < r ? xcd * (q + 1) : r * (q + 1) + (xcd - r) * q) + off; }
        const int nig = WGM * nN, gid = wgid / nig, fm = gid * WGM, gsz = (nM - fm) < WGM ? (nM - fm) : WGM;
        u.pm = fm + ((wgid % nig) % gsz); u.pn = (wgid % nig) / gsz; return true;
    }
    __device__ __forceinline__ void a_ready(const Unit&) const {}
    __device__ __forceinline__ void done(const Unit&) const {}
};
struct LatentOrder : StaticOrder {
    __host__ __device__ void init(int N, int G_, int c_) { StaticOrder::init(16384, N, G_, c_); }
    __host__ __device__ bool next(int i, Unit& u) const { if (!StaticOrder::next(i, u)) return false; u.pm = u.pm + (u.pm >> 4) + 1; return true; }
};


__device__ __forceinline__ unsigned cvt_pk_bf16(float lo, float hi) { return ::cvt_pk_asm(lo, hi); }

template <int ACT  > struct EpiBf16 {
    static constexpr bool PERM = true, AFTER_DRAIN = false; static_assert(ACT == 0, "EpiBf16: no activation here");
    bf16_t* O; int ldc; const float* bias; int split_cols; size_t split_stride; float scale0;
    __device__ __forceinline__ void operator()(const f32x4 (&acc)[2][2][4][2], const Unit& u, int wr, int wc, int fr, int fq) const {
        const int row0 = u.pm * BM + wr * 64 + fr; int colt = u.pn * BM; bf16_t* base = O;
        float sc = 1.f; if (split_cols) { const int t = colt / split_cols; base += (size_t)t * split_stride; colt -= t * split_cols; if (t == 0) sc = scale0; }
        const int col0 = colt + wc * 32 + 8 * fq, bcol0 = u.pn * BM + wc * 32 + 8 * fq;
        f32x4 bv[2][2];
#pragma unroll
        for (int bj = 0; bj < 2; ++bj)
#pragma unroll
            for (int n = 0; n < 2; ++n) bv[bj][n] = bias ? *(const f32x4*)(bias + bcol0 + bj * HALF + 4 * n) : (f32x4){0.f, 0.f, 0.f, 0.f};
#pragma unroll
        for (int ai = 0; ai < 2; ++ai)
#pragma unroll
            for (int m = 0; m < 4; ++m) { bf16_t* rowp = base + (size_t)(row0 + ai * HALF + m * 16) * ldc + col0;
#pragma unroll
                for (int bj = 0; bj < 2; ++bj) { f32x4 v0 = acc[ai][bj][m][0] + bv[bj][0], v1 = acc[ai][bj][m][1] + bv[bj][1];
                    v0 = v0 * sc; v1 = v1 * sc; u32x4 w; w.x = cvt_pk_bf16(v0[0], v0[1]); w.y = cvt_pk_bf16(v0[2], v0[3]); w.z = cvt_pk_bf16(v1[0], v1[1]); w.w = cvt_pk_bf16(v1[2], v1[3]);
                    *(u32x4*)(rowp + bj * HALF) = w; } }
    }
};


template <class Epi, class Sched, bool ALIGN_EPI = false, bool SP2 = false>
__device__ __forceinline__ void gemm_phase(PG8_LAS unsigned char* lds, const Gemm g, const Sched& S, const Epi& E, int wid) {
    asm volatile("" : "+s"(wid));
    const int lane = lane_id(), tid = wid * 64 + lane, wr = wid >> 2, wc = wid & 3, fr = lane & 15, fq = lane >> 4;
    const int K = g.K, nt = K / BK;
    unsigned voffA[2], voffB[2];
#pragma unroll
    for (int i = 0; i < 2; ++i) { int R, C; stage_rc(tid * 16 + i * 8192, R, C); const int Rb = Epi::PERM ? ((R & ~31) + perm32(R & 31)) : R;
        voffA[i] = (unsigned)(R * g.lda + C) * 2u; voffB[i] = (unsigned)(Rb * g.ldb + C) * 2u; }
    const size_t kstep = (size_t)(BK * 2);
    const size_t hstepA = (size_t)HALF * g.lda * 2, hstepB = (size_t)HALF * g.ldb * 2;
    const size_t tstepA = 2 * hstepA, tstepB = 2 * hstepB;
    const unsigned ldsw = (unsigned)wid * 1024u;
    const int aoff = lds_byte(wr * 64 + fr, fq * 8), boff = lds_byte(wc * 32 + fr, fq * 8);
#define PG8_SA(b, h) (((b) * 2 + (h)) * HTB)
#define PG8_SB(b, h) ((4 + (b) * 2 + (h)) * HTB)
#define PG8_STAGE(bufoff, gbase, voff) do { _Pragma("unroll") for (int _i = 0; _i < 2; ++_i) \
        __builtin_amdgcn_global_load_lds((const unsigned*)((const char*)(gbase) + (voff)[_i]), (PG8_LAS unsigned*)(lds + (bufoff) + ldsw + _i * 8192), 16, 0, 0); } while (0)
#define PG8_LDA(dst, b, h) do { _Pragma("unroll") for (int m = 0; m < 4; ++m) _Pragma("unroll") for (int k = 0; k < 2; ++k) dst[m][k] = *(const PG8_LAS bf16x8*)(lds + PG8_SA(b, h) + aoff + m * 2048 + k * 1024); } while (0)
#define PG8_LDB(dst, b, h) do { _Pragma("unroll") for (int n = 0; n < 2; ++n) _Pragma("unroll") for (int k = 0; k < 2; ++k) dst[n][k] = *(const PG8_LAS bf16x8*)(lds + PG8_SB(b, h) + boff + n * 2048 + k * 1024); } while (0)
#define PG8_MMA(ai, bj, At, Bt) do { __builtin_amdgcn_s_setprio(1); _Pragma("unroll") for (int m = 0; m < 4; ++m) _Pragma("unroll") for (int n = 0; n < 2; ++n) _Pragma("unroll") for (int k = 0; k < 2; ++k) \
        acc[ai][bj][m][n] = __builtin_amdgcn_mfma_f32_16x16x32_bf16(Bt[n][k], At[m][k], acc[ai][bj][m][n], 0, 0, 0); __builtin_amdgcn_s_setprio(0); } while (0)
#define PG8_WAIT_V(n) asm volatile("s_waitcnt vmcnt(" #n ")" ::: "memory")
#define PG8_WAIT_L(n) asm volatile("s_waitcnt lgkmcnt(" #n ")" ::: "memory")
#define PG8_BAR __builtin_amdgcn_s_barrier()
#define PG8_SCHED __builtin_amdgcn_sched_barrier(0)
    Unit cur, nxt; int ui = 0;
    if (!S.next(0, cur)) return;
    f32x4 acc[2][2][4][2];
#pragma unroll
    for (int a = 0; a < 2; ++a)
#pragma unroll
        for (int b = 0; b < 2; ++b)
#pragma unroll
            for (int m = 0; m < 4; ++m)
#pragma unroll
                for (int n = 0; n < 2; ++n) acc[a][b][m][n] = (f32x4){0.f, 0.f, 0.f, 0.f};
    bf16x8 At[4][2], B0[2][2], B1[2][2];
    const char* cA = (const char*)g.A + (size_t)cur.pm * tstepA; const char* cB = (const char*)g.Bt + (size_t)cur.pn * tstepB;
    S.a_ready(cur);
    if constexpr (SP2) {
        PG8_STAGE(PG8_SB(0, 0), cB, voffB); PG8_STAGE(PG8_SB(0, 1), cB + hstepB, voffB); PG8_STAGE(PG8_SA(0, 0), cA, voffA); PG8_STAGE(PG8_SA(0, 1), cA + hstepA, voffA);
        if (wr == 1) PG8_BAR;
        PG8_WAIT_V(2); PG8_BAR;
        PG8_STAGE(PG8_SB(1, 0), cB + kstep, voffB); PG8_STAGE(PG8_SA(1, 0), cA + kstep, voffA); PG8_STAGE(PG8_SB(1, 1), cB + hstepB + kstep, voffB);
        PG8_WAIT_V(6); PG8_BAR;
    } else {
        PG8_STAGE(PG8_SB(0, 0), cB, voffB); PG8_STAGE(PG8_SA(0, 0), cA, voffA); PG8_STAGE(PG8_SB(0, 1), cB + hstepB, voffB); PG8_STAGE(PG8_SA(0, 1), cA + hstepA, voffA);
        if (wr == 1) PG8_BAR;
        PG8_WAIT_V(4); PG8_BAR;
        PG8_STAGE(PG8_SB(1, 0), cB + kstep, voffB); PG8_STAGE(PG8_SA(1, 0), cA + kstep, voffA); PG8_STAGE(PG8_SB(1, 1), cB + hstepB + kstep, voffB);
        PG8_WAIT_V(6); PG8_BAR;
    }
    for (;;) {
        const bool has_next = S.next(ui + 1, nxt);
        const char* nA = has_next ? (const char*)g.A + (size_t)nxt.pm * tstepA : cA; const char* nB = has_next ? (const char*)g.Bt + (size_t)nxt.pn * tstepB : cB;
#pragma unroll 1
        for (int t = 0; t < nt; t += 2) {
            const bool last = (t == nt - 2);
            const char* a1 = cA + (size_t)(t + 1) * kstep;
            const char* a2 = last ? nA : cA + (size_t)(t + 2) * kstep; const char* b2 = last ? nB : cB + (size_t)(t + 2) * kstep;
            const char* a3 = a2 + kstep; const char* b3 = b2 + kstep;
            if (last && has_next) S.a_ready(nxt);
            if constexpr (SP2) {
            PG8_LDB(B0, 0, 0); PG8_LDB(B1, 0, 1); PG8_SCHED; PG8_LDA(At, 0, 0); PG8_STAGE(PG8_SA(1, 1), a1 + hstepA, voffA);
            PG8_WAIT_V(8); PG8_WAIT_L(0); PG8_BAR; PG8_MMA(0, 0, At, B0); PG8_MMA(0, 1, At, B1); PG8_BAR; PG8_SCHED;
            PG8_LDA(At, 0, 1); PG8_STAGE(PG8_SB(0, 0), b2, voffB); PG8_STAGE(PG8_SB(0, 1), b2 + hstepB, voffB); PG8_STAGE(PG8_SA(0, 0), a2, voffA);
            PG8_WAIT_V(8); PG8_WAIT_L(0); PG8_BAR; PG8_MMA(1, 0, At, B0); PG8_MMA(1, 1, At, B1); PG8_BAR; PG8_SCHED;
            PG8_LDB(B0, 1, 0); PG8_LDB(B1, 1, 1); PG8_SCHED; PG8_LDA(At, 1, 0); PG8_STAGE(PG8_SA(0, 1), a2 + hstepA, voffA);
            PG8_WAIT_V(8); PG8_WAIT_L(0); PG8_BAR; PG8_MMA(0, 0, At, B0); PG8_MMA(0, 1, At, B1); PG8_BAR; PG8_SCHED;
            PG8_LDA(At, 1, 1); PG8_STAGE(PG8_SB(1, 0), b3, voffB); PG8_STAGE(PG8_SB(1, 1), b3 + hstepB, voffB); PG8_STAGE(PG8_SA(1, 0), a3, voffA);
            PG8_WAIT_V(8); PG8_WAIT_L(0); PG8_BAR; PG8_MMA(1, 0, At, B0); PG8_MMA(1, 1, At, B1); PG8_BAR; PG8_SCHED;
            } else {
            PG8_LDB(B0, 0, 0); PG8_SCHED; PG8_LDA(At, 0, 0); PG8_STAGE(PG8_SA(1, 1), a1 + hstepA, voffA);
            PG8_WAIT_L(8); PG8_BAR; PG8_WAIT_L(0); PG8_MMA(0, 0, At, B0); PG8_BAR; PG8_SCHED;
            PG8_LDB(B1, 0, 1); PG8_STAGE(PG8_SB(0, 0), b2, voffB);
            PG8_BAR; PG8_WAIT_L(0); PG8_MMA(0, 1, At, B1); PG8_BAR;
            PG8_LDA(At, 0, 1); PG8_STAGE(PG8_SA(0, 0), a2, voffA);
            PG8_BAR; PG8_WAIT_L(0); PG8_MMA(1, 0, At, B0); PG8_BAR; PG8_SCHED;
            PG8_STAGE(PG8_SB(0, 1), b2 + hstepB, voffB);
            PG8_WAIT_V(6); PG8_BAR; PG8_MMA(1, 1, At, B1); PG8_BAR;
            PG8_LDB(B0, 1, 0); PG8_SCHED; PG8_LDA(At, 1, 0); PG8_STAGE(PG8_SA(0, 1), a2 + hstepA, voffA);
            PG8_WAIT_L(8); PG8_BAR; PG8_WAIT_L(0); PG8_MMA(0, 0, At, B0); PG8_BAR; PG8_SCHED;
            PG8_LDB(B1, 1, 1); PG8_STAGE(PG8_SB(1, 0), b3, voffB);
            PG8_BAR; PG8_WAIT_L(0); PG8_MMA(0, 1, At, B1); PG8_BAR;
            PG8_LDA(At, 1, 1); PG8_STAGE(PG8_SA(1, 0), a3, voffA);
            PG8_BAR; PG8_WAIT_L(0); PG8_MMA(1, 0, At, B0); PG8_BAR; PG8_SCHED;
            PG8_STAGE(PG8_SB(1, 1), b3 + hstepB, voffB);
            PG8_WAIT_V(6); PG8_BAR; PG8_MMA(1, 1, At, B1); PG8_BAR;
            }
        }
        if constexpr (ALIGN_EPI) { if (wr == 0) PG8_BAR; }
        if constexpr (!Epi::AFTER_DRAIN) { E(acc, cur, wr, wc, fr, fq); S.done(cur); }
        if (!has_next) break;
#pragma unroll
        for (int a = 0; a < 2; ++a)
#pragma unroll
            for (int b = 0; b < 2; ++b)
#pragma unroll
                for (int m = 0; m < 4; ++m)
#pragma unroll
                    for (int n = 0; n < 2; ++n) acc[a][b][m][n] = (f32x4){0.f, 0.f, 0.f, 0.f};
        cur = nxt; cA = nA; cB = nB; ++ui;
        if constexpr (ALIGN_EPI) { if (wr == 1) PG8_BAR; }
    }
    PG8_WAIT_V(0);
    if constexpr (!ALIGN_EPI) { if (wr == 0) PG8_BAR; }
    PG8_BAR;
    if constexpr (Epi::AFTER_DRAIN) { E.fused(acc, cur, wr, wc, fr, fq, lds, wid, lane); S.done(cur); }
#undef PG8_SA
#undef PG8_SB
#undef PG8_STAGE
#undef PG8_LDA
#undef PG8_LDB
#undef PG8_MMA
#undef PG8_WAIT_V
#undef PG8_WAIT_L
#undef PG8_BAR
#undef PG8_SCHED
}
}
#define XB_TMO      128
#define XB_XCNT(j)  (256  + 64 * (j))
#define XB_XSUB(j)  (1280 + 64 * (j))
#define XB_XGEN(j)  (2304 + 64 * (j))
#define XB_TOP      3328
#define XB_TOPGEN   3392
#define XCD_BAR_WORDS 3456
#define XB_SPIN_CAP (1u << 22)

__device__ __forceinline__ unsigned xb_ld(unsigned* p)              { return __hip_atomic_load(p, __ATOMIC_RELAXED, __HIP_MEMORY_SCOPE_AGENT); }
__device__ __forceinline__ unsigned xb_add(unsigned* p, unsigned v) { return __hip_atomic_fetch_add(p, v, __ATOMIC_RELAXED, __HIP_MEMORY_SCOPE_AGENT); }
__device__ __forceinline__ unsigned xb_xcc_id() { return (unsigned)__builtin_amdgcn_s_getreg((3 << 11) | 20) & 0xFu; }
#define XB_SPIN(cond, bar) do { unsigned _sp = 0; while (cond) { __builtin_amdgcn_s_sleep(1); \
    if ((++_sp & 255u) == 0u) { if (xb_ld(&(bar)[XB_TMO])) break; if (_sp > XB_SPIN_CAP) { atomicAdd(&(bar)[XB_TMO], 1u); break; } } } } while (0)

struct XcdBarrier {
    unsigned* bar; unsigned x; unsigned wv;
    volatile LAS unsigned* st;
};

__device__ __forceinline__ XcdBarrier xcd_barrier_post(unsigned* bar, volatile LAS unsigned* st) {
    XcdBarrier b; b.bar = bar; b.x = xb_xcc_id(); b.st = st; b.wv = 0u;
    if (threadIdx.x == 0) (void)xb_add(&bar[XB_XCNT(b.x)], 1u);
    return b;
}
__device__ __forceinline__ void xcd_barrier_complete(unsigned* bar, unsigned x, unsigned& nloc, unsigned& nx) {
    const unsigned G = gridDim.x * gridDim.y * gridDim.z;
    unsigned sum, cnt, mine, sp = 0u;
    for (;;) {
        sum = 0u; cnt = 0u; mine = 0u;
#pragma unroll
        for (unsigned j = 0; j < 16; ++j) { const unsigned c = xb_ld(&bar[XB_XCNT(j)]); sum += c; cnt += (c > 0u) ? 1u : 0u; mine = (j == x) ? c : mine; }
        if (sum == G) break;
        __builtin_amdgcn_s_sleep(1);
        if ((++sp & 255u) == 0u) { if (xb_ld(&bar[XB_TMO])) break; if (sp > XB_SPIN_CAP) { atomicAdd(&bar[XB_TMO], 1u); break; } }
    }
    nloc = mine > 0u ? mine : 1u; nx = cnt > 0u ? cnt : 1u;
}

__device__ __forceinline__ void xcd_barrier(const XcdBarrier& b) {
    asm volatile("s_waitcnt vmcnt(0)" ::: "memory");
    __syncthreads();
    if (b.wv == 0u && lane_id() == 0) {
        unsigned* bar = b.bar;
        __builtin_amdgcn_s_waitcnt(0);
        unsigned nloc = b.st[0], nx = b.st[1];
        if (nloc == 0u) { xcd_barrier_complete(bar, b.x, nloc, nx); b.st[0] = nloc; b.st[1] = nx; }
        const unsigned old = xb_add(&bar[XB_XSUB(b.x)], 1u);
        const unsigned gen = old / nloc;
        if (old + 1u == (gen + 1u) * nloc) {
            __builtin_amdgcn_fence(__ATOMIC_RELEASE, "agent");
            asm volatile("s_waitcnt vmcnt(0)" ::: "memory");
            const unsigned og = xb_add(&bar[XB_TOP], 1u);
            const unsigned tg = og / nx;
            if (og + 1u == (tg + 1u) * nx) xb_add(&bar[XB_TOPGEN], 1u);
            else XB_SPIN(xb_ld(&bar[XB_TOPGEN]) == tg, bar);
            __builtin_amdgcn_fence(__ATOMIC_ACQUIRE, "agent");
            xb_add(&bar[XB_XGEN(b.x)], 1u);
            asm volatile("s_waitcnt vmcnt(0)" ::: "memory");
        } else {
            XB_SPIN(xb_ld(&bar[XB_XGEN(b.x)]) == gen, bar);
            __builtin_amdgcn_fence(__ATOMIC_ACQUIRE, "agent");
            asm volatile("s_waitcnt vmcnt(0)" ::: "memory");
        }
    }
    __syncthreads();
}

namespace pg8 {
struct EpiQRope {
    static constexpr bool PERM = true, AFTER_DRAIN = false;
    bf16_t* O; const float* cosT; const float* sinT;
    __device__ __forceinline__ void operator()(const f32x4 (&acc)[2][2][4][2], const Unit& u, int wr, int wc, int fr, int fq) const {
        const int row0 = u.pm * BM + wr * 64 + fr, colb = u.pn * BM + wc * 32 + 8 * fq;
#pragma unroll
        for (int ai = 0; ai < 2; ++ai)
#pragma unroll
            for (int m = 0; m < 4; ++m) {
                const int row = row0 + ai * HALF + m * 16; const int b = row / RPB, t = row - b * RPB - CTX;
                bf16_t* rowp = O + (size_t)row * 1536;
#pragma unroll
                for (int bj = 0; bj < 2; ++bj) {
                    const int col = colb + bj * HALF; const int hh = col / 192, jj = col - hh * 192;
                    f32x4 v0 = acc[ai][bj][m][0], v1 = acc[ai][bj][m][1];
                    if (jj >= 128 && t >= 0) {
                        const int i0 = (jj - 128) >> 1;
                        const f32x4 c4 = *(const f32x4*)(cosT + (size_t)t * 32 + i0), s4 = *(const f32x4*)(sinT + (size_t)t * 32 + i0);
                        f32x4 w0, w1;
                        w0.x = v0.x * c4.x - v0.y * s4.x; w0.y = v0.x * s4.x + v0.y * c4.x;
                        w0.z = v0.z * c4.y - v0.w * s4.y; w0.w = v0.z * s4.y + v0.w * c4.y;
                        w1.x = v1.x * c4.z - v1.y * s4.z; w1.y = v1.x * s4.z + v1.y * c4.z;
                        w1.z = v1.z * c4.w - v1.w * s4.w; w1.w = v1.z * s4.w + v1.w * c4.w;
                        v0 = w0; v1 = w1;
                    }
                    u32x4 w; w.x = cvt_pk_bf16(v0[0], v0[1]); w.y = cvt_pk_bf16(v0[2], v0[3]); w.z = cvt_pk_bf16(v1[0], v1[1]); w.w = cvt_pk_bf16(v1[2], v1[3]);
                    *(u32x4*)(rowp + col) = w;
                }
            }
    }
};
struct EpiResid {
    static constexpr bool PERM = false, AFTER_DRAIN = false;
    float* X; const float* gate;
    __device__ __forceinline__ void operator()(const f32x4 (&acc)[2][2][4][2], const Unit& u, int wr, int wc, int fr, int fq) const {
        const int row0 = u.pm * BM + wr * 64 + fr, col0 = u.pn * BM + wc * 32 + 4 * fq;
#pragma unroll
        for (int ai = 0; ai < 2; ++ai)
#pragma unroll
            for (int m = 0; m < 4; ++m) {
                const int row = row0 + ai * HALF + m * 16; const float* gp = gate + (size_t)modrow(row) * NMOD + col0; float* xp = X + (size_t)row * DM + col0;
#pragma unroll
                for (int bj = 0; bj < 2; ++bj)
#pragma unroll
                    for (int n = 0; n < 2; ++n) { const int c = bj * HALF + n * 16; const f32x4 g4 = *(const f32x4*)(gp + c); f32x4 x4 = *(const f32x4*)(xp + c); x4 += g4 * acc[ai][bj][m][n]; *(f32x4*)(xp + c) = x4; }
            }
    }
};
}

struct Args { const float* in[22]; float* out; unsigned char* ws; int ph_lo, ph_hi; };
struct Ptrs {
    LAS unsigned char* L;
    __device__ __forceinline__ unsigned long long raw(int i) const { const unsigned long long v = *(volatile LAS unsigned long long*)(L + LDS_CTL_OFF + 64 + 8 * i);
        const unsigned lo = __builtin_amdgcn_readfirstlane((unsigned)v), hi = __builtin_amdgcn_readfirstlane((unsigned)(v >> 32)); return ((unsigned long long)hi << 32) | lo; }
    __device__ __forceinline__ const float* in(int i) const { return (const float*)(GAS const float*)raw(i); }
    __device__ __forceinline__ float* out() const { return (float*)(GAS float*)raw(22); }
    __device__ __forceinline__ unsigned char* ws() const { return (unsigned char*)(GAS unsigned char*)raw(23); }
};

__device__ __forceinline__ void row_load_f32(const float* src, int lane, float (&v)[4][8]) {
#pragma unroll
    for (int i = 0; i < 4; ++i) { const f32x4 a = *(const f32x4*)(src + (lane + 64 * i) * 8), b = *(const f32x4*)(src + (lane + 64 * i) * 8 + 4);
        v[i][0] = a.x; v[i][1] = a.y; v[i][2] = a.z; v[i][3] = a.w; v[i][4] = b.x; v[i][5] = b.y; v[i][6] = b.z; v[i][7] = b.w; }
}
__device__ __forceinline__ void row_store_f32(float* dst, int lane, const float (&v)[4][8]) {
#pragma unroll
    for (int i = 0; i < 4; ++i) { *(f32x4*)(dst + (lane + 64 * i) * 8) = (f32x4){v[i][0], v[i][1], v[i][2], v[i][3]}; *(f32x4*)(dst + (lane + 64 * i) * 8 + 4) = (f32x4){v[i][4], v[i][5], v[i][6], v[i][7]}; }
}
__device__ __forceinline__ float row_rstd(const float (&v)[4][8]) {
    float ss = 0.f;
#pragma unroll
    for (int i = 0; i < 4; ++i)
#pragma unroll
        for (int j = 0; j < 8; ++j) ss += v[i][j] * v[i][j];
    ss = wave_sum(ss);
    return 1.0f / sqrtf(ss * (1.0f / DM) + EPS);
}
__device__ __forceinline__ void norm_mod_store(const float (&v)[4][8], float rstd, const float* g, const float* sh, const float* sc, bf16_t* hrow, int lane) {
#pragma unroll
    for (int i = 0; i < 4; ++i) { const int col = (lane + 64 * i) * 8; float gg[8], ss[8], cc[8];
        *(f32x4*)&gg[0] = *(const f32x4*)(g + col); *(f32x4*)&gg[4] = *(const f32x4*)(g + col + 4);
        *(f32x4*)&ss[0] = *(const f32x4*)(sh + col); *(f32x4*)&ss[4] = *(const f32x4*)(sh + col + 4);
        *(f32x4*)&cc[0] = *(const f32x4*)(sc + col); *(f32x4*)&cc[4] = *(const f32x4*)(sc + col + 4);
        float y[8];
#pragma unroll
        for (int j = 0; j < 8; ++j) y[j] = (v[i][j] * rstd * gg[j]) * (1.f + cc[j]) + ss[j];
        u32x4 o; o.x = cvt_pk(y[0], y[1]); o.y = cvt_pk(y[2], y[3]); o.z = cvt_pk(y[4], y[5]); o.w = cvt_pk(y[6], y[7]);
        *(u32x4*)(hrow + col) = o; }
}

template <class RM>
__device__ __forceinline__ void transpose_item(const float* W, int K, int N, int item, LAS float* scr, int lane, const RM& rm) {
    const int nblk = N / 32, kb = item / nblk, nb = item - kb * nblk, k0 = 64 * kb, n0 = 32 * nb;
#pragma unroll 8
    for (int i = 0; i < 32; ++i) { const int kk = 2 * i + (lane >> 5); scr[kk * 33 + (lane & 31)] = W[(size_t)(k0 + kk) * N + n0 + (lane & 31)]; }
    LDS_WAIT(); asm volatile("" ::: "memory");
    const int c = lane & 7;
#pragma unroll
    for (int j = 0; j < 4; ++j) { const int n = (lane >> 3) + 8 * j; const LAS float* s = scr + (8 * c) * 33 + n;
        u32x4 o; o.x = cvt_pk(s[0], s[33]); o.y = cvt_pk(s[66], s[99]); o.z = cvt_pk(s[132], s[165]); o.w = cvt_pk(s[198], s[231]);
        *(u32x4*)(rm(n0 + n) + k0 + 8 * c) = o; }
    LDS_WAIT(); asm volatile("" ::: "memory");
}

__device__ __forceinline__ void p0a(const Ptrs& A, LAS unsigned char* L, int wave, int bid, int G) { asm volatile("" : "+s"(wave)); const int lane = lane_id(); const int tid = wave * 64 + lane; (void)tid;
    unsigned char* ws = A.ws(); LAUNDER_G(ws);
    {
        LAS float* sl = (LAS float*)L;
        LAS float* red = (LAS float*)(L + 40960);
        for (int i = tid; i < 5 * DM; i += NTHR) { const int r = i / DM, k = i - r * DM; const float c = r < 4 ? A.in(1)[r * DM + k] : A.in(3)[k]; sl[i] = c / (1.f + expf(-c)); }
        __syncthreads();
        float* MOD = (float*)(ws + WS_MOD);
        for (int u = bid; u < DEPTH * 192; u += G) {
            const int l = u / 192, nt = u - l * 192, cg = tid & 15, kg = tid >> 4;
            const float* wp = A.in(4) + ((size_t)l * DM + kg * 64) * NMOD + nt * 64 + cg * 4;
            f32x4 acc[5];
#pragma unroll
            for (int r = 0; r < 5; ++r) acc[r] = (f32x4){0.f, 0.f, 0.f, 0.f};
#pragma unroll 8
            for (int kk = 0; kk < 64; ++kk) { const f32x4 w = *(const f32x4*)(wp + (size_t)kk * NMOD); const int k = kg * 64 + kk;
#pragma unroll
                for (int r = 0; r < 5; ++r) acc[r] += w * sl[r * DM + k]; }
#pragma unroll
            for (int r = 0; r < 5; ++r) *(LAS f32x4*)(red + (kg * 5 + r) * 64 + cg * 4) = acc[r];
            __syncthreads();
            if (tid < 320) { const int r = tid >> 6, col = tid & 63; float s = 0.f;
                for (int g = 0; g < 32; ++g) s += red[(g * 5 + r) * 64 + col];
                MOD[((size_t)l * 5 + r) * NMOD + nt * 64 + col] = s + A.in(5)[l * NMOD + nt * 64 + col]; }
            __syncthreads();
        }
    }
    {
        LAS float* scr = (LAS float*)(L + wave * 16384);
        const int gw = bid * NWAVES + wave, NGW = G * NWAVES;
        constexpr int I_IN = 32 * 123, I_UQ = 8 * 48, I_UKV = 4 * 64, I_SQ = 32 * 64, I_L = I_IN + I_UQ + I_UKV + 2 * I_SQ;
        for (int it = gw; it < DEPTH * I_L; it += NGW) {
            const int l = it / I_L; int r = it - l * I_L;
            if (r < I_IN) {
                bf16_t* mainp = (bf16_t*)(ws + WS_WIN) + (size_t)l * PW * DM; bf16_t* sidep = (bf16_t*)(ws + WS_WSIDE) + (size_t)l * SIDEW * DM;
                transpose_item(A.in(8) + (size_t)l * DM * 3936, DM, 3936, r, scr, lane, [=](int n) -> bf16_t* {
                    return n < 768 ? mainp + (size_t)n * DM : n < 832 ? sidep + (size_t)(n - 768) * DM : n < 3904 ? mainp + (size_t)(n - 64) * DM : sidep + (size_t)(64 + n - 3904) * DM; });
                continue; }
            r -= I_IN;
            if (r < I_UQ) {
                bf16_t* dst = (bf16_t*)(ws + WS_WUQ) + (size_t)l * 1536 * 512;
                transpose_item(A.in(11) + (size_t)l * 512 * 1536, 512, 1536, r, scr, lane, [=](int n) -> bf16_t* {
                    const int hh = n / 192, j = n - hh * 192; const int jn = j < 128 ? j : (j < 160 ? 128 + 2 * (j - 128) : 128 + 2 * (j - 160) + 1); return dst + (size_t)(hh * 192 + jn) * 512; });
                continue; }
            r -= I_UQ;
            if (r < I_UKV) { bf16_t* dst = (bf16_t*)(ws + WS_WUKV) + (size_t)l * 2048 * 256;
                transpose_item(A.in(12) + (size_t)l * 256 * 2048, 256, 2048, r, scr, lane, [=](int n) -> bf16_t* { return dst + (size_t)n * 256; }); continue; }
            r -= I_UKV;
            if (r < I_SQ) { bf16_t* dst = (bf16_t*)(ws + WS_WOUT) + (size_t)l * DM * DM;
                transpose_item(A.in(16) + (size_t)l * DM * DM, DM, DM, r, scr, lane, [=](int n) -> bf16_t* { return dst + (size_t)n * DM; }); continue; }
            r -= I_SQ;
            { bf16_t* dst = (bf16_t*)(ws + WS_WQRY) + (size_t)l * DM * DM;
                transpose_item(A.in(17) + (size_t)l * DM * DM, DM, DM, r, scr, lane, [=](int n) -> bf16_t* { return dst + (size_t)n * DM; }); }
        }
    }
    {
        const size_t gt = (size_t)bid * NTHR + tid, NT = (size_t)G * NTHR;
        {
            const int gw = bid * NWAVES + wave, NGW = G * NWAVES;
            for (int rr = gw; rr < 2 * DEPTH * NEXP; rr += NGW) { const bool isu = rr < DEPTH * NEXP; const int row = isu ? rr : rr - DEPTH * NEXP;
                const float* src = (isu ? A.in(19) : A.in(20)) + (size_t)row * DM;
                f32x4 x[8]; float ss = 0.f;
#pragma unroll
                for (int i = 0; i < 8; ++i) { x[i] = *(const f32x4*)(src + (lane + 64 * i) * 4); ss += (x[i].x * x[i].x + x[i].y * x[i].y) + (x[i].z * x[i].z + x[i].w * x[i].w); }
                ss = wave_sum(ss); const float rms = sqrtf(ss * (1.0f / DM));
                u32x4 p; float sc;
                if (isu) { sc = rms > 0.f ? rms * (1.0f / 3.0f) : 1.0f; const float inv = 1.0f / sc;
#pragma unroll
                    for (int w = 0; w < 4; ++w) { const f32x4 a = x[2 * w], c = x[2 * w + 1]; const float av[4] = {a.x, a.y, a.z, a.w}, cv[4] = {c.x, c.y, c.z, c.w}; unsigned d = 0u;
#pragma unroll
                        for (int b = 0; b < 4; ++b) { const int n0 = (int)fminf(fmaxf(floorf(av[b] * inv + 8.0f), 0.f), 15.f), n1 = (int)fminf(fmaxf(floorf(cv[b] * inv + 8.0f), 0.f), 15.f);
                            d |= ((unsigned)n0 << (8 * b)) | ((unsigned)n1 << (8 * b + 4)); }
                        p[w] = d; }
                } else { sc = rms > 0.f ? rms * 0.5f : 1.0f; const float inv = 1.0f / sc;
#pragma unroll
                    for (int w = 0; w < 4; ++w) { const f32x4 a = x[2 * w], c = x[2 * w + 1]; unsigned d = 0u;
#define Q4C(v) fminf(fmaxf((v) * inv, -6.0f), 6.0f)
                        d = __builtin_amdgcn_cvt_scalef32_pk_fp4_f32(d, Q4C(a.x), Q4C(a.y), 1.0f, 0); d = __builtin_amdgcn_cvt_scalef32_pk_fp4_f32(d, Q4C(a.z), Q4C(a.w), 1.0f, 1);
                        d = __builtin_amdgcn_cvt_scalef32_pk_fp4_f32(d, Q4C(c.x), Q4C(c.y), 1.0f, 2); d = __builtin_amdgcn_cvt_scalef32_pk_fp4_f32(d, Q4C(c.z), Q4C(c.w), 1.0f, 3);
#undef Q4C
                        p[w] = d; } }
                unsigned char* dst = ws + (isu ? WS_EU : WS_EV) + (size_t)row * EROW;
                *(u32x4*)(dst + lane * 16) = p;
                if (lane == 0) ((float*)(ws + (isu ? WS_SU : WS_SV)))[row] = sc; } }
        const size_t s8 = (size_t)DEPTH * 2 * 8 * 128 * 128 / 8;
        for (size_t i = gt; i < s8; i += NT) { const float* src = A.in(18) + i * 8;
            const f32x4 a = *(const f32x4*)src, b = *(const f32x4*)(src + 4); u32x4 o; o.x = cvt_pk(a.x, a.y); o.y = cvt_pk(a.z, a.w); o.z = cvt_pk(b.x, b.y); o.w = cvt_pk(b.z, b.w);
            *(u32x4*)((bf16_t*)(ws + WS_SUBK) + i * 8) = o; }
        float* cosT = (float*)(ws + WS_ROPE); float* sinT = cosT + SEQ * 32;
        for (size_t i = gt; i < (size_t)SEQ * 32; i += NT) { const int t = (int)(i >> 5), a = (int)(i & 31), m = a & 15; const int pos = a < 16 ? (t >> 6) : (t & 63);
            const float inv = 1.0f / powf(10000.0f, (float)(2 * m) / 32.0f); const float ang = (float)pos * inv; cosT[i] = cosf(ang); sinT[i] = sinf(ang); }
    }
}

__device__ __forceinline__ void p0b(const Ptrs& A, int wave, int bid, int G) { asm volatile("" : "+s"(wave)); const int lane = lane_id();
    unsigned char* ws = A.ws(); LAUNDER_G(ws); const int gw = bid + G * wave, NGW = G * NWAVES;
    const float* MOD = (const float*)(ws + WS_MOD);
    for (int r = gw; r < NTOK; r += NGW) {
        const int b = r / RPB, j = r - b * RPB; const float* src = j < CTX ? A.in(2) + ((size_t)b * CTX + j) * DM : A.in(0) + ((size_t)b * SEQ + (j - CTX)) * DM;
        float v[4][8]; row_load_f32(src, lane, v); row_store_f32((float*)(ws + WS_XRES) + (size_t)r * DM, lane, v);
        const float rstd = row_rstd(v); const float* mp = MOD + (size_t)(j < CTX ? 4 : b) * NMOD;
        norm_mod_store(v, rstd, A.in(6), mp, mp + DM, (bf16_t*)(ws + WS_H) + (size_t)r * DM, lane);
    }
}

__device__ __forceinline__ void side_gemm(const Ptrs& A, LAS unsigned char* L, int l, int wave, int bid, int G) { asm volatile("" : "+s"(wave)); const int lane = lane_id(); const int tid = wave * 64 + lane;
    unsigned char* ws = A.ws(); LAUNDER_G(ws); const bf16_t* H = (const bf16_t*)(ws + WS_H); const bf16_t* W = (const bf16_t*)(ws + WS_WSIDE) + (size_t)l * SIDEW * DM; float* SIDE = (float*)(ws + WS_SIDE);
    LAS float* red = (LAS float*)L;
    for (int u = bid; u < NTOK / 32; u += G) {
        const int rbase = u * 32;
        f32x4 acc[2][6];
#pragma unroll
        for (int rb = 0; rb < 2; ++rb)
#pragma unroll
            for (int cb = 0; cb < 6; ++cb) acc[rb][cb] = (f32x4){0.f, 0.f, 0.f, 0.f};
        const bf16_t* ap = H + (size_t)(rbase + (lane & 15)) * DM + wave * 256 + 8 * (lane >> 4);
        const bf16_t* bp = W + (size_t)(lane & 15) * DM + wave * 256 + 8 * (lane >> 4);
#pragma unroll
        for (int kh = 0; kh < 2; ++kh) {
            bf16x8 a[2][4], bq[6][4];
#pragma unroll
            for (int ks = 0; ks < 4; ++ks) {
#pragma unroll
                for (int rb = 0; rb < 2; ++rb) a[rb][ks] = *(const bf16x8*)(ap + (size_t)rb * 16 * DM + (kh * 4 + ks) * 32);
#pragma unroll
                for (int cb = 0; cb < 6; ++cb) bq[cb][ks] = *(const bf16x8*)(bp + (size_t)cb * 16 * DM + (kh * 4 + ks) * 32); }
#pragma unroll
            for (int ks = 0; ks < 4; ++ks)
#pragma unroll
                for (int rb = 0; rb < 2; ++rb)
#pragma unroll
                    for (int cb = 0; cb < 6; ++cb) acc[rb][cb] = __builtin_amdgcn_mfma_f32_16x16x32_bf16(a[rb][ks], bq[cb][ks], acc[rb][cb], 0, 0, 0);
        }
#pragma unroll
        for (int rb = 0; rb < 2; ++rb)
#pragma unroll
            for (int cb = 0; cb < 6; ++cb)
#pragma unroll
                for (int rg = 0; rg < 4; ++rg) red[(wave * 32 + rb * 16 + (lane >> 4) * 4 + rg) * 96 + cb * 16 + (lane & 15)] = acc[rb][cb][rg];
        __syncthreads();
        for (int i = tid; i < 32 * 96 / 4; i += NTHR) { f32x4 s = *(const LAS f32x4*)(red + i * 4);
#pragma unroll
            for (int w = 1; w < 8; ++w) s += *(const LAS f32x4*)(red + w * 32 * 96 + i * 4);
            *(f32x4*)(SIDE + (size_t)rbase * SIDEW + i * 4) = s; }
        __syncthreads();
    }
}

constexpr int CG_A = 0, CG_B = 16384, CG_BUF = 49152;
template <class F>
__device__ __forceinline__ void ctx_gemm(LAS unsigned char* L, const bf16_t* Ab, int lda, const bf16_t* Wt, int ldb, int N, int K, int wave, int bid, int G, const F& f) { asm volatile("" : "+s"(wave)); const int lane = lane_id(); const int tid = wave * 64 + lane;
    const int r32 = lane & 31, hi = lane >> 5, wr = wave >> 2, wc = wave & 3, ncu = N / 128, nch = K / 128;
    for (int u = bid; u < 16 * ncu; u += G) {
        const int mt = u / ncu, nt = u - mt * ncu; const int m0 = mt * 64, row0 = (m0 >> 8) * RPB + (m0 & 255), col0 = nt * 128;
        const int cch = tid & 15, ra = tid >> 4;
        const bf16_t* ga = Ab + (size_t)(row0 + ra) * lda + cch * 8; const bf16_t* gb = Wt + (size_t)(col0 + ra) * ldb + cch * 8;
        u32x4 sa[2], sb[4];
#define CG_LOAD(k0) do { sa[0] = *(const u32x4*)(ga + (k0)); sa[1] = *(const u32x4*)(ga + (size_t)32 * lda + (k0)); \
        _Pragma("unroll") for (int i = 0; i < 4; ++i) sb[i] = *(const u32x4*)(gb + (size_t)(32 * i) * ldb + (k0)); } while (0)
#define CG_WRITE(buf) do { _Pragma("unroll") for (int i = 0; i < 2; ++i) { const int row = ra + 32 * i; *(LAS u32x4*)(L + (buf) * CG_BUF + CG_A + row * 256 + ((cch ^ (row & 15)) << 4)) = sa[i]; } \
        _Pragma("unroll") for (int i = 0; i < 4; ++i) { const int row = ra + 32 * i; *(LAS u32x4*)(L + (buf) * CG_BUF + CG_B + row * 256 + ((cch ^ (row & 15)) << 4)) = sb[i]; } } while (0)
        f32x16 acc;
#pragma unroll
        for (int r = 0; r < 16; ++r) acc[r] = 0.f;
        CG_LOAD(0); CG_WRITE(0);
        __syncthreads();
#pragma unroll 1
        for (int ch = 0; ch < nch; ++ch) { const int buf = ch & 1;
            if (ch + 1 < nch) CG_LOAD((ch + 1) * 128);
#pragma unroll
            for (int ks = 0; ks < 8; ++ks) { const int cc = ks * 2 + hi;
                const bf16x8 a = *(const LAS bf16x8*)(L + buf * CG_BUF + CG_A + (32 * wr + r32) * 256 + ((cc ^ (r32 & 15)) << 4)), bq = *(const LAS bf16x8*)(L + buf * CG_BUF + CG_B + (32 * wc + r32) * 256 + ((cc ^ (r32 & 15)) << 4));
                acc = __builtin_amdgcn_mfma_f32_32x32x16_bf16(a, bq, acc, 0, 0, 0); }
            if (ch + 1 < nch) CG_WRITE(buf ^ 1);
            __syncthreads(); }
#undef CG_LOAD
#undef CG_WRITE
#pragma unroll
        for (int r = 0; r < 16; ++r) f(row0 + 32 * wr + crow(r, hi), col0 + 32 * wc + r32, acc[r]);
    }
}

__device__ __forceinline__ void thin_rows(const Ptrs& A, int l, int wave, int bid, int G) { asm volatile("" : "+s"(wave)); const int lane = lane_id();
    unsigned char* ws = A.ws(); LAUNDER_G(ws); const int nx5 = (NGU % G) * 2 < G ? NGU % G : 0;
    if (bid < nx5) return;
    const int gw = (bid - nx5) + (G - nx5) * wave, NGW = (G - nx5) * NWAVES;
    bf16_t* P = (bf16_t*)(ws + WS_P); const float* SIDE = (const float*)(ws + WS_SIDE); bf16_t* KR = (bf16_t*)(ws + WS_KR);
    const float* cosT = (const float*)(ws + WS_ROPE); const float* sinT = cosT + SEQ * 32;
    const float* gq = A.in(9) + l * 512; const float* gkv = A.in(10) + l * 256;
    for (int r = gw; r < NTOK; r += NGW) {
        bf16_t* pr = P + (size_t)r * PW;
        { const u32x4 w = *(const u32x4*)(pr + P_CQ + lane * 8); float x[8] = {bflo(w.x), bfhi(w.x), bflo(w.y), bfhi(w.y), bflo(w.z), bfhi(w.z), bflo(w.w), bfhi(w.w)};
          float ss = 0.f;
#pragma unroll
          for (int j = 0; j < 8; ++j) ss += x[j] * x[j];
          ss = wave_sum(ss); const float rstd = 1.0f / sqrtf(ss * (1.0f / 512.f) + EPS);
          const f32x4 g0 = *(const f32x4*)(gq + lane * 8), g1 = *(const f32x4*)(gq + lane * 8 + 4);
          u32x4 o; o.x = cvt_pk(x[0] * rstd * g0.x, x[1] * rstd * g0.y); o.y = cvt_pk(x[2] * rstd * g0.z, x[3] * rstd * g0.w); o.z = cvt_pk(x[4] * rstd * g1.x, x[5] * rstd * g1.y); o.w = cvt_pk(x[6] * rstd * g1.z, x[7] * rstd * g1.w);
          *(u32x4*)(pr + P_CQ + lane * 8) = o; }
        { const u32x2 w = *(const u32x2*)(pr + P_CKV + lane * 4); float x[4] = {bflo(w.x), bfhi(w.x), bflo(w.y), bfhi(w.y)};
          float ss = x[0] * x[0] + x[1] * x[1] + x[2] * x[2] + x[3] * x[3];
          ss = wave_sum(ss); const float rstd = 1.0f / sqrtf(ss * (1.0f / 256.f) + EPS);
          const f32x4 g0 = *(const f32x4*)(gkv + lane * 4);
          u32x2 o; o.x = cvt_pk(x[0] * rstd * g0.x, x[1] * rstd * g0.y); o.y = cvt_pk(x[2] * rstd * g0.z, x[3] * rstd * g0.w);
          *(u32x2*)(pr + P_CKV + lane * 4) = o; }
        if (lane < 32) { const float x1 = SIDE[(size_t)r * SIDEW + lane], x2 = SIDE[(size_t)r * SIDEW + 32 + lane];
          const int b = r / RPB, t = r - b * RPB - CTX; float y1 = x1, y2 = x2;
          if (t >= 0) { const float cs = cosT[(size_t)t * 32 + lane], sn = sinT[(size_t)t * 32 + lane]; y1 = x1 * cs - x2 * sn; y2 = x1 * sn + x2 * cs; }
          *(unsigned*)(KR + (size_t)r * 64 + 2 * lane) = cvt_pk(y1, y2); }
    }
}

constexpr int G1_LR = 0, G1_WG = 8192, G1_BG = 24576, G1_GT = 25600, G1_QD = 29696, G1_KD = G1_QD + 64 * 272, G1_KET = G1_KD + 64 * 272, G1_VT = G1_KET + 128 * 144, G1_AS = G1_VT + 256 * 144, G1_END = G1_AS + 64 * 144;
constexpr int G1_RAWV = G1_QD;
constexpr int G1_RAW = G1_END;
static_assert(G1_RAWV + 32768 <= G1_VT && G1_RAW + 32768 <= LDS_CTL_OFF, "G1 LDS map");

__device__ __forceinline__ void g1_mma(LAS unsigned char* L, f32x16& Aacc, const bf16x8 (&av)[4], bf16_t* dsp, int lane, int wave) {
    const int r32 = lane & 31, hi = lane >> 5;
    if (wave < 4) { const int mb = wave >> 1, nb = wave & 1;
#pragma unroll
        for (int r = 0; r < 16; ++r) Aacc[r] = 0.f;
#pragma unroll
        for (int ks = 0; ks < 8; ++ks) { const bf16x8 a = *(const LAS bf16x8*)(L + G1_QD + (32 * mb + r32) * 272 + ks * 32 + hi * 16), bq = *(const LAS bf16x8*)(L + G1_KD + (32 * nb + r32) * 272 + ks * 32 + hi * 16);
            Aacc = __builtin_amdgcn_mfma_f32_32x32x16_bf16(a, bq, Aacc, 0, 0, 0); } }
#pragma unroll
    for (int db = 0; db < 4; ++db) { f32x16 acc;
#pragma unroll
        for (int r = 0; r < 16; ++r) acc[r] = 0.f;
#pragma unroll
        for (int ks = 0; ks < 4; ++ks) { const bf16x8 bk = *(const LAS bf16x8*)(L + G1_KET + (32 * db + r32) * 144 + ks * 32 + hi * 16); acc = __builtin_amdgcn_mfma_f32_32x32x16_bf16(av[ks], bk, acc, 0, 0, 0); }
        LAS unsigned char* slab = L + G1_RAW + wave * 4096;
#pragma unroll
        for (int r = 0; r < 16; r += 2) {
            const float x0 = acc[r], x1 = acc[r + 1];
            const float n0 = __builtin_bit_cast(float, __builtin_amdgcn_mov_dpp(__builtin_bit_cast(int, x0), 0xB1, 0xF, 0xF, true)), n1 = __builtin_bit_cast(float, __builtin_amdgcn_mov_dpp(__builtin_bit_cast(int, x1), 0xB1, 0xF, 0xF, true));
            const bool odd = r32 & 1;
            const unsigned pk = odd ? cvt_pk_safe(n1, x1) : cvt_pk_safe(x0, n0);
            *(LAS unsigned*)(slab + crow(r + (odd ? 1 : 0), hi) * 128 + (db & 1) * 64 + (r32 >> 1) * 4) = pk; }
        if (db & 1) {
#pragma unroll
            for (int i = 0; i < 4; ++i) { const int idx = lane + 64 * i, row = idx >> 3, ch = idx & 7;
                *(u32x4*)(dsp + (size_t)(32 * wave + row) * 128 + (db >> 1) * 64 + ch * 8) = *(const LAS u32x4*)(slab + row * 128 + ch * 16); } } }
}

template <int DIR>
__device__ __forceinline__ void g1_dir(const Ptrs& A, unsigned char* ws, LAS unsigned char* L, int l, int u, int bh, int c, int h, int r0, f32x16& Aacc, const bf16x8 (&av)[4], const float (&qv)[16], const float (&kv)[16], int tid, int lane, int wave) {
    LAS float* lr = (LAS float*)(L + G1_LR); LAS float* wg = (LAS float*)(L + G1_WG); LAS float* bg = (LAS float*)(L + G1_BG); LAS float* gt = (LAS float*)(L + G1_GT);
    const int d = tid & 127, pg = tid >> 7;
    float cum[16];
    {
        float wv[16];
#pragma unroll
        for (int rr = 0; rr < 16; ++rr) wv[rr] = wg[(DIR * 16 + rr) * 128 + d];
        const float bias = bg[DIR * 128 + d];
#pragma unroll
        for (int i = 0; i < 16; ++i) { const LAS float* lp = lr + (DIR * 64 + pg * 16 + i) * 16; float z = bias;
#pragma unroll
            for (int rr = 0; rr < 16; ++rr) z += lp[rr] * wv[rr];
            cum[i] = -(fmaxf(-z, 0.f) + __logf(1.0f + __expf(-fabsf(z)))) * (1.0f / 16.0f); }
    }
    if (DIR == 0) {
#pragma unroll
        for (int i = 1; i < 16; ++i) cum[i] += cum[i - 1];
        gt[(DIR * 4 + pg) * 128 + d] = cum[15];
    } else {
#pragma unroll
        for (int i = 14; i >= 0; --i) cum[i] += cum[i + 1];
        gt[(DIR * 4 + pg) * 128 + d] = cum[0];
    }
    __syncthreads();
    float off = 0.f, last = 0.f;
#pragma unroll
    for (int g = 0; g < 4; ++g) { const float t = gt[(DIR * 4 + g) * 128 + d]; last += t; if (DIR == 0 ? (g < pg) : (g > pg)) off += t; }
    bf16_t* qdec = (bf16_t*)(ws + WS_QDEC) + ((size_t)u * 2 + DIR) * 8192;
    const float elast = __expf(last);
    unsigned ke[8];
#pragma unroll
    for (int i = 0; i < 16; i += 2) {
        const int p = pg * 16 + i;
        const float q0 = qv[i], q1 = qv[i + 1], k0 = kv[i], k1 = kv[i + 1];
        const float c0 = cum[i] + off, c1 = cum[i + 1] + off;
        const float e0 = __expf(c0), e1 = __expf(c1), n0 = __expf(-c0), n1 = __expf(-c1);
        const bf16_t qa = f2bf(q0 * e0), qb = f2bf(q1 * e1);
        *(LAS bf16_t*)(L + G1_QD + p * 272 + d * 2) = qa; *(LAS bf16_t*)(L + G1_QD + (p + 1) * 272 + d * 2) = qb;
        *(LAS bf16_t*)(L + G1_KD + p * 272 + d * 2) = f2bf(k0 * n0); *(LAS bf16_t*)(L + G1_KD + (p + 1) * 272 + d * 2) = f2bf(k1 * n1);
        ke[i >> 1] = cvt_pk(k0 * n0 * elast, k1 * n1 * elast);
    }
    *(LAS u32x4*)(L + G1_KET + d * 144 + pg * 32) = (u32x4){ke[0], ke[1], ke[2], ke[3]};
    *(LAS u32x4*)(L + G1_KET + d * 144 + pg * 32 + 16) = (u32x4){ke[4], ke[5], ke[6], ke[7]};
    if (pg == 0) ((float*)(ws + WS_DEC))[((size_t)(DIR * 16 + bh) * NCH + c) * 128 + d] = elast;
    __syncthreads();
#pragma unroll
    for (int i = 0; i < 2; ++i) { const int idx = tid + 512 * i, row = idx >> 4, ch = idx & 15;
        *(u32x4*)(qdec + row * 128 + ch * 8) = *(const LAS u32x4*)(L + G1_QD + row * 272 + ch * 16); }
    g1_mma(L, Aacc, av, (bf16_t*)(ws + WS_DS) + ((size_t)(DIR * 16 + bh) * NCH + c) * 32768, lane, wave);
}

__device__ __forceinline__ void gla_g1(const Ptrs& A, LAS unsigned char* L, int l, int u, int wave) { asm volatile("" : "+s"(wave)); const int lane = lane_id(); const int tid = wave * 64 + lane; (void)tid;
    unsigned char* ws = A.ws(); LAUNDER_G(ws);
    const int bh = u / NCH, c = u - bh * NCH, b = bh >> 2, h = bh & 3, r0 = b * RPB + c * 64;
    const bf16_t* P = (const bf16_t*)(ws + WS_P); const float* SIDE = (const float*)(ws + WS_SIDE);
    LAS float* lr = (LAS float*)(L + G1_LR); LAS float* wg = (LAS float*)(L + G1_WG); LAS float* bg = (LAS float*)(L + G1_BG);
    { const int p = tid >> 3, q = tid & 7, dir = q >> 2, rr4 = (q & 3) * 4;
      *(LAS f32x4*)(lr + (dir * 64 + p) * 16 + rr4) = *(const f32x4*)(SIDE + (size_t)(r0 + p) * SIDEW + 64 + dir * 16 + rr4); }
#pragma unroll
    for (int i = 0; i < 2; ++i) { const int idx = (tid * 2 + i) * 4, dir = idx >> 11, rr = (idx >> 7) & 15, d4 = idx & 127;
      *(LAS f32x4*)(wg + idx) = *(const f32x4*)(A.in(13) + ((size_t)(l * 2 + dir) * 16 + rr) * 512 + h * 128 + d4); }
    if (tid < 256) bg[tid] = A.in(14)[(l * 2 + (tid >> 7)) * 512 + h * 128 + (tid & 127)];
#pragma unroll
    for (int i = 0; i < 2; ++i) { const int idx = tid + 512 * i, row = idx >> 4, ch = idx & 15; const bf16_t* src = P + (size_t)(r0 + row) * PW + h * 128 + ch * 8;
        *(LAS u32x4*)(L + G1_RAW + row * 256 + ch * 16) = *(const u32x4*)(src + P_GQ); *(LAS u32x4*)(L + G1_RAW + 16384 + row * 256 + ch * 16) = *(const u32x4*)(src + P_GK); }
#pragma unroll
    for (int i = 0; i < 4; ++i) { const int idx = tid + 512 * i, row = idx >> 5, ch = idx & 31;
        *(LAS u32x4*)(L + G1_RAWV + row * 512 + ch * 16) = *(const u32x4*)(P + (size_t)(r0 + row) * PW + P_GV + h * 256 + ch * 8); }
    __syncthreads();
    float qv[16], kv[16];
#pragma unroll
    for (int i = 0; i < 16; ++i) { const int off = ((tid >> 7) * 16 + i) * 256 + (tid & 127) * 2; qv[i] = bf2f(*(const LAS bf16_t*)(L + G1_RAW + off)) * 0.08838834764831845f; kv[i] = bf2f(*(const LAS bf16_t*)(L + G1_RAW + 16384 + off)); }
    { const int e = tid & 255, ph = tid >> 8;
      unsigned w[16];
#pragma unroll
      for (int i = 0; i < 16; ++i) w[i] = (unsigned)*(const LAS bf16_t*)(L + G1_RAWV + (ph * 32 + 2 * i) * 512 + e * 2) | ((unsigned)*(const LAS bf16_t*)(L + G1_RAWV + (ph * 32 + 2 * i + 1) * 512 + e * 2) << 16);
#pragma unroll
      for (int i = 0; i < 4; ++i) *(LAS u32x4*)(L + G1_VT + e * 144 + ph * 64 + i * 16) = (u32x4){w[4 * i], w[4 * i + 1], w[4 * i + 2], w[4 * i + 3]}; }
    __syncthreads();
    const int r32 = lane & 31, hi = lane >> 5;
    bf16x8 av[4];
#pragma unroll
    for (int ks = 0; ks < 4; ++ks) av[ks] = *(const LAS bf16x8*)(L + G1_VT + (32 * wave + r32) * 144 + ks * 32 + hi * 16);
    f32x16 Af, Ab;
    g1_dir<0>(A, ws, L, l, u, bh, c, h, r0, Af, av, qv, kv, tid, lane, wave);
    __syncthreads();
    g1_dir<1>(A, ws, L, l, u, bh, c, h, r0, Ab, av, qv, kv, tid, lane, wave);
    if (wave < 4) { const int mb = wave >> 1, nb = wave & 1;
#pragma unroll
        for (int r = 0; r < 16; ++r) { const int cc = 32 * mb + crow(r, hi), jj = 32 * nb + r32; const float v = (jj <= cc ? Af[r] : 0.f) + (jj >= cc ? Ab[r] : 0.f);
            *(LAS bf16_t*)(L + G1_AS + cc * 144 + jj * 2) = f2bf(v); } }
    __syncthreads();
    float* OI = (float*)(ws + WS_OINTRA);
#pragma unroll
    for (int mb = 0; mb < 2; ++mb) { f32x16 acc;
#pragma unroll
        for (int r = 0; r < 16; ++r) acc[r] = 0.f;
#pragma unroll
        for (int ks = 0; ks < 4; ++ks) { const bf16x8 a = *(const LAS bf16x8*)(L + G1_AS + (32 * mb + r32) * 144 + ks * 32 + hi * 16); acc = __builtin_amdgcn_mfma_f32_32x32x16_bf16(a, av[ks], acc, 0, 0, 0); }
        float* op = OI + (size_t)(r0 + 32 * mb) * 1024 + h * 256 + 32 * wave + r32;
#pragma unroll
        for (int r = 0; r < 16; ++r) op[(size_t)crow(r, hi) * 1024] = acc[r]; }
    __syncthreads();
}

__device__ __forceinline__ void gla_g2(const Ptrs& A, int wave, int bid, int G) { const int tid = wave * 64 + lane_id();
    unsigned char* ws = A.ws(); LAUNDER_G(ws); const bf16_t* DS = (const bf16_t*)(ws + WS_DS); const float* DEC = (const float*)(ws + WS_DEC); bf16_t* SENT = (bf16_t*)(ws + WS_SENT);
    const int NT = G * NTHR;
    for (int it = bid * NTHR + tid; it < 2 * 16 * 256 * 16; it += NT) {
        const int d8 = it & 15, e = (it >> 4) & 255, db = it >> 12;
        const int dir = db >> 4;
        const size_t base = (size_t)db * NCH * 32768 + (size_t)e * 128 + d8 * 8, dbase = (size_t)db * NCH * 128 + d8 * 8;
        f32x4 s0 = (f32x4){0.f, 0.f, 0.f, 0.f}, s1 = (f32x4){0.f, 0.f, 0.f, 0.f};
#pragma unroll 4
        for (int st = 0; st < NCH; ++st) { const int c = dir == 0 ? st : (st < 4 ? 3 - st : NCH + 3 - st);
            const u32x4 dw = *(const u32x4*)(DS + base + (size_t)c * 32768); const f32x4 dc0 = *(const f32x4*)(DEC + dbase + (size_t)c * 128), dc1 = *(const f32x4*)(DEC + dbase + (size_t)c * 128 + 4);
            const unsigned w0 = dw.x, w1 = dw.y, w2 = dw.z, w3 = dw.w;
            const f32x4 ds0 = (f32x4){bflo(w0), bfhi(w0), bflo(w1), bfhi(w1)}, ds1 = (f32x4){bflo(w2), bfhi(w2), bflo(w3), bfhi(w3)};
            u32x4 o; o.x = cvt_pk(s0.x, s0.y); o.y = cvt_pk(s0.z, s0.w); o.z = cvt_pk(s1.x, s1.y); o.w = cvt_pk(s1.z, s1.w); *(u32x4*)(SENT + base + (size_t)c * 32768) = o;
            s0 = dc0 * s0 + ds0; s1 = dc1 * s1 + ds1; }
    }
}

constexpr int G3_A = 0, G3_OUT = 32768, G3_ROWB = 528, G3_GG = G3_OUT + 64 * G3_ROWB, G3_SSQ = G3_GG + 64 * G3_ROWB, G3_RSTD = G3_SSQ + 2048, G3_END = G3_RSTD + 256;
static_assert(G3_END <= LDS_CTL_OFF, "G3 LDS map");
__device__ __forceinline__ void gla_g3(const Ptrs& A, LAS unsigned char* L, int l, int u, int wave) { asm volatile("" : "+s"(wave)); const int lane = lane_id(); const int tid = wave * 64 + lane;
    unsigned char* ws = A.ws(); LAUNDER_G(ws);
    const int bh = u / NCH, c = u - bh * NCH, b = bh >> 2, h = bh & 3, r0 = b * RPB + c * 64, r32 = lane & 31, hi = lane >> 5;
    const bf16_t* qa = (const bf16_t*)(ws + WS_QDEC) + (size_t)u * 2 * 8192; const bf16_t* SENT = (const bf16_t*)(ws + WS_SENT);
    const bf16_t* P = (const bf16_t*)(ws + WS_P); bf16_t* MIX = (bf16_t*)(ws + WS_MIX);
#pragma unroll
    for (int i = 0; i < 4; ++i) { const int idx = tid + 512 * i, dir = idx >> 10, rem = idx & 1023, row = rem >> 4, cc = rem & 15;
        *(LAS u32x4*)(L + G3_A + dir * 16384 + row * 256 + ((cc ^ (row & 15)) << 4)) = *(const u32x4*)(qa + dir * 8192 + row * 128 + cc * 8);
        const int grow = idx >> 5, gch = idx & 31;
        *(LAS u32x4*)(L + G3_GG + grow * G3_ROWB + gch * 16) = *(const u32x4*)(P + (size_t)(r0 + grow) * PW + P_GG + h * 256 + gch * 8); }
    bf16x8 bb[16];
#pragma unroll
    for (int ks = 0; ks < 16; ++ks) { const int dir = ks >> 3, kk = (ks & 7) * 16 + 8 * hi;
        bb[ks] = *(const bf16x8*)(SENT + ((size_t)(dir * 16 + bh) * NCH + c) * 32768 + (size_t)(32 * wave + r32) * 128 + kk); }
    float v[32];
    { const float* oi = (const float*)(ws + WS_OINTRA) + (size_t)r0 * 1024 + h * 256 + 32 * wave + r32;
#pragma unroll
      for (int r = 0; r < 16; ++r) { v[r] = oi[(size_t)crow(r, hi) * 1024]; v[16 + r] = oi[(size_t)(32 + crow(r, hi)) * 1024]; } }
    __syncthreads();
    f32x16 acc0, acc1;
#pragma unroll
    for (int r = 0; r < 16; ++r) { acc0[r] = 0.f; acc1[r] = 0.f; }
#pragma unroll
    for (int ks = 0; ks < 16; ++ks) { const int dir = ks >> 3, cc = (ks & 7) * 2 + hi;
        const bf16x8 a0 = *(const LAS bf16x8*)(L + G3_A + dir * 16384 + r32 * 256 + ((cc ^ (r32 & 15)) << 4)), a1 = *(const LAS bf16x8*)(L + G3_A + dir * 16384 + (32 + r32) * 256 + ((cc ^ (r32 & 15)) << 4));
        acc0 = __builtin_amdgcn_mfma_f32_32x32x16_bf16(a0, bb[ks], acc0, 0, 0, 0); acc1 = __builtin_amdgcn_mfma_f32_32x32x16_bf16(a1, bb[ks], acc1, 0, 0, 0); }
#pragma unroll
    for (int r = 0; r < 16; ++r) { v[r] += acc0[r]; v[16 + r] += acc1[r]; }
    {
        float t[32];
#pragma unroll
        for (int q = 0; q < 32; ++q) t[q] = v[q] * v[q];
#pragma unroll
        for (int s_ = 0; s_ < 5; ++s_) { const int half = 16 >> s_; const bool bit = (r32 >> s_) & 1;
#pragma unroll
            for (int i = 0; i < half; ++i) { const float send = bit ? t[i] : t[i + half], keep = bit ? t[i + half] : t[i]; t[i] = keep + shx_f(send, 1 << s_); } }
        const int q = ((r32 & 1) << 4) | ((r32 & 2) << 2) | (r32 & 4) | ((r32 & 8) >> 2) | ((r32 & 16) >> 4);
        const int row = 32 * (q >> 4) + crow(q & 15, hi);
        ((LAS float*)(L + G3_SSQ))[row * 8 + wave] = t[0];
    }
    __syncthreads();
    if (tid < 64) { const f32x4 sa = *(const LAS f32x4*)(L + G3_SSQ + tid * 32), sb = *(const LAS f32x4*)(L + G3_SSQ + tid * 32 + 16);
        ((LAS float*)(L + G3_RSTD))[tid] = 1.0f / sqrtf(((sa.x + sa.y) + (sa.z + sa.w) + (sb.x + sb.y) + (sb.z + sb.w)) * (1.0f / 256.f) + EPS); }
    __syncthreads();
    const float g = A.in(15)[l * 256 + 32 * wave + r32];
#pragma unroll
    for (int q = 0; q < 32; ++q) { const int row = 32 * (q >> 4) + crow(q & 15, hi);
        const float rstd = ((const LAS float*)(L + G3_RSTD))[row];
        const float gg = bf2f(*(const LAS bf16_t*)(L + G3_GG + row * G3_ROWB + (32 * wave + r32) * 2));
        *(LAS bf16_t*)(L + G3_OUT + row * G3_ROWB + (32 * wave + r32) * 2) = f2bf((v[q] * rstd * g) * (gg / (1.f + __expf(-gg)))); }
    __syncthreads();
#pragma unroll
    for (int i = 0; i < 4; ++i) { const int idx = tid + 512 * i, row = idx >> 5, ch = idx & 31;
        *(u32x4*)(MIX + (size_t)(r0 + row) * DM + 1024 + h * 256 + ch * 8) = *(const LAS u32x4*)(L + G3_OUT + row * G3_ROWB + ch * 16); }
    __syncthreads();
}

#ifndef QR_REG
#define QR_REG 1
#endif
namespace att {
constexpr int NW = 8, QBLK = 32, KVBLK = 64;
constexpr float SCALE = 0.07216878364870323f;
constexpr float THR = 8.f;
constexpr int LDQ = 1536, LDKV = 2048, LDKR = 64, LDO = 2048;
constexpr int SHM_V = 16384, SHM_K = 16384, SHM_R = 8192;
constexpr int OFF_V = 0, OFF_K = 2 * SHM_V, OFF_R = OFF_K + 2 * SHM_K, OFF_WS = OFF_R + 2 * SHM_R, OFF_QR = OFF_WS + NW * 64 * 4, LDS_NEED = OFF_QR + NW * 8704;
static_assert(LDS_NEED <= LDS_CTL_OFF, "attention LDS map");
#define KSWZ(row, colB) ((row) * 256 + ((colB) ^ (((row) & 15) << 4)))
#define RSWZ(row, colB) ((row) * 128 + ((colB) ^ ((((row) >> 1) & 7) << 4)))

__device__ __forceinline__ void partialSM(f32x16& p0, f32x16& p1, float& m_reg, float& mn, float& alpha) {
  constexpr float C = SCALE * 1.4426950408889634f;
  float pmax = p0[0];
#pragma unroll
  for (int r = 1; r < 16; ++r) pmax = fmaxf(pmax, p0[r]);
#pragma unroll
  for (int r = 0; r < 16; ++r) pmax = fmaxf(pmax, p1[r]);
  { auto rr = __builtin_amdgcn_permlane32_swap(__float_as_uint(pmax), __float_as_uint(pmax), false, false);
    pmax = fmaxf(__uint_as_float(rr[0]), __uint_as_float(rr[1])); }
  if (__builtin_expect(__all(pmax - m_reg <= THR / SCALE), 1)) { mn = m_reg; alpha = 1.f; }
  else { mn = fmaxf(m_reg, pmax); alpha = __builtin_amdgcn_exp2f((m_reg - mn) * C); m_reg = mn; }
  const float mnC = -mn * C;
#pragma unroll
  for (int r = 0; r < 16; ++r) p0[r] = fmaf(p0[r], C, mnC);
#pragma unroll
  for (int r = 0; r < 16; ++r) p1[r] = fmaf(p1[r], C, mnC);
#pragma unroll
  for (int r = 0; r < 16; ++r) p0[r] = __builtin_amdgcn_exp2f(p0[r]);
}
__device__ __forceinline__ void finishSM(f32x16& p0, f32x16& p1, float alpha, float& l_reg, bf16x8& pa0, bf16x8& pa1, bf16x8& pa2, bf16x8& pa3) {
#pragma unroll
  for (int r = 0; r < 16; ++r) p1[r] = __builtin_amdgcn_exp2f(p1[r]);
  float ps = 0;
#pragma unroll
  for (int r = 0; r < 16; ++r) ps += p0[r];
#pragma unroll
  for (int r = 0; r < 16; ++r) ps += p1[r];
  { auto rr = __builtin_amdgcn_permlane32_swap(__float_as_uint(ps), __float_as_uint(ps), false, false);
    ps = __uint_as_float(rr[0]) + __uint_as_float(rr[1]); }
  l_reg = l_reg * alpha + ps;
#define PK4(P, BASE, OUT) do { unsigned a0 = cvt_pk_asm(P[BASE + 0], P[BASE + 1]), a1 = cvt_pk_asm(P[BASE + 2], P[BASE + 3]);   \
    unsigned b0 = cvt_pk_asm(P[BASE + 4], P[BASE + 5]), b1 = cvt_pk_asm(P[BASE + 6], P[BASE + 7]);                              \
    auto r0 = __builtin_amdgcn_permlane32_swap(a0, b0, false, false); auto r1 = __builtin_amdgcn_permlane32_swap(a1, b1, false, false); \
    u32x4 w = {r0[0], r1[0], r0[1], r1[1]}; OUT = __builtin_bit_cast(bf16x8, w); } while (0)
  PK4(p0, 0, pa0); PK4(p0, 8, pa1); PK4(p1, 0, pa2); PK4(p1, 8, pa3);
#undef PK4
}
__device__ __forceinline__ void qkt(f32x16& p0, f32x16& p1, const LAS unsigned char* Ks, const LAS unsigned char* Rs, const bf16x8 (&qr)[8], const bf16x8 (&qrr)[4], const LAS unsigned char* QRl, int r32, int hi) {
#pragma unroll
  for (int r = 0; r < 16; ++r) { p0[r] = 0.f; p1[r] = 0.f; }
#pragma unroll
  for (int d0 = 0; d0 < 8; ++d0) { const int cb = d0 * 32 + hi * 16;
    const bf16x8 b0 = *(const LAS bf16x8*)(Ks + KSWZ(r32, cb)), b1 = *(const LAS bf16x8*)(Ks + KSWZ(32 + r32, cb));
    p0 = __builtin_amdgcn_mfma_f32_32x32x16_bf16(b0, qr[d0], p0, 0, 0, 0);
    p1 = __builtin_amdgcn_mfma_f32_32x32x16_bf16(b1, qr[d0], p1, 0, 0, 0); }
#pragma unroll
  for (int d0 = 0; d0 < 4; ++d0) { const int cb = d0 * 32 + hi * 16;
    const bf16x8 b0 = *(const LAS bf16x8*)(Rs + RSWZ(r32, cb)), b1 = *(const LAS bf16x8*)(Rs + RSWZ(32 + r32, cb));
#if QR_REG
    const bf16x8 qq = qrr[d0];
#else
    const bf16x8 qq = *(const LAS bf16x8*)(QRl + d0 * 1024);
#endif
    p0 = __builtin_amdgcn_mfma_f32_32x32x16_bf16(b0, qq, p0, 0, 0, 0);
    p1 = __builtin_amdgcn_mfma_f32_32x32x16_bf16(b1, qq, p1, 0, 0, 0); }
}
__device__ __forceinline__ int v_st(int k, int c) { const int kk = (k & ~0xC) | ((k & 4) << 1) | ((k & 8) >> 1); return ((kk >> 3) * 4 + (c >> 5)) * 512 + ((kk & 7) * 32 + (c & 31)) * 2; }
__device__ __forceinline__ int v_rd_base(int lane) { return ((lane & 3) << 3) | (((lane >> 2) & 3) << 6) | (((lane >> 4) & 1) << 5) | (((lane >> 5) & 1) << 8); }
constexpr int v_rd_off(int d0, int ks, int half) { return d0 * 512 + ks * 4096 + half * 2048; }
template <int OFF> __device__ __forceinline__ s16x4 tr_read(int vb) {
  s16x4 r; asm volatile("ds_read_b64_tr_b16 %0, %1 offset:%2" : "=&v"(r) : "v"(vb), "i"(OFF) : "memory"); return r;
}
template <int D0> __device__ __forceinline__ void pv_one(f32x16& od, int vb, bf16x8 pa0, bf16x8 pa1, bf16x8 pa2, bf16x8 pa3) {
  const s16x4 l0 = tr_read<v_rd_off(D0, 0, 0)>(vb), h0 = tr_read<v_rd_off(D0, 0, 1)>(vb), l1 = tr_read<v_rd_off(D0, 1, 0)>(vb), h1 = tr_read<v_rd_off(D0, 1, 1)>(vb);
  const s16x4 l2 = tr_read<v_rd_off(D0, 2, 0)>(vb), h2 = tr_read<v_rd_off(D0, 2, 1)>(vb), l3 = tr_read<v_rd_off(D0, 3, 0)>(vb), h3 = tr_read<v_rd_off(D0, 3, 1)>(vb);
  asm volatile("s_waitcnt lgkmcnt(0)" ::: "memory"); SBAR();
#define PKV(L_, H_) (bf16x8){L_[0], L_[1], L_[2], L_[3], H_[0], H_[1], H_[2], H_[3]}
  od = __builtin_amdgcn_mfma_f32_32x32x16_bf16(pa0, PKV(l0, h0), od, 0, 0, 0);
  od = __builtin_amdgcn_mfma_f32_32x32x16_bf16(pa1, PKV(l1, h1), od, 0, 0, 0);
  od = __builtin_amdgcn_mfma_f32_32x32x16_bf16(pa2, PKV(l2, h2), od, 0, 0, 0);
  od = __builtin_amdgcn_mfma_f32_32x32x16_bf16(pa3, PKV(l3, h3), od, 0, 0, 0);
#undef PKV
}
__device__ __forceinline__ void pv_d0(f32x16 (&o)[4], int vb, bf16x8 pa0, bf16x8 pa1, bf16x8 pa2, bf16x8 pa3) {
  pv_one<0>(o[0], vb, pa0, pa1, pa2, pa3); pv_one<1>(o[1], vb, pa0, pa1, pa2, pa3); pv_one<2>(o[2], vb, pa0, pa1, pa2, pa3); pv_one<3>(o[3], vb, pa0, pa1, pa2, pa3);
}

__device__ __forceinline__ void attn_unit(const bf16_t* __restrict__ Qb, const bf16_t* __restrict__ Kn, const bf16_t* __restrict__ Kr, const bf16_t* __restrict__ Vh,
                                          bf16_t* __restrict__ Ob, int nkeys, LAS unsigned char* lds, int wid) {
  asm volatile("" : "+s"(wid));
  const int lane = lane_id(), tid = wid * 64 + lane, r32 = lane & 31, hi = lane >> 5;
  LAS unsigned char* V_lds = lds + OFF_V; LAS unsigned char* K_lds = lds + OFF_K; LAS unsigned char* R_lds = lds + OFF_R;
  LAS float* wsf = (LAS float*)(lds + OFF_WS) + wid * 64; LAS float* li_l = wsf; LAS float* al_l = wsf + 32;
  float m_reg = -1e30f, l_reg = 0.f; f32x16 o[4]; bf16x8 qr[8];
  LAS unsigned char* QRl = lds + OFF_QR + wid * 4096 + lane * 16;
#pragma unroll
  for (int d = 0; d < 4; ++d)
#pragma unroll
    for (int r = 0; r < 16; ++r) o[d][r] = 0.f;
  const bf16_t* Qw = Qb + (size_t)(wid * QBLK + r32) * LDQ + hi * 8;
#pragma unroll
  for (int d0 = 0; d0 < 8; ++d0) qr[d0] = *(const bf16x8*)(Qw + d0 * 16);
  bf16x8 qrr[4];
#pragma unroll
  for (int d0 = 0; d0 < 4; ++d0) { qrr[d0] = *(const bf16x8*)(Qw + (8 + d0) * 16);
#if !QR_REG
    *(LAS bf16x8*)(QRl + d0 * 1024) = qrr[d0];
#endif
  }
  const int sr = tid >> 4, sc = (tid & 15) * 8, vst0 = v_st(sr, sc), vst1 = v_st(32 + sr, sc);
  const int rr_ = tid >> 3, rc_ = (tid & 7) * 8;
  const int vb0 = (int)(unsigned)(uintptr_t)V_lds + v_rd_base(lane);
  bf16x8 vs0, vs1, ks0, ks1, rs0;
#define SLOAD(k0) do { vs0 = *(const bf16x8*)(Vh + (size_t)((k0) + sr) * LDKV + sc); vs1 = *(const bf16x8*)(Vh + (size_t)((k0) + 32 + sr) * LDKV + sc); \
    ks0 = *(const bf16x8*)(Kn + (size_t)((k0) + sr) * LDKV + sc); ks1 = *(const bf16x8*)(Kn + (size_t)((k0) + 32 + sr) * LDKV + sc); \
    rs0 = *(const bf16x8*)(Kr + (size_t)((k0) + rr_) * LDKR + rc_); } while (0)
#define SWRITE(b) do { *(LAS bf16x8*)(V_lds + (b) * SHM_V + vst0) = vs0; *(LAS bf16x8*)(V_lds + (b) * SHM_V + vst1) = vs1; const int kc = sc * 2; \
    *(LAS bf16x8*)(K_lds + (b) * SHM_K + KSWZ(sr, kc)) = ks0; *(LAS bf16x8*)(K_lds + (b) * SHM_K + KSWZ(32 + sr, kc)) = ks1; \
    *(LAS bf16x8*)(R_lds + (b) * SHM_R + RSWZ(rr_, rc_ * 2)) = rs0; } while (0)
#define SWAIT() asm volatile("s_waitcnt vmcnt(0)" ::: "memory")
#define RESC(a) do { if (__any((a) < 1.f)) { if (hi == 0) al_l[r32] = (a); asm volatile("s_waitcnt lgkmcnt(0)" ::: "memory"); \
    _Pragma("unroll") for (int d = 0; d < 4; ++d) _Pragma("unroll") for (int r = 0; r < 16; ++r) o[d][r] *= al_l[crow(r, hi)]; } } while (0)
  f32x16 pA0, pA1, pB0, pB1; float mnA, mnB, alA, alB; bf16x8 pa0, pa1, pa2, pa3; const int NT = nkeys / KVBLK;
  SLOAD(0); SWAIT(); SWRITE(0); __syncthreads();
  qkt(pA0, pA1, K_lds, R_lds, qr, qrr, QRl, r32, hi); partialSM(pA0, pA1, m_reg, mnA, alA);
  SLOAD(KVBLK);
  SWAIT(); SWRITE(1); __syncthreads();
  for (int j = 1; j + 1 < NT; j += 2) {
    SBAR(); qkt(pB0, pB1, K_lds + SHM_K, R_lds + SHM_R, qr, qrr, QRl, r32, hi);
    finishSM(pA0, pA1, alA, l_reg, pa0, pa1, pa2, pa3); SBAR();
    SLOAD((j + 1) * KVBLK); SBAR();
    pv_d0(o, vb0, pa0, pa1, pa2, pa3); partialSM(pB0, pB1, m_reg, mnB, alB);
    __syncthreads(); SWAIT(); SWRITE(0);
    RESC(alB); __syncthreads();
    SBAR(); qkt(pA0, pA1, K_lds, R_lds, qr, qrr, QRl, r32, hi);
    finishSM(pB0, pB1, alB, l_reg, pa0, pa1, pa2, pa3); SBAR();
    SLOAD((j + 2) * KVBLK); SBAR();
    pv_d0(o, vb0 + SHM_V, pa0, pa1, pa2, pa3); partialSM(pA0, pA1, m_reg, mnA, alA);
    __syncthreads(); SWAIT(); SWRITE(1);
    RESC(alA); __syncthreads();
  }
  SBAR(); qkt(pB0, pB1, K_lds + SHM_K, R_lds + SHM_R, qr, qrr, QRl, r32, hi);
  finishSM(pA0, pA1, alA, l_reg, pa0, pa1, pa2, pa3); SBAR();
  pv_d0(o, vb0, pa0, pa1, pa2, pa3); partialSM(pB0, pB1, m_reg, mnB, alB);
  __syncthreads(); RESC(alB);
  finishSM(pB0, pB1, alB, l_reg, pa0, pa1, pa2, pa3); SBAR();
  pv_d0(o, vb0 + SHM_V, pa0, pa1, pa2, pa3);
  if (hi == 0) li_l[r32] = l_reg; asm volatile("s_waitcnt lgkmcnt(0)" ::: "memory");
  float rli[16];
#pragma unroll
  for (int r = 0; r < 16; ++r) rli[r] = __builtin_amdgcn_rcpf(li_l[crow(r, hi)]);
  bf16_t* Ow = Ob + (size_t)(wid * QBLK) * LDO;
#if QR_REG
  { LAS unsigned char* slab = lds + OFF_QR + wid * 8704;
#pragma unroll
    for (int r = 0; r < 16; ++r) { const int orow = crow(r, hi);
#pragma unroll
      for (int d0 = 0; d0 < 4; ++d0) *(LAS bf16_t*)(slab + orow * 272 + (d0 * 32 + r32) * 2) = f2bf(o[d0][r] * rli[r]); }
#pragma unroll
    for (int i = 0; i < 8; ++i) { const int idx = lane + 64 * i, row = idx >> 4, ch = idx & 15;
      *(u32x4*)(Ow + (size_t)row * LDO + ch * 8) = *(const LAS u32x4*)(slab + row * 272 + ch * 16); } }
#else
#pragma unroll
  for (int r = 0; r < 16; ++r) { const int orow = crow(r, hi);
#pragma unroll
    for (int d0 = 0; d0 < 4; ++d0) Ow[(size_t)orow * LDO + d0 * 32 + r32] = f2bf(o[d0][r] * rli[r]); }
#endif
  __syncthreads();
#undef SLOAD
#undef SWRITE
#undef SWAIT
#undef RESC
}
}

constexpr int TK_S = 0, TK_SSTR = 260, TK_SBYTES = 64 * TK_SSTR * 4, TK_TV = 2 * TK_SBYTES, TK_TI = TK_TV + 64 * 2 * 16 * 4, TK_TAB = TK_TI + 64 * 2 * 16 * 4, TK_END = TK_TAB + 64 * 4;
static_assert(TK_END <= LDS_CTL_OFF, "topk LDS map");
constexpr int TK_COFF[17] = {0, 16, 24, 29, 33, 36, 38, 40, 42, 43, 44, 45, 46, 47, 48, 49, 50};
__device__ __forceinline__ unsigned f2mono(float f) { const unsigned u = __float_as_uint(f); return (u & 0x80000000u) ? ~u : (u | 0x80000000u); }
template <int N> __device__ __forceinline__ void bitonic_merge_desc(unsigned (&a)[N]) {
#pragma unroll
    for (int d = N >> 1; d > 0; d >>= 1)
#pragma unroll
        for (int i = 0; i < N; ++i) { const int p = i ^ d; if (p > i) { const unsigned lo = a[i] < a[p] ? a[i] : a[p], hi = a[i] < a[p] ? a[p] : a[i]; a[i] = hi; a[p] = lo; } }
}
template <int N> __device__ __forceinline__ void bitonic_sort_desc(unsigned (&a)[N]) {
#pragma unroll
    for (int k = 2; k <= N; k <<= 1)
#pragma unroll
        for (int d = k >> 1; d > 0; d >>= 1)
#pragma unroll
            for (int i = 0; i < N; ++i) { const int p = i ^ d; if (p > i) { const bool desc = ((i & k) == 0) || (k == N); const unsigned lo = a[i] < a[p] ? a[i] : a[p], hi = a[i] < a[p] ? a[p] : a[i]; a[i] = desc ? hi : lo; a[p] = desc ? lo : hi; } }
}
__device__ __forceinline__ void tk_scores(unsigned char* ws, LAS float* S, int l, int u, int half, int kb0, int nkb, int lane) {
    const int tile = u >> 3, h = u & 7, r0 = tile * 64, r32 = lane & 31, hi = lane >> 5;
    const bf16_t* qp = (const bf16_t*)(ws + WS_QP) + (size_t)(r0 + r32) * DM + h * 256 + half * 128 + 8 * hi;
    bf16x8 q0[8], q1[8];
#pragma unroll
    for (int ks = 0; ks < 8; ++ks) { q0[ks] = *(const bf16x8*)(qp + ks * 16); q1[ks] = *(const bf16x8*)(qp + (size_t)32 * DM + ks * 16); }
    for (int kb = kb0; kb < kb0 + nkb; ++kb) {
        const bf16_t* kp = (const bf16_t*)(ws + WS_SUBK) + ((size_t)((l * 2 + half) * 8 + h) * 128 + kb * 32 + r32) * 128 + 8 * hi;
        f32x16 a0, a1;
#pragma unroll
        for (int r = 0; r < 16; ++r) { a0[r] = 0.f; a1[r] = 0.f; }
#pragma unroll
        for (int ks = 0; ks < 8; ++ks) { const bf16x8 kk = *(const bf16x8*)(kp + ks * 16);
            a0 = __builtin_amdgcn_mfma_f32_32x32x16_bf16(q0[ks], kk, a0, 0, 0, 0); a1 = __builtin_amdgcn_mfma_f32_32x32x16_bf16(q1[ks], kk, a1, 0, 0, 0); }
#pragma unroll
        for (int r = 0; r < 16; ++r) { S[crow(r, hi) * TK_SSTR + half * 128 + kb * 32 + r32] = a0[r]; S[(32 + crow(r, hi)) * TK_SSTR + half * 128 + kb * 32 + r32] = a1[r]; }
    }
}
__device__ __forceinline__ void peer_topk_phase(const Ptrs& A, LAS unsigned char* L, int l, int wave, int bid, int G) { asm volatile("" : "+s"(wave));
    unsigned char* ws = A.ws(); LAUNDER_G(ws);
    const int NU = (NTOK / 64) * 8;
    LAS float* TV = (LAS float*)(L + TK_TV); LAS int* TI = (LAS int*)(L + TK_TI); LAS int* TAB = (LAS int*)(L + TK_TAB);
    { const int lane = lane_id(); const int tid = wave * 64 + lane;
      if (bid < NU) tk_scores(ws, (LAS float*)(L + TK_S), l, bid, wave >> 2, wave & 3, 1, lane);
      if (tid < 50) { int row = 0;
#pragma unroll
          for (int i = 1; i < 16; ++i) row = tid >= TK_COFF[i] ? i : row;
          int base = 0;
#pragma unroll
          for (int i = 1; i < 16; ++i) base = row == i ? TK_COFF[i] : base;
          TAB[tid] = row * 16 + (tid - base); } }
    __syncthreads();
    int n = 0;
    for (int u = bid; u < NU; u += G, ++n) {
        const int lane = lane_id(); const int tid = wave * 64 + lane;
        const int tile = u >> 3, h = u & 7, r0 = tile * 64;
        LAS float* S = (LAS float*)(L + TK_S + (n & 1) * TK_SBYTES);
    {
        const int item = tid >> 2, q = tid & 3, tok = item & 63, half = item >> 6;
        unsigned k0[16], k1[16];
#pragma unroll
        for (int j = 0; j < 4; ++j) { const f32x4 x = *(const LAS f32x4*)(S + tok * TK_SSTR + half * 128 + q * 32 + j * 4), y = *(const LAS f32x4*)(S + tok * TK_SSTR + half * 128 + q * 32 + 16 + j * 4);
            const int ib = 127 - (q * 32 + 4 * j);
            k0[4 * j] = (f2mono(x.x) & ~127u) | (unsigned)ib; k0[4 * j + 1] = (f2mono(x.y) & ~127u) | (unsigned)(ib - 1); k0[4 * j + 2] = (f2mono(x.z) & ~127u) | (unsigned)(ib - 2); k0[4 * j + 3] = (f2mono(x.w) & ~127u) | (unsigned)(ib - 3);
            k1[4 * j] = (f2mono(y.x) & ~127u) | (unsigned)(ib - 16); k1[4 * j + 1] = (f2mono(y.y) & ~127u) | (unsigned)(ib - 17); k1[4 * j + 2] = (f2mono(y.z) & ~127u) | (unsigned)(ib - 18); k1[4 * j + 3] = (f2mono(y.w) & ~127u) | (unsigned)(ib - 19); }
        bitonic_sort_desc<16>(k0); bitonic_sort_desc<16>(k1);
#pragma unroll
        for (int i = 0; i < 16; ++i) k0[i] = k0[i] > k1[15 - i] ? k0[i] : k1[15 - i];
        bitonic_merge_desc<16>(k0);
#pragma unroll
        for (int o = 1; o < 4; o <<= 1) {
#pragma unroll
            for (int i = 0; i < 16; ++i) k1[i] = (unsigned)shx_i((int)k0[i], o);
#pragma unroll
            for (int i = 0; i < 16; ++i) k0[i] = k0[i] > k1[15 - i] ? k0[i] : k1[15 - i];
            bitonic_merge_desc<16>(k0); }
#pragma unroll
        for (int i = 0; i < 16; ++i) if ((i >> 2) == q) { const int idx = 127 - (int)(k0[i] & 127u); TI[(tok * 2 + half) * 16 + i] = idx; TV[(tok * 2 + half) * 16 + i] = S[tok * TK_SSTR + half * 128 + idx]; }
    }
    __syncthreads();
        if (wave >= 4) { if (u + G < NU) tk_scores(ws, (LAS float*)(L + TK_S + ((n + 1) & 1) * TK_SBYTES), l, u + G, (wave - 4) >> 1, ((wave - 4) & 1) * 2, 2, lane); }
        else
    {
        const int tok = tid >> 2, q = tid & 3;
        unsigned ck[13];
#pragma unroll
        for (int sl = 0; sl < 13; ++sl) { const int n = 4 * sl + q; unsigned key = 0u;
            if (n < 50) { const int code = TAB[n]; const float sum = TV[(tok * 2) * 16 + (code >> 4)] + TV[(tok * 2 + 1) * 16 + (code & 15)]; key = (f2mono(sum) & ~63u) | (unsigned)(63 - n); }
            ck[sl] = key; }
        unsigned win[4] = {0u, 0u, 0u, 0u};
#pragma unroll
        for (int pass = 0; pass < 16; ++pass) {
            unsigned best = ck[0];
#pragma unroll
            for (int sl = 1; sl < 13; ++sl) best = ck[sl] > best ? ck[sl] : best;
#pragma unroll
            for (int o = 1; o < 4; o <<= 1) { const unsigned ob = (unsigned)shx_i((int)best, o); best = ob > best ? ob : best; }
#pragma unroll
            for (int sl = 0; sl < 13; ++sl) ck[sl] = ck[sl] == best ? 0u : ck[sl];
            if ((pass >> 2) == q) win[pass & 3] = best;
        }
        float sm[4]; int ex_idx[4];
#pragma unroll
        for (int w = 0; w < 4; ++w) { const int n = 63 - (int)(win[w] & 63u); const int code = TAB[n]; const int i = code >> 4, j = code & 15;
            sm[w] = TV[(tok * 2) * 16 + i] + TV[(tok * 2 + 1) * 16 + j]; ex_idx[w] = TI[(tok * 2) * 16 + i] * 128 + TI[(tok * 2 + 1) * 16 + j]; }
        const float mx = DPP_F(sm[0], 0x00);
        float ex[4], den = 0.f;
#pragma unroll
        for (int w = 0; w < 4; ++w) { ex[w] = __expf(sm[w] - mx); den += ex[w]; }
        den += shx_f(den, 1); den += shx_f(den, 2);
        const float inv = 1.0f / den;
        int* IDX = (int*)(ws + WS_IDX) + (size_t)(r0 + tok) * 128 + h * 16 + 4 * q; float* GATE = (float*)(ws + WS_GATE) + (size_t)(r0 + tok) * 128 + h * 16 + 4 * q;
        *(u32x4*)IDX = (u32x4){(unsigned)ex_idx[0], (unsigned)ex_idx[1], (unsigned)ex_idx[2], (unsigned)ex_idx[3]};
        *(f32x4*)GATE = (f32x4){ex[0] * inv, ex[1] * inv, ex[2] * inv, ex[3] * inv};
    }
    __syncthreads();
    }
}

__device__ __forceinline__ float gelu_tanh(float x) { const float y = 0.7978845608028654f * (x + 0.044715f * x * x * x); const float t = 1.f - 2.f * __builtin_amdgcn_rcpf(__expf(2.f * y) + 1.f); return 0.5f * x * (1.f + t); }
#ifndef PEER_NEB
#define PEER_NEB 4
#endif
#ifndef PEER_NEC
#define PEER_NEC 4
#endif
template <int NTK>
__device__ __forceinline__ void peer_tokens(const Ptrs& A, unsigned char* ws, const int (&rows)[NTK], int l, int lane) {
    constexpr int NE = PEER_NEB / NTK, NEC = PEER_NEC / NTK;
    const unsigned char* EU = ws + WS_EU + (size_t)l * NEXP * EROW; const unsigned char* EV = ws + WS_EV + (size_t)l * NEXP * EROW;
    const float* SU = (const float*)(ws + WS_SU) + (size_t)l * NEXP; const float* SV = (const float*)(ws + WS_SV) + (size_t)l * NEXP;
    const float* MOD = (const float*)(ws + WS_MOD);
    int hq[NTK][8]; float hoff[NTK]; float out[NTK][32]; unsigned k_lo[NTK], k_hi[NTK]; float g_lo[NTK], g_hi[NTK], s_lo[NTK], s_hi[NTK];
    { const int lane = lane_id();
#pragma unroll
    for (int t = 0; t < NTK; ++t) { const int r = rows[t];
        const bf16_t* hrow = (const bf16_t*)(ws + WS_H) + (size_t)r * DM;
        u32x2 hb[8]; float am = 0.f;
#pragma unroll
        for (int i = 0; i < 8; ++i) { hb[i] = *(const u32x2*)(hrow + (lane + 64 * i) * 4);
            am = fmaxf(am, fmaxf(fmaxf(fabsf(bflo(hb[i].x)), fabsf(bfhi(hb[i].x))), fmaxf(fabsf(bflo(hb[i].y)), fabsf(bfhi(hb[i].y))))); }
        am = wave_max(am);
        const float hs = am > 0.f ? am * (1.0f / 127.0f) : 1.0f, hinv = 1.0f / hs; int hsum = 0;
#pragma unroll
        for (int i = 0; i < 8; ++i) { const int q0 = (int)rintf(bflo(hb[i].x) * hinv), q1 = (int)rintf(bfhi(hb[i].x) * hinv), q2 = (int)rintf(bflo(hb[i].y) * hinv), q3 = (int)rintf(bfhi(hb[i].y) * hinv);
            hsum += (q0 + q1) + (q2 + q3);
            hq[t][i] = (int)(((unsigned)q0 & 255u) | (((unsigned)q1 & 255u) << 8) | (((unsigned)q2 & 255u) << 16) | ((unsigned)q3 << 24)); }
        hsum = wave_sum_i(hsum);
        hoff[t] = 7.5f * (float)hsum;
        const int* ip = (const int*)(ws + WS_IDX) + (size_t)r * 128; const float* gp = (const float*)(ws + WS_GATE) + (size_t)r * 128;
        const int i_lo = ip[lane], i_hi = ip[64 + lane]; g_lo[t] = gp[lane] * SV[i_lo]; g_hi[t] = gp[64 + lane] * SV[i_hi]; s_lo[t] = SU[i_lo] * hs; s_hi[t] = SU[i_hi] * hs;
        unsigned kl = ((unsigned)i_lo << 7) | (unsigned)lane, kh = ((unsigned)i_hi << 7) | (unsigned)(64 + lane);
#pragma unroll
        for (int k = 2; k <= 128; k <<= 1)
#pragma unroll
            for (int d = k >> 1; d > 0; d >>= 1) {
                if (d == 64) { const unsigned a = kl < kh ? kl : kh, c = kl < kh ? kh : kl; kl = a; kh = c; }
                else { const unsigned o0 = (unsigned)shx_i((int)kl, d), o1 = (unsigned)shx_i((int)kh, d);
                    const bool up0 = k == 128 ? true : (k == 64 ? true : ((lane & k) == 0)), up1 = k == 128 ? true : (k == 64 ? false : ((lane & k) == 0));
                    const bool lowhalf = (lane & d) == 0;
                    const unsigned mn0 = kl < o0 ? kl : o0, mx0 = kl < o0 ? o0 : kl, mn1 = kh < o1 ? kh : o1, mx1 = kh < o1 ? o1 : kh;
                    kl = (lowhalf == up0) ? mn0 : mx0; kh = (lowhalf == up1) ? mn1 : mx1; } }
        k_lo[t] = kl; k_hi[t] = kh;
#pragma unroll
        for (int jj = 0; jj < 32; ++jj) out[t][jj] = 0.f;
    }
    }
    const unsigned l16 = (unsigned)lane_id() * 16u;
    for (int k0 = 0; k0 < 128; k0 += NE) {
        float gt[NTK][NE], su[NTK][NE]; u32x4 ua[NTK][NE], va[NTK][NE];
#pragma unroll
        for (int t = 0; t < NTK; ++t)
#pragma unroll
            for (int k = 0; k < NE; ++k) { const int kk = k0 + k;
                const unsigned key = (unsigned)__builtin_amdgcn_readlane((int)(kk < 64 ? k_lo[t] : k_hi[t]), kk & 63); const int ps = (int)(key & 127u), e = (int)(key >> 7);
                gt[t][k] = __builtin_bit_cast(float, __builtin_amdgcn_readlane(__builtin_bit_cast(int, ps < 64 ? g_lo[t] : g_hi[t]), ps & 63));
                ua[t][k] = *(const u32x4*)((EU + (size_t)e * EROW) + l16); va[t][k] = *(const u32x4*)((EV + (size_t)e * EROW) + l16);
                su[t][k] = __builtin_bit_cast(float, __builtin_amdgcn_readlane(__builtin_bit_cast(int, ps < 64 ? s_lo[t] : s_hi[t]), ps & 63)); }
#pragma unroll
        for (int sub = 0; sub < NE; sub += NEC) {
        int si[NTK][NEC];
#pragma unroll
        for (int t = 0; t < NTK; ++t)
#pragma unroll
            for (int k = 0; k < NEC; ++k) { const u32x4 pa = ua[t][sub + k]; const unsigned pw[4] = {pa.x, pa.y, pa.z, pa.w};
                int a0 = 0, a1 = 0;
#pragma unroll
                for (int w = 0; w < 4; ++w) { a0 = __builtin_amdgcn_sdot4((int)(pw[w] & 0x0F0F0F0Fu), hq[t][2 * w], a0, false); a1 = __builtin_amdgcn_sdot4((int)((pw[w] >> 4) & 0x0F0F0F0Fu), hq[t][2 * w + 1], a1, false); }
                si[t][k] = a0 + a1; }
#define PEER_DPP_STEP(ctrl) _Pragma("unroll") for (int t = 0; t < NTK; ++t) _Pragma("unroll") for (int k = 0; k < NEC; ++k) si[t][k] += __builtin_amdgcn_update_dpp(0, si[t][k], ctrl, 0xF, 0xF, true);
        PEER_DPP_STEP(0xB1) PEER_DPP_STEP(0x4E) PEER_DPP_STEP(0x141) PEER_DPP_STEP(0x140)
#undef PEER_DPP_STEP
#pragma unroll
        for (int t = 0; t < NTK; ++t)
#pragma unroll
            for (int k = 0; k < NEC; ++k) si[t][k] = (__builtin_amdgcn_readlane(si[t][k], 0) + __builtin_amdgcn_readlane(si[t][k], 16)) + (__builtin_amdgcn_readlane(si[t][k], 32) + __builtin_amdgcn_readlane(si[t][k], 48));
#pragma unroll
        for (int t = 0; t < NTK; ++t)
#pragma unroll
            for (int k = 0; k < NEC; ++k) { const float s = ((float)si[t][k] - hoff[t]) * su[t][sub + k];
                const float act = gelu_tanh(s) * gt[t][sub + k];
                const u32x4 pa = va[t][sub + k]; const unsigned pw[4] = {pa.x, pa.y, pa.z, pa.w};
#pragma unroll
                for (int w = 0; w < 4; ++w) {
                    const f32x2 f0 = __builtin_amdgcn_cvt_scalef32_pk_f32_fp4(pw[w], 1.0f, 0), f1 = __builtin_amdgcn_cvt_scalef32_pk_f32_fp4(pw[w], 1.0f, 1), f2 = __builtin_amdgcn_cvt_scalef32_pk_f32_fp4(pw[w], 1.0f, 2), f3 = __builtin_amdgcn_cvt_scalef32_pk_f32_fp4(pw[w], 1.0f, 3);
                    out[t][8 * w + 0] = fmaf(act, f0.x, out[t][8 * w + 0]); out[t][8 * w + 1] = fmaf(act, f0.y, out[t][8 * w + 1]); out[t][8 * w + 2] = fmaf(act, f1.x, out[t][8 * w + 2]); out[t][8 * w + 3] = fmaf(act, f1.y, out[t][8 * w + 3]);
                    out[t][8 * w + 4] = fmaf(act, f2.x, out[t][8 * w + 4]); out[t][8 * w + 5] = fmaf(act, f2.y, out[t][8 * w + 5]); out[t][8 * w + 6] = fmaf(act, f3.x, out[t][8 * w + 6]); out[t][8 * w + 7] = fmaf(act, f3.y, out[t][8 * w + 7]); } }
        __builtin_amdgcn_sched_barrier(0);
        }
    }
    const int lane_e = lane_id();
#pragma unroll
    for (int t = 0; t < NTK; ++t) { const int r = rows[t]; const int b = r / RPB, j = r - b * RPB; const bool isctx = j < CTX;
        float* xrow = (float*)(ws + WS_XRES) + (size_t)r * DM; const int mr = isctx ? 4 : b;
        const float* gf = MOD + ((size_t)l * 5 + mr) * NMOD + 5 * DM;
        float ss = 0.f;
#pragma unroll
        for (int i = 0; i < 8; ++i) { const int col = (lane_e + 64 * i) * 4; const f32x4 g4 = *(const f32x4*)(gf + col); f32x4 x4 = *(const f32x4*)(xrow + col);
            x4.x += g4.x * out[t][4 * i]; x4.y += g4.y * out[t][4 * i + 1]; x4.z += g4.z * out[t][4 * i + 2]; x4.w += g4.w * out[t][4 * i + 3];
            out[t][4 * i] = x4.x; out[t][4 * i + 1] = x4.y; out[t][4 * i + 2] = x4.z; out[t][4 * i + 3] = x4.w;
            ss += (x4.x * x4.x + x4.y * x4.y) + (x4.z * x4.z + x4.w * x4.w); }
        ss = wave_sum(ss); const float rstd = 1.0f / sqrtf(ss * (1.0f / DM) + EPS);
        if (l < DEPTH - 1) {
            const float* mp = MOD + ((size_t)(l + 1) * 5 + mr) * NMOD; const float* gn = A.in(6) + (l + 1) * DM; bf16_t* hw = (bf16_t*)(ws + WS_H) + (size_t)r * DM;
#pragma unroll
            for (int i = 0; i < 8; ++i) { const int col = (lane_e + 64 * i) * 4;
                *(f32x4*)(xrow + col) = (f32x4){out[t][4 * i], out[t][4 * i + 1], out[t][4 * i + 2], out[t][4 * i + 3]};
                const f32x4 g4 = *(const f32x4*)(gn + col), sh = *(const f32x4*)(mp + col), sc = *(const f32x4*)(mp + DM + col);
                *(u32x2*)(hw + col) = (u32x2){cvt_pk((out[t][4 * i] * rstd * g4.x) * (1.f + sc.x) + sh.x, (out[t][4 * i + 1] * rstd * g4.y) * (1.f + sc.y) + sh.y),
                                              cvt_pk((out[t][4 * i + 2] * rstd * g4.z) * (1.f + sc.z) + sh.z, (out[t][4 * i + 3] * rstd * g4.w) * (1.f + sc.w) + sh.w)}; }
        } else {
            float* orow = A.out() + ((size_t)b * SEQ + (j - CTX)) * DM; const float* fg = A.in(21);
#pragma unroll
            for (int i = 0; i < 8; ++i) { const int col = (lane_e + 64 * i) * 4; const f32x4 g4 = *(const f32x4*)(fg + col);
                *(f32x4*)(orow + col) = (f32x4){out[t][4 * i] * rstd * g4.x, out[t][4 * i + 1] * rstd * g4.y, out[t][4 * i + 2] * rstd * g4.z, out[t][4 * i + 3] * rstd * g4.w}; }
        }
    }
}
#ifndef PEER_NTK
#define PEER_NTK 2
#endif
__device__ __forceinline__ void peer_rows(const Ptrs& A, LAS unsigned char* L, unsigned xcc, int l, int wave, int bid, int G) { asm volatile("" : "+s"(wave));
    unsigned char* ws = A.ws(); LAUNDER_G(ws); const int gw = bid + G * wave, NGW = G * NWAVES;
    for (int r = gw; r < NTOK; ) {
        const int lane = lane_id();
        int rr[3] = {-1, -1, -1}; int n = 0;
#pragma unroll
        for (int t = 0; t < PEER_NTK; ++t) { while (r < NTOK && rr[t] < 0) { if (!(l == DEPTH - 1 && (r % RPB) < CTX)) { rr[t] = r; ++n; } r += NGW; } }
        if (n == 0) break;
        if (PEER_NTK >= 3 && n == 3) { const int rows[3] = {rr[0], rr[1], rr[2]}; peer_tokens<3>(A, ws, rows, l, lane); }
        else if (PEER_NTK >= 2 && n >= 2) { const int rows[2] = {rr[0], rr[1]}; peer_tokens<2>(A, ws, rows, l, lane); }
        else { const int rows[1] = {rr[0]}; peer_tokens<1>(A, ws, rows, l, lane); }
    }
}

__device__ __forceinline__ void norm2_rows(const Ptrs& A, int l, int wave, int bid, int G) { asm volatile("" : "+s"(wave)); const int lane = lane_id();
    unsigned char* ws = A.ws(); LAUNDER_G(ws); const int gw = bid + G * wave, NGW = G * NWAVES; const float* MOD = (const float*)(ws + WS_MOD);
    for (int r = gw; r < NTOK; r += NGW) {
        float v[4][8]; row_load_f32((const float*)(ws + WS_XRES) + (size_t)r * DM, lane, v);
        const float rstd = row_rstd(v); const float* mp = MOD + ((size_t)l * 5 + modrow(r)) * NMOD;
        norm_mod_store(v, rstd, A.in(7) + l * DM, mp + 3 * DM, mp + 4 * DM, (bf16_t*)(ws + WS_H) + (size_t)r * DM, lane);
    }
}

constexpr int PH_P0A = 0, PH_P0B = 1, PH_L0 = 2, NPL = 9, N_PHASES = PH_L0 + DEPTH * NPL;
__global__ void __launch_bounds__(NTHR, 2) mk_fwd(Args args) {
    extern __shared__ __attribute__((aligned(16))) unsigned char lds_raw[];
    LAS unsigned char* L = (LAS unsigned char*)lds_raw;
    const int wave = __builtin_amdgcn_readfirstlane(threadIdx.x >> 6), bid = blockIdx.x, G = gridDim.x;
    if (wave == 0) { const int ln = lane_id(); if (ln < 16) ((LAS unsigned*)(L + LDS_CTL_OFF))[ln] = 0u;
        if (ln == 0) { LAS unsigned long long* pt = (LAS unsigned long long*)(L + LDS_CTL_OFF + 64);
#pragma unroll
            for (int i = 0; i < 22; ++i) pt[i] = (unsigned long long)(uintptr_t)args.in[i];
            pt[22] = (unsigned long long)(uintptr_t)args.out; pt[23] = (unsigned long long)(uintptr_t)args.ws; } }
    __syncthreads();
    const Ptrs PT{L};
    unsigned* ctl = (unsigned*)(PT.ws() + WS_CTL);
    XcdBarrier bar; bar.bar = ctl + CW_BAR; bar.x = 0; bar.st = nullptr; bar.wv = (unsigned)wave;
#if !MK_MULTI
    bar = xcd_barrier_post(ctl + CW_BAR, (volatile LAS unsigned*)(L + LDS_CTL_OFF) + 8);
    bar.wv = (unsigned)wave;
#endif
    const int lo = args.ph_lo, hi = args.ph_hi;
#ifndef PH_MASK
#define PH_MASK 0x7ff
#endif
#define PHSEL(n) (((PH_MASK) >> (n)) & 1)
#define IN(k) (lo <= (k) && (k) < hi)
#if MK_MULTI
#define SEAM(k) do { } while (0)
#else
#define SEAM(k) do { if (IN(k) && IN((k) + 1)) xcd_barrier(bar); } while (0)
#endif
    if (PHSEL(0) && IN(PH_P0A)) p0a(PT, L, wave, bid, G);
    SEAM(PH_P0A);
    if (PHSEL(1) && IN(PH_P0B)) p0b(PT, wave, bid, G);
    SEAM(PH_P0B);
    for (int l = 0; l < DEPTH; ++l) {
        const int pb = PH_L0 + l * NPL;
        if (PHSEL(2) && IN(pb + 0)) {
            unsigned char* ws = PT.ws(); LAUNDER_G(ws);
            pg8::Gemm g{(const bf16_t*)(ws + WS_H), (const bf16_t*)(ws + WS_WIN) + (size_t)l * PW * DM, NTOK, PW, DM, DM, DM};
            pg8::StaticOrder S; S.init(NTOK, PW, G, bid);
            pg8::EpiBf16<0> E{(bf16_t*)(ws + WS_P), PW, nullptr, 0, 0, 1.f};
#ifndef DBL_GIN
#define DBL_GIN 1
#endif
            for (int rep = 0; rep < DBL_GIN; ++rep)
            pg8::gemm_phase<pg8::EpiBf16<0>, pg8::StaticOrder, true, true>(L, g, S, E, wave);
#ifndef DBL_SIDE
#define DBL_SIDE 1
#endif
            for (int rep = 0; rep < DBL_SIDE; ++rep)
            side_gemm(PT, L, l, wave, bid, G);
        }
        SEAM(pb + 0);
        if (PHSEL(3) && IN(pb + 1)) {
            unsigned char* ws = PT.ws(); LAUNDER_G(ws);
#ifndef NO_THIN
            thin_rows(PT, l, wave, bid, G);
#endif
#ifndef NO_G1
#ifndef DBL_GLA
#define DBL_GLA 1
#endif
#ifndef DBL_G1
#define DBL_G1 DBL_GLA
#endif
            for (int rep = 0; rep < DBL_G1; ++rep)
            for (int u = bid; u < NGU; u += G) gla_g1(PT, L, l, u, wave);
#endif
        }
        SEAM(pb + 1);
        if (PHSEL(4) && IN(pb + 2)) {
            unsigned char* ws = PT.ws(); LAUNDER_G(ws);
#ifndef NO_UQ
            { pg8::Gemm g{(const bf16_t*)(ws + WS_P) + P_CQ, (const bf16_t*)(ws + WS_WUQ) + (size_t)l * 1536 * 512, NTOK, 1536, 512, PW, 512};
              pg8::StaticOrder S; S.init(NTOK, 1536, G, bid);
              pg8::EpiQRope E{(bf16_t*)(ws + WS_Q), (const float*)(ws + WS_ROPE), (const float*)(ws + WS_ROPE) + SEQ * 32};
              pg8::gemm_phase<pg8::EpiQRope, pg8::StaticOrder, true, true>(L, g, S, E, wave); }
#endif
#ifndef NO_UKV
            { pg8::Gemm g{(const bf16_t*)(ws + WS_P) + P_CKV, (const bf16_t*)(ws + WS_WUKV) + (size_t)l * 2048 * 256, NTOK, 2048, 256, PW, 256};
              pg8::LatentOrder S; S.init(2048, G, bid);
              pg8::EpiBf16<0> E{(bf16_t*)(ws + WS_KV), 2048, nullptr, 0, 0, 1.f};
              pg8::gemm_phase<pg8::EpiBf16<0>, pg8::LatentOrder, true, true>(L, g, S, E, wave);
              bf16_t* KVo = (bf16_t*)(ws + WS_KV);
              ctx_gemm(L, (const bf16_t*)(ws + WS_P) + P_CKV, PW, (const bf16_t*)(ws + WS_WUKV) + (size_t)l * 2048 * 256, 256, 2048, 256, wave, bid, G, [=](int row, int col, float v) { KVo[(size_t)row * 2048 + col] = f2bf_safe(v); }); }
#endif
#ifndef NO_G2
#ifndef DBL_G2
#define DBL_G2 DBL_GLA
#endif
            for (int rep = 0; rep < DBL_G2; ++rep) gla_g2(PT, wave, bid, G);
#endif
        }
        SEAM(pb + 2);
        if (PHSEL(5) && IN(pb + 3)) {
            unsigned char* ws = PT.ws(); LAUNDER_G(ws);
            const bf16_t* Q = (const bf16_t*)(ws + WS_Q); const bf16_t* KV = (const bf16_t*)(ws + WS_KV); const bf16_t* KR = (const bf16_t*)(ws + WS_KR); bf16_t* MIX = (bf16_t*)(ws + WS_MIX);
            const int nau = NB * 8 * 16 + (l < DEPTH - 1 ? NB * 8 : 0);
#ifndef DBL_ATT
#define DBL_ATT 1
#endif
#ifndef DBL_G3
#define DBL_G3 DBL_GLA
#endif
            const bool g3first = ((bid >> 3) & 1) != 0;
            for (int step = 0; step < 2; ++step) {
                if ((step == 0) == g3first) {
            for (int rep = 0; rep < DBL_G3; ++rep)
            for (int u = G - 1 - bid; u < NGU; u += G) gla_g3(PT, L, l, u, wave);
                } else {
            for (int rep = 0; rep < DBL_ATT; ++rep)
            for (int u = bid; u < nau; u += G) {
                int b, h, q0, nk;
                if (u < NB * 8 * 16) {
                    int uu = u; if ((G & 7) == 0 && G * 2 == NB * 8 * 16) { const int xcd = bid & 7, idx = (bid >> 3) + (G >> 3) * (u / G); uu = (4 * xcd + (idx >> 4)) * 16 + (idx & 15); }
                    b = uu >> 7; h = (uu >> 4) & 7; q0 = b * RPB + CTX + (uu & 15) * 256; nk = RPB; }
                else { const int v = u - NB * 8 * 16; b = v >> 3; h = v & 7; q0 = b * RPB; nk = CTX; }
                att::attn_unit(Q + (size_t)q0 * 1536 + h * 192, KV + (size_t)b * RPB * 2048 + h * 256, KR + (size_t)b * RPB * 64, KV + (size_t)b * RPB * 2048 + h * 256 + 128,
                               MIX + (size_t)q0 * DM + h * 128, nk, L, wave);
            }
                }
            }
        }
        SEAM(pb + 3);
        if (PHSEL(6) && IN(pb + 4)) {
            unsigned char* ws = PT.ws(); LAUNDER_G(ws);
            pg8::Gemm g{(const bf16_t*)(ws + WS_MIX), (const bf16_t*)(ws + WS_WOUT) + (size_t)l * DM * DM, NTOK, DM, DM, DM, DM};
            pg8::LatentOrder S; S.init(DM, G, bid);
            pg8::EpiResid E{(float*)(ws + WS_XRES), (const float*)(ws + WS_MOD) + (size_t)l * 5 * NMOD + 2 * DM};
            const bool cfirst = ((bid >> 3) & 1) != 0 && (l < DEPTH - 1);
            float* X = (float*)(ws + WS_XRES); const float* gate = (const float*)(ws + WS_MOD) + ((size_t)l * 5 + 4) * NMOD + 2 * DM;
            for (int step = 0; step < 2; ++step) {
                if ((step == 0) != cfirst) pg8::gemm_phase<pg8::EpiResid, pg8::LatentOrder, true, true>(L, g, S, E, wave);
                else if (l < DEPTH - 1) {
                ctx_gemm(L, (const bf16_t*)(ws + WS_MIX), DM, (const bf16_t*)(ws + WS_WOUT) + (size_t)l * DM * DM, DM, DM, DM, wave, bid, G, [=](int row, int col, float v) { X[(size_t)row * DM + col] += gate[col] * v; });
                }
            }
        }
        SEAM(pb + 4);
        if (PHSEL(7) && IN(pb + 5)) norm2_rows(PT, l, wave, bid, G);
        SEAM(pb + 5);
        if (PHSEL(8) && IN(pb + 6)) {
            unsigned char* ws = PT.ws(); LAUNDER_G(ws);
            pg8::Gemm g{(const bf16_t*)(ws + WS_H), (const bf16_t*)(ws + WS_WQRY) + (size_t)l * DM * DM, NTOK, DM, DM, DM, DM};
            pg8::LatentOrder S; S.init(DM, G, bid);
            pg8::EpiBf16<0> E{(bf16_t*)(ws + WS_QP), DM, nullptr, 0, 0, 1.f};
            pg8::gemm_phase<pg8::EpiBf16<0>, pg8::LatentOrder, true, true>(L, g, S, E, wave);
            if (l < DEPTH - 1) { bf16_t* QPo = (bf16_t*)(ws + WS_QP);
                ctx_gemm(L, (const bf16_t*)(ws + WS_H), DM, (const bf16_t*)(ws + WS_WQRY) + (size_t)l * DM * DM, DM, DM, DM, wave, bid, G, [=](int row, int col, float v) { QPo[(size_t)row * DM + col] = f2bf_safe(v); }); }
        }
        SEAM(pb + 6);
#ifndef DBL_TOPK
#define DBL_TOPK 1
#endif
        if (PHSEL(9) && IN(pb + 7)) { for (int rep = 0; rep < DBL_TOPK; ++rep) { peer_topk_phase(PT, L, l, wave, bid, G); __syncthreads(); } }
        SEAM(pb + 7);
        if (PHSEL(10) && IN(pb + 8)) peer_rows(PT, L, bar.x, l, wave, bid, G);
        SEAM(pb + 8);
    }
}

extern "C" void kernel_launch(void* const* d_in, const int* in_sizes, int n_in, void* d_out, int out_size, void* d_ws, size_t ws_size, hipStream_t stream) {
    static int grid = 0;
    if (grid == 0) {
        if (n_in != 22 || out_size != NB * SEQ * DM || ws_size < WS_END) { fprintf(stderr, "kernel_launch: unexpected shapes: n_in %d out %d ws %zu (need %zu)\n", n_in, out_size, ws_size, (size_t)WS_END); grid = -1; return; }
        int dev = 0, cus = 0, per_cu = 0;
        if (hipGetDevice(&dev) != hipSuccess || hipDeviceGetAttribute(&cus, hipDeviceAttributeMultiprocessorCount, dev) != hipSuccess) { grid = -1; return; }
        if (hipFuncSetAttribute((const void*)mk_fwd, hipFuncAttributeMaxDynamicSharedMemorySize, LDS_BYTES) != hipSuccess) { fprintf(stderr, "kernel_launch: hipFuncSetAttribute failed\n"); grid = -1; return; }
        if (hipOccupancyMaxActiveBlocksPerMultiprocessor(&per_cu, mk_fwd, NTHR, LDS_BYTES) != hipSuccess || per_cu < 1) { fprintf(stderr, "kernel_launch: occupancy query says %d\n", per_cu); grid = -1; return; }
        grid = cus;
    }
    if (grid < 0) return;
    (void)hipMemsetAsync((char*)d_ws + WS_CTL, 0, CTL_BYTES, stream);
    Args a{};
    for (int i = 0; i < 22; ++i) a.in[i] = (const float*)d_in[i];
    a.out = (float*)d_out; a.ws = (unsigned char*)d_ws;
#if MK_MULTI
    for (int p = 0; p < N_PHASES; ++p) { a.ph_lo = p; a.ph_hi = p + 1; hipLaunchKernelGGL(mk_fwd, dim3(grid), dim3(NTHR), LDS_BYTES, stream, a); }
#else
    a.ph_lo = 0; a.ph_hi = N_PHASES;
    hipLaunchKernelGGL(mk_fwd, dim3(grid), dim3(NTHR), LDS_BYTES, stream, a);
#endif
    const hipError_t le = hipPeekAtLastError();
    if (le != hipSuccess) fprintf(stderr, "kernel_launch: launch failed: %s\n", hipGetErrorName(le));
}
```

```cpp
#include <hip/hip_runtime.h>
#include <cstdio>
#include <cstdint>

#ifndef MK_MULTI
#define MK_MULTI 0
#endif

#define GAS __attribute__((address_space(1)))
#define LAS __attribute__((address_space(3)))
typedef unsigned short bf16_t;
typedef short bf16x8 __attribute__((ext_vector_type(8)));
typedef short s16x4 __attribute__((ext_vector_type(4)));
typedef float f32x2 __attribute__((ext_vector_type(2)));
typedef float f32x4 __attribute__((ext_vector_type(4)));
typedef float f32x16 __attribute__((ext_vector_type(16)));
typedef unsigned u32x2 __attribute__((ext_vector_type(2)));
typedef unsigned u32x4 __attribute__((ext_vector_type(4)));
typedef __bf16 bf16v2 __attribute__((ext_vector_type(2)));
typedef unsigned u32x6 __attribute__((ext_vector_type(6)));
typedef float f32x32 __attribute__((ext_vector_type(32)));
typedef __bf16 bf16x32v __attribute__((ext_vector_type(32)));
typedef unsigned u32x16 __attribute__((ext_vector_type(16)));

constexpr int DM = 2048, NB = 4, SEQ = 4096, CTX = 256, RPB = SEQ + CTX, NTOK = NB * RPB, DEPTH = 4;
constexpr int NMOD = 6 * DM;
constexpr int PW = 3840;
constexpr int P_CQ = 0, P_CKV = 512, P_GQ = 768, P_GK = 1280, P_GV = 1792, P_GG = 2816;
constexpr int SIDEW = 96;
constexpr int NCH = RPB / 64;
constexpr int NGU = NB * 4 * NCH;
constexpr int NEXP = 16384;
constexpr float EPS = 1e-6f;
constexpr int NTHR = 512, NWAVES = 8;

constexpr size_t al256(size_t x) { return (x + 255) & ~(size_t)255; }
constexpr size_t WS_CTL = 0, CTL_BYTES = 1u << 20;
constexpr size_t WS_MOD = WS_CTL + CTL_BYTES;
constexpr size_t WS_ROPE = WS_MOD + al256((size_t)DEPTH * 5 * NMOD * 4);
constexpr size_t WS_WIN = WS_ROPE + al256((size_t)2 * SEQ * 32 * 4);
constexpr size_t WS_WSIDE = WS_WIN + (size_t)DEPTH * PW * DM * 2;
constexpr size_t WS_WUQ = WS_WSIDE + (size_t)DEPTH * SIDEW * DM * 2;
constexpr size_t WS_WUKV = WS_WUQ + (size_t)DEPTH * 1536 * 512 * 2;
constexpr size_t WS_WOUT = WS_WUKV + (size_t)DEPTH * 2048 * 256 * 2;
constexpr size_t WS_WQRY = WS_WOUT + (size_t)DEPTH * DM * DM * 2;
constexpr size_t WS_SUBK = WS_WQRY + (size_t)DEPTH * DM * DM * 2;
constexpr int EROW = 1024;
constexpr size_t WS_EU = WS_SUBK + (size_t)DEPTH * 2 * 8 * 128 * 128 * 2;
constexpr size_t WS_EV = WS_EU + (size_t)DEPTH * NEXP * EROW;
constexpr size_t WS_SU = WS_EV + (size_t)DEPTH * NEXP * EROW;
constexpr size_t WS_SV = WS_SU + (size_t)DEPTH * NEXP * 4;
constexpr size_t WS_XRES = WS_SV + (size_t)DEPTH * NEXP * 4;
constexpr size_t WS_H = WS_XRES + (size_t)NTOK * DM * 4;
constexpr size_t WS_P = WS_H + (size_t)NTOK * DM * 2;
constexpr size_t WS_SIDE = WS_P + (size_t)NTOK * PW * 2;
constexpr size_t WS_Q = WS_SIDE + (size_t)NTOK * SIDEW * 4;
constexpr size_t WS_KV = WS_Q + (size_t)NTOK * 1536 * 2;
constexpr size_t WS_KR = WS_KV + (size_t)NTOK * 2048 * 2;
constexpr size_t WS_MIX = WS_KR + (size_t)NTOK * 64 * 2;
constexpr size_t WS_QDEC = WS_MIX + (size_t)NTOK * DM * 2;
constexpr size_t WS_OINTRA = WS_QDEC + (size_t)NGU * 2 * 64 * 128 * 2;
constexpr size_t WS_DS = WS_OINTRA + (size_t)NTOK * 1024 * 4;
constexpr size_t WS_DEC = WS_DS + (size_t)2 * 16 * NCH * 32768 * 2;
constexpr size_t WS_SENT = WS_DEC + al256((size_t)2 * 16 * NCH * 128 * 4);
constexpr size_t WS_QP = WS_SENT + (size_t)2 * 16 * NCH * 32768 * 2;
constexpr size_t WS_IDX = WS_QP + (size_t)NTOK * DM * 2;
constexpr size_t WS_GATE = WS_IDX + (size_t)NTOK * 128 * 4;
constexpr size_t WS_END = WS_GATE + (size_t)NTOK * 128 * 4;

constexpr int CW_DBG = 8;
constexpr int CW_BAR = 4096;
constexpr int CW_RND = 8192;

constexpr int LDS_BYTES = 163840;
constexpr int LDS_CTL_OFF = LDS_BYTES - 256;

__device__ __forceinline__ unsigned cvt_pk(float lo, float hi) { unsigned r; asm volatile("v_cvt_pk_bf16_f32 %0, %1, %2" : "=v"(r) : "v"(lo), "v"(hi)); return r; }
__device__ __forceinline__ unsigned cvt_pk_safe(float lo, float hi) { const f32x2 v = {lo, hi}; const bf16v2 b = __builtin_convertvector(v, bf16v2); return __builtin_bit_cast(unsigned, b); }
__device__ __forceinline__ unsigned cvt_pk_asm(float lo, float hi) { unsigned r; asm volatile("v_cvt_pk_bf16_f32 %0, %1, %2" : "=v"(r) : "v"(lo), "v"(hi)); return r; }
__device__ __forceinline__ float bflo(unsigned w) { return __builtin_bit_cast(float, w << 16); }
__device__ __forceinline__ float bfhi(unsigned w) { return __builtin_bit_cast(float, w & 0xffff0000u); }
__device__ __forceinline__ float bf2f(bf16_t b) { return __builtin_bit_cast(float, (unsigned)b << 16); }
__device__ __forceinline__ bf16_t f2bf_safe(float f) { return (bf16_t)(cvt_pk_safe(f, 0.f) & 0xffffu); }
__device__ __forceinline__ bf16_t f2bf(float f) { return (bf16_t)(cvt_pk(f, 0.f) & 0xffffu); }
#define DPP_I(v, ctrl) __builtin_amdgcn_update_dpp(0, (v), (ctrl), 0xF, 0xF, true)
__device__ __forceinline__ int shx_i(int v, int o) {
    switch (o) {
    case 1: return DPP_I(v, 0xB1);
    case 2: return DPP_I(v, 0x4E);
    case 4: return DPP_I(DPP_I(v, 0x1B), 0x141);
    case 8: return DPP_I(v, 0x128);
    default: return __shfl_xor(v, o);
    }
}
__device__ __forceinline__ float shx_f(float v, int o) { return __builtin_bit_cast(float, shx_i(__builtin_bit_cast(int, v), o)); }
#define DPP_F(v, ctrl) __builtin_bit_cast(float, DPP_I(__builtin_bit_cast(int, (v)), (ctrl)))
#define RL_F(v, l) __builtin_bit_cast(float, __builtin_amdgcn_readlane(__builtin_bit_cast(int, (v)), (l)))
__device__ __forceinline__ float wave_sum(float v) {
    v += DPP_F(v, 0xB1); v += DPP_F(v, 0x4E); v += DPP_F(v, 0x141); v += DPP_F(v, 0x140);
    return (RL_F(v, 0) + RL_F(v, 16)) + (RL_F(v, 32) + RL_F(v, 48));
}
__device__ __forceinline__ float wave_max(float v) {
    v = fmaxf(v, DPP_F(v, 0xB1)); v = fmaxf(v, DPP_F(v, 0x4E)); v = fmaxf(v, DPP_F(v, 0x141)); v = fmaxf(v, DPP_F(v, 0x140));
    return fmaxf(fmaxf(RL_F(v, 0), RL_F(v, 16)), fmaxf(RL_F(v, 32), RL_F(v, 48)));
}
__device__ __forceinline__ int wave_sum_i(int v) {
    v += DPP_I(v, 0xB1); v += DPP_I(v, 0x4E); v += DPP_I(v, 0x141); v += DPP_I(v, 0x140);
    return (__builtin_amdgcn_readlane(v, 0) + __builtin_amdgcn_readlane(v, 16)) + (__builtin_amdgcn_readlane(v, 32) + __builtin_amdgcn_readlane(v, 48));
}
__device__ __forceinline__ int crow(int r, int hi) { return (r & 3) + 8 * (r >> 2) + 4 * hi; }
__device__ __forceinline__ int modrow(int r) { const int b = r / RPB; return (r - b * RPB) < CTX ? 4 : b; }
__device__ __forceinline__ int lane_id() { int l; asm volatile("v_mbcnt_lo_u32_b32 %0, -1, 0\n\tv_mbcnt_hi_u32_b32 %0, -1, %0" : "=&v"(l)); return l; }
#define LDS_WAIT() asm volatile("s_waitcnt lgkmcnt(0)" ::: "memory")
#define VM_WAIT() asm volatile("s_waitcnt vmcnt(0)" ::: "memory")
#define SBAR() __builtin_amdgcn_sched_barrier(0)
#define LAUNDER_G(p) do { GAS unsigned char* _g = (GAS unsigned char*)(p); asm volatile("" : "+s"(_g)); (p) = (unsigned char*)_g; } while (0)

namespace pg8 {
#define PG8_LAS __attribute__((address_space(3)))
typedef unsigned short bf16_t;
typedef short bf16x8 __attribute__((ext_vector_type(8)));
typedef float f32x4 __attribute__((ext_vector_type(4)));
typedef unsigned u32x4 __attribute__((ext_vector_type(4)));
constexpr int BM = 256, BK = 64, HALF = 128, HTB = HALF * BK * 2  , STAGE_BYTES = 8 * HTB, NXCD = 8, WGM = 8;

__host__ __device__ __forceinline__ int lds_byte(int r, int c) { const int st = (r >> 4) * 2 + (c >> 5), rr = r & 15, cc = c & 31, ob = rr * 64 + cc * 2; return st * 1024 + (ob ^ (((ob >> 9) & 1) << 5)); }
__host__ __device__ __forceinline__ void stage_rc(int b, int& R, int& C) { const int st = b / 1024, sb = b % 1024, swz = sb ^ (((sb >> 9) & 1) << 5); R = (st >> 1) * 16 + swz / 64; C = (st & 1) * 32 + (swz % 64) / 2; }
__host__ __device__ __forceinline__ int perm32(int rho) { const int n = rho >> 4, i = rho & 15; return 8 * (i >> 2) + 4 * n + (i & 3); }

struct Unit { int pm, pn; };
struct Gemm { const bf16_t* A; const bf16_t* Bt; int M, N, K, lda, ldb; };

struct StaticOrder {
    int nM, nN, nwg, G, c;
    __host__ __device__ void init(int M, int N, int G_, int c_) { nM = M / BM; nN = N / BM; nwg = nM * nN; G = G_; c = c_; }
    __host__ __device__ bool next(int i, Unit& u) const {
        const long L = (long)i * G + c; if (L >= nwg) return false;
        int wgid = (int)L; { const int q = nwg / NXCD, r = nwg % NXCD, xcd = wgid % NXCD, off = wgid / NXCD; wgid = (xcd < r ? xcd * (q + 1) : r * (q + 1) + (xcd - r) * q) + off; }
        const int nig = WGM * nN, gid = wgid / nig, fm = gid * WGM, gsz = (nM - fm) < WGM ? (nM - fm) : WGM;
        u.pm = fm + ((wgid % nig) % gsz); u.pn = (wgid % nig) / gsz; return true;
    }
    __device__ __forceinline__ void a_ready(const Unit&) const {}
    __device__ __forceinline__ void done(const Unit&) const {}
};
struct LatentOrder : StaticOrder {
    __host__ __device__ void init(int N, int G_, int c_) { StaticOrder::init(16384, N, G_, c_); }
    __host__ __device__ bool next(int i, Unit& u) const { if (!StaticOrder::next(i, u)) return false; u.pm = u.pm + (u.pm >> 4) + 1; return true; }
};


__device__ __forceinline__ unsigned cvt_pk_bf16(float lo, float hi) { return ::cvt_pk_asm(lo, hi); }

template <int ACT  > struct EpiBf16 {
    static constexpr bool PERM = true, AFTER_DRAIN = false; static_assert(ACT == 0, "EpiBf16: no activation here");
    bf16_t* O; int ldc; const float* bias; int split_cols; size_t split_stride; float scale0;
    __device__ __forceinline__ void operator()(const f32x4 (&acc)[2][2][4][2], const Unit& u, int wr, int wc, int fr, int fq) const {
        const int row0 = u.pm * BM + wr * 64 + fr; int colt = u.pn * BM; bf16_t* base = O;
        float sc = 1.f; if (split_cols) { const int t = colt / split_cols; base += (size_t)t * split_stride; colt -= t * split_cols; if (t == 0) sc = scale0; }
        const int col0 = colt + wc * 32 + 8 * fq, bcol0 = u.pn * BM + wc * 32 + 8 * fq;
        f32x4 bv[2][2];
#pragma unroll
        for (int bj = 0; bj < 2; ++bj)
#pragma unroll
            for (int n = 0; n < 2; ++n) bv[bj][n] = bias ? *(const f32x4*)(bias + bcol0 + bj * HALF + 4 * n) : (f32x4){0.f, 0.f, 0.f, 0.f};
#pragma unroll
        for (int ai = 0; ai < 2; ++ai)
#pragma unroll
            for (int m = 0; m < 4; ++m) { bf16_t* rowp = base + (size_t)(row0 + ai * HALF + m * 16) * ldc + col0;
#pragma unroll
                for (int bj = 0; bj < 2; ++bj) { f32x4 v0 = acc[ai][bj][m][0] + bv[bj][0], v1 = acc[ai][bj][m][1] + bv[bj][1];
                    v0 = v0 * sc; v1 = v1 * sc; u32x4 w; w.x = cvt_pk_bf16(v0[0], v0[1]); w.y = cvt_pk_bf16(v0[2], v0[3]); w.z = cvt_pk_bf16(v1[0], v1[1]); w.w = cvt_pk_bf16(v1[2], v1[3]);
                    *(u32x4*)(rowp + bj * HALF) = w; } }
    }
};


template <class Epi, class Sched, bool ALIGN_EPI = false, bool SP2 = false>
__device__ __forceinline__ void gemm_phase(PG8_LAS unsigned char* lds, const Gemm g, const Sched& S, const Epi& E, int wid) {
    asm volatile("" : "+s"(wid));
    const int lane = lane_id(), tid = wid * 64 + lane, wr = wid >> 2, wc = wid & 3, fr = lane & 15, fq = lane >> 4;
    const int K = g.K, nt = K / BK;
    unsigned voffA[2], voffB[2];
#pragma unroll
    for (int i = 0; i < 2; ++i) { int R, C; stage_rc(tid * 16 + i * 8192, R, C); const int Rb = Epi::PERM ? ((R & ~31) + perm32(R & 31)) : R;
        voffA[i] = (unsigned)(R * g.lda + C) * 2u; voffB[i] = (unsigned)(Rb * g.ldb + C) * 2u; }
    const size_t kstep = (size_t)(BK * 2);
    const size_t hstepA = (size_t)HALF * g.lda * 2, hstepB = (size_t)HALF * g.ldb * 2;
    const size_t tstepA = 2 * hstepA, tstepB = 2 * hstepB;
    const unsigned ldsw = (unsigned)wid * 1024u;
    const int aoff = lds_byte(wr * 64 + fr, fq * 8), boff = lds_byte(wc * 32 + fr, fq * 8);
#define PG8_SA(b, h) (((b) * 2 + (h)) * HTB)
#define PG8_SB(b, h) ((4 + (b) * 2 + (h)) * HTB)
#define PG8_STAGE(bufoff, gbase, voff) do { _Pragma("unroll") for (int _i = 0; _i < 2; ++_i) \
        __builtin_amdgcn_global_load_lds((const unsigned*)((const char*)(gbase) + (voff)[_i]), (PG8_LAS unsigned*)(lds + (bufoff) + ldsw + _i * 8192), 16, 0, 0); } while (0)
#define PG8_LDA(dst, b, h) do { _Pragma("unroll") for (int m = 0; m < 4; ++m) _Pragma("unroll") for (int k = 0; k < 2; ++k) dst[m][k] = *(const PG8_LAS bf16x8*)(lds + PG8_SA(b, h) + aoff + m * 2048 + k * 1024); } while (0)
#define PG8_LDB(dst, b, h) do { _Pragma("unroll") for (int n = 0; n < 2; ++n) _Pragma("unroll") for (int k = 0; k < 2; ++k) dst[n][k] = *(const PG8_LAS bf16x8*)(lds + PG8_SB(b, h) + boff + n * 2048 + k * 1024); } while (0)
#define PG8_MMA(ai, bj, At, Bt) do { __builtin_amdgcn_s_setprio(1); _Pragma("unroll") for (int m = 0; m < 4; ++m) _Pragma("unroll") for (int n = 0; n < 2; ++n) _Pragma("unroll") for (int k = 0; k < 2; ++k) \
        acc[ai][bj][m][n] = __builtin_amdgcn_mfma_f32_16x16x32_bf16(Bt[n][k], At[m][k], acc[ai][bj][m][n], 0, 0, 0); __builtin_amdgcn_s_setprio(0); } while (0)
#define PG8_WAIT_V(n) asm volatile("s_waitcnt vmcnt(" #n ")" ::: "memory")
#define PG8_WAIT_L(n) asm volatile("s_waitcnt lgkmcnt(" #n ")" ::: "memory")
#define PG8_BAR __builtin_amdgcn_s_barrier()
#define PG8_SCHED __builtin_amdgcn_sched_barrier(0)
    Unit cur, nxt; int ui = 0;
    if (!S.next(0, cur)) return;
    f32x4 acc[2][2][4][2];
#pragma unroll
    for (int a = 0; a < 2; ++a)
#pragma unroll
        for (int b = 0; b < 2; ++b)
#pragma unroll
            for (int m = 0; m < 4; ++m)
#pragma unroll
                for (int n = 0; n < 2; ++n) acc[a][b][m][n] = (f32x4){0.f, 0.f, 0.f, 0.f};
    bf16x8 At[4][2], B0[2][2], B1[2][2];
    const char* cA = (const char*)g.A + (size_t)cur.pm * tstepA; const char* cB = (const char*)g.Bt + (size_t)cur.pn * tstepB;
    S.a_ready(cur);
    if constexpr (SP2) {
        PG8_STAGE(PG8_SB(0, 0), cB, voffB); PG8_STAGE(PG8_SB(0, 1), cB + hstepB, voffB); PG8_STAGE(PG8_SA(0, 0), cA, voffA); PG8_STAGE(PG8_SA(0, 1), cA + hstepA, voffA);
        if (wr == 1) PG8_BAR;
        PG8_WAIT_V(2); PG8_BAR;
        PG8_STAGE(PG8_SB(1, 0), cB + kstep, voffB); PG8_STAGE(PG8_SA(1, 0), cA + kstep, voffA); PG8_STAGE(PG8_SB(1, 1), cB + hstepB + kstep, voffB);
        PG8_WAIT_V(6); PG8_BAR;
    } else {
        PG8_STAGE(PG8_SB(0, 0), cB, voffB); PG8_STAGE(PG8_SA(0, 0), cA, voffA); PG8_STAGE(PG8_SB(0, 1), cB + hstepB, voffB); PG8_STAGE(PG8_SA(0, 1), cA + hstepA, voffA);
        if (wr == 1) PG8_BAR;
        PG8_WAIT_V(4); PG8_BAR;
        PG8_STAGE(PG8_SB(1, 0), cB + kstep, voffB); PG8_STAGE(PG8_SA(1, 0), cA + kstep, voffA); PG8_STAGE(PG8_SB(1, 1), cB + hstepB + kstep, voffB);
        PG8_WAIT_V(6); PG8_BAR;
    }
    for (;;) {
        const bool has_next = S.next(ui + 1, nxt);
        const char* nA = has_next ? (const char*)g.A + (size_t)nxt.pm * tstepA : cA; const char* nB = has_next ? (const char*)g.Bt + (size_t)nxt.pn * tstepB : cB;
#pragma unroll 1
        for (int t = 0; t < nt; t += 2) {
            const bool last = (t == nt - 2);
            const char* a1 = cA + (size_t)(t + 1) * kstep;
            const char* a2 = last ? nA : cA + (size_t)(t + 2) * kstep; const char* b2 = last ? nB : cB + (size_t)(t + 2) * kstep;
            const char* a3 = a2 + kstep; const char* b3 = b2 + kstep;
            if (last && has_next) S.a_ready(nxt);
            if constexpr (SP2) {
            PG8_LDB(B0, 0, 0); PG8_LDB(B1, 0, 1); PG8_SCHED; PG8_LDA(At, 0, 0); PG8_STAGE(PG8_SA(1, 1), a1 + hstepA, voffA);
            PG8_WAIT_V(8); PG8_WAIT_L(0); PG8_BAR; PG8_MMA(0, 0, At, B0); PG8_MMA(0, 1, At, B1); PG8_BAR; PG8_SCHED;
            PG8_LDA(At, 0, 1); PG8_STAGE(PG8_SB(0, 0), b2, voffB); PG8_STAGE(PG8_SB(0, 1), b2 + hstepB, voffB); PG8_STAGE(PG8_SA(0, 0), a2, voffA);
            PG8_WAIT_V(8); PG8_WAIT_L(0); PG8_BAR; PG8_MMA(1, 0, At, B0); PG8_MMA(1, 1, At, B1); PG8_BAR; PG8_SCHED;
            PG8_LDB(B0, 1, 0); PG8_LDB(B1, 1, 1); PG8_SCHED; PG8_LDA(At, 1, 0); PG8_STAGE(PG8_SA(0, 1), a2 + hstepA, voffA);
            PG8_WAIT_V(8); PG8_WAIT_L(0); PG8_BAR; PG8_MMA(0, 0, At, B0); PG8_MMA(0, 1, At, B1); PG8_BAR; PG8_SCHED;
            PG8_LDA(At, 1, 1); PG8_STAGE(PG8_SB(1, 0), b3, voffB); PG8_STAGE(PG8_SB(1, 1), b3 + hstepB, voffB); PG8_STAGE(PG8_SA(1, 0), a3, voffA);
            PG8_WAIT_V(8); PG8_WAIT_L(0); PG8_BAR; PG8_MMA(1, 0, At, B0); PG8_MMA(1, 1, At, B1); PG8_BAR; PG8_SCHED;
            } else {
            PG8_LDB(B0, 0, 0); PG8_SCHED; PG8_LDA(At, 0, 0); PG8_STAGE(PG8_SA(1, 1), a1 + hstepA, voffA);
            PG8_WAIT_L(8); PG8_BAR; PG8_WAIT_L(0); PG8_MMA(0, 0, At, B0); PG8_BAR; PG8_SCHED;
            PG8_LDB(B1, 0, 1); PG8_STAGE(PG8_SB(0, 0), b2, voffB);
            PG8_BAR; PG8_WAIT_L(0); PG8_MMA(0, 1, At, B1); PG8_BAR;
            PG8_LDA(At, 0, 1); PG8_STAGE(PG8_SA(0, 0), a2, voffA);
            PG8_BAR; PG8_WAIT_L(0); PG8_MMA(1, 0, At, B0); PG8_BAR; PG8_SCHED;
            PG8_STAGE(PG8_SB(0, 1), b2 + hstepB, voffB);
            PG8_WAIT_V(6); PG8_BAR; PG8_MMA(1, 1, At, B1); PG8_BAR;
            PG8_LDB(B0, 1, 0); PG8_SCHED; PG8_LDA(At, 1, 0); PG8_STAGE(PG8_SA(0, 1), a2 + hstepA, voffA);
            PG8_WAIT_L(8); PG8_BAR; PG8_WAIT_L(0); PG8_MMA(0, 0, At, B0); PG8_BAR; PG8_SCHED;
            PG8_LDB(B1, 1, 1); PG8_STAGE(PG8_SB(1, 0), b3, voffB);
            PG8_BAR; PG8_WAIT_L(0); PG8_MMA(0, 1, At, B1); PG8_BAR;
            PG8_LDA(At, 1, 1); PG8_STAGE(PG8_SA(1, 0), a3, voffA);
            PG8_BAR; PG8_WAIT_L(0); PG8_MMA(1, 0, At, B0); PG8_BAR; PG8_SCHED;
            PG8_STAGE(PG8_SB(1, 1), b3 + hstepB, voffB);
            PG8_WAIT_V(6); PG8_BAR; PG8_MMA(1, 1, At, B1); PG8_BAR;
            }
        }
        if constexpr (ALIGN_EPI) { if (wr == 0) PG8_BAR; }
        if constexpr (!Epi::AFTER_DRAIN) { E(acc, cur, wr, wc, fr, fq); S.done(cur); }
        if (!has_next) break;
#pragma unroll
        for (int a = 0; a < 2; ++a)
#pragma unroll
            for (int b = 0; b < 2; ++b)
#pragma unroll
                for (int m = 0; m < 4; ++m)
#pragma unroll
                    for (int n = 0; n < 2; ++n) acc[a][b][m][n] = (f32x4){0.f, 0.f, 0.f, 0.f};
        cur = nxt; cA = nA; cB = nB; ++ui;
        if constexpr (ALIGN_EPI) { if (wr == 1) PG8_BAR; }
    }
    PG8_WAIT_V(0);
    if constexpr (!ALIGN_EPI) { if (wr == 0) PG8_BAR; }
    PG8_BAR;
    if constexpr (Epi::AFTER_DRAIN) { E.fused(acc, cur, wr, wc, fr, fq, lds, wid, lane); S.done(cur); }
#undef PG8_SA
#undef PG8_SB
#undef PG8_STAGE
#undef PG8_LDA
#undef PG8_LDB
#undef PG8_MMA
#undef PG8_WAIT_V
#undef PG8_WAIT_L
#undef PG8_BAR
#undef PG8_SCHED
}
}
#define XB_TMO      128
#define XB_XCNT(j)  (256  + 64 * (j))
#define XB_XSUB(j)  (1280 + 64 * (j))
#define XB_XGEN(j)  (2304 + 64 * (j))
#define XB_TOP      3328
#define XB_TOPGEN   3392
#define XCD_BAR_WORDS 3456
#define XB_SPIN_CAP (1u << 22)

__device__ __forceinline__ unsigned xb_ld(unsigned* p)              { return __hip_atomic_load(p, __ATOMIC_RELAXED, __HIP_MEMORY_SCOPE_AGENT); }
__device__ __forceinline__ unsigned xb_add(unsigned* p, unsigned v) { return __hip_atomic_fetch_add(p, v, __ATOMIC_RELAXED, __HIP_MEMORY_SCOPE_AGENT); }
__device__ __forceinline__ unsigned xb_xcc_id() { return (unsigned)__builtin_amdgcn_s_getreg((3 << 11) | 20) & 0xFu; }
#define XB_SPIN(cond, bar) do { unsigned _sp = 0; while (cond) { __builtin_amdgcn_s_sleep(1); \
    if ((++_sp & 255u) == 0u) { if (xb_ld(&(bar)[XB_TMO])) break; if (_sp > XB_SPIN_CAP) { atomicAdd(&(bar)[XB_TMO], 1u); break; } } } } while (0)

struct XcdBarrier {
    unsigned* bar; unsigned x; unsigned wv;
    volatile LAS unsigned* st;
};

__device__ __forceinline__ XcdBarrier xcd_barrier_post(unsigned* bar, volatile LAS unsigned* st) {
    XcdBarrier b; b.bar = bar; b.x = xb_xcc_id(); b.st = st; b.wv = 0u;
    if (threadIdx.x == 0) (void)xb_add(&bar[XB_XCNT(b.x)], 1u);
    return b;
}
__device__ __forceinline__ void xcd_barrier_complete(unsigned* bar, unsigned x, unsigned& nloc, unsigned& nx) {
    const unsigned G = gridDim.x * gridDim.y * gridDim.z;
    unsigned sum, cnt, mine, sp = 0u;
    for (;;) {
        sum = 0u; cnt = 0u; mine = 0u;
#pragma unroll
        for (unsigned j = 0; j < 16; ++j) { const unsigned c = xb_ld(&bar[XB_XCNT(j)]); sum += c; cnt += (c > 0u) ? 1u : 0u; mine = (j == x) ? c : mine; }
        if (sum == G) break;
        __builtin_amdgcn_s_sleep(1);
        if ((++sp & 255u) == 0u) { if (xb_ld(&bar[XB_TMO])) break; if (sp > XB_SPIN_CAP) { atomicAdd(&bar[XB_TMO], 1u); break; } }
    }
    nloc = mine > 0u ? mine : 1u; nx = cnt > 0u ? cnt : 1u;
}

__device__ __forceinline__ void xcd_barrier(const XcdBarrier& b) {
    asm volatile("s_waitcnt vmcnt(0)" ::: "memory");
    __syncthreads();
    if (b.wv == 0u && lane_id() == 0) {
        unsigned* bar = b.bar;
        __builtin_amdgcn_s_waitcnt(0);
        unsigned nloc = b.st[0], nx = b.st[1];
        if (nloc == 0u) { xcd_barrier_complete(bar, b.x, nloc, nx); b.st[0] = nloc; b.st[1] = nx; }
        const unsigned old = xb_add(&bar[XB_XSUB(b.x)], 1u);
        const unsigned gen = old / nloc;
        if (old + 1u == (gen + 1u) * nloc) {
            __builtin_amdgcn_fence(__ATOMIC_RELEASE, "agent");
            asm volatile("s_waitcnt vmcnt(0)" ::: "memory");
            const unsigned og = xb_add(&bar[XB_TOP], 1u);
            const unsigned tg = og / nx;
            if (og + 1u == (tg + 1u) * nx) xb_add(&bar[XB_TOPGEN], 1u);
            else XB_SPIN(xb_ld(&bar[XB_TOPGEN]) == tg, bar);
            __builtin_amdgcn_fence(__ATOMIC_ACQUIRE, "agent");
            xb_add(&bar[XB_XGEN(b.x)], 1u);
            asm volatile("s_waitcnt vmcnt(0)" ::: "memory");
        } else {
            XB_SPIN(xb_ld(&bar[XB_XGEN(b.x)]) == gen, bar);
            __builtin_amdgcn_fence(__ATOMIC_ACQUIRE, "agent");
            asm volatile("s_waitcnt vmcnt(0)" ::: "memory");
        }
    }
    __syncthreads();
}

namespace pg8 {
struct EpiQRope {
    static constexpr bool PERM = true, AFTER_DRAIN = false;
    bf16_t* O; const float* cosT; const float* sinT;
    __device__ __forceinline__ void operator()(const f32x4 (&acc)[2][2][4][2], const Unit& u, int wr, int wc, int fr, int fq) const {
        const int row0 = u.pm * BM + wr * 64 + fr, colb = u.pn * BM + wc * 32 + 8 * fq;
#pragma unroll
        for (int ai = 0; ai < 2; ++ai)
#pragma unroll
            for (int m = 0; m < 4; ++m) {
                const int row = row0 + ai * HALF + m * 16; const int b = row / RPB, t = row - b * RPB - CTX;
                bf16_t* rowp = O + (size_t)row * 1536;
#pragma unroll
                for (int bj = 0; bj < 2; ++bj) {
                    const int col = colb + bj * HALF; const int hh = col / 192, jj = col - hh * 192;
                    f32x4 v0 = acc[ai][bj][m][0], v1 = acc[ai][bj][m][1];
                    if (jj >= 128 && t >= 0) {
                        const int i0 = (jj - 128) >> 1;
                        const f32x4 c4 = *(const f32x4*)(cosT + (size_t)t * 32 + i0), s4 = *(const f32x4*)(sinT + (size_t)t * 32 + i0);
                        f32x4 w0, w1;
                        w0.x = v0.x * c4.x - v0.y * s4.x; w0.y = v0.x * s4.x + v0.y * c4.x;
                        w0.z = v0.z * c4.y - v0.w * s4.y; w0.w = v0.z * s4.y + v0.w * c4.y;
                        w1.x = v1.x * c4.z - v1.y * s4.z; w1.y = v1.x * s4.z + v1.y * c4.z;
                        w1.z = v1.z * c4.w - v1.w * s4.w; w1.w = v1.z * s4.w + v1.w * c4.w;
                        v0 = w0; v1 = w1;
                    }
                    u32x4 w; w.x = cvt_pk_bf16(v0[0], v0[1]); w.y = cvt_pk_bf16(v0[2], v0[3]); w.z = cvt_pk_bf16(v1[0], v1[1]); w.w = cvt_pk_bf16(v1[2], v1[3]);
                    *(u32x4*)(rowp + col) = w;
                }
            }
    }
};
struct EpiResid {
    static constexpr bool PERM = false, AFTER_DRAIN = false;
    float* X; const float* gate;
    __device__ __forceinline__ void operator()(const f32x4 (&acc)[2][2][4][2], const Unit& u, int wr, int wc, int fr, int fq) const {
        const int row0 = u.pm * BM + wr * 64 + fr, col0 = u.pn * BM + wc * 32 + 4 * fq;
#pragma unroll
        for (int ai = 0; ai < 2; ++ai)
#pragma unroll
            for (int m = 0; m < 4; ++m) {
                const int row = row0 + ai * HALF + m * 16; const float* gp = gate + (size_t)modrow(row) * NMOD + col0; float* xp = X + (size_t)row * DM + col0;
#pragma unroll
                for (int bj = 0; bj < 2; ++bj)
#pragma unroll
                    for (int n = 0; n < 2; ++n) { const int c = bj * HALF + n * 16; const f32x4 g4 = *(const f32x4*)(gp + c); f32x4 x4 = *(const f32x4*)(xp + c); x4 += g4 * acc[ai][bj][m][n]; *(f32x4*)(xp + c) = x4; }
            }
    }
};
}

struct Args { const float* in[22]; float* out; unsigned char* ws; int ph_lo, ph_hi; };
struct Ptrs {
    LAS unsigned char* L;
    __device__ __forceinline__ unsigned long long raw(int i) const { const unsigned long long v = *(volatile LAS unsigned long long*)(L + LDS_CTL_OFF + 64 + 8 * i);
        const unsigned lo = __builtin_amdgcn_readfirstlane((unsigned)v), hi = __builtin_amdgcn_readfirstlane((unsigned)(v >> 32)); return ((unsigned long long)hi << 32) | lo; }
    __device__ __forceinline__ const float* in(int i) const { return (const float*)(GAS const float*)raw(i); }
    __device__ __forceinline__ float* out() const { return (float*)(GAS float*)raw(22); }
    __device__ __forceinline__ unsigned char* ws() const { return (unsigned char*)(GAS unsigned char*)raw(23); }
};

__device__ __forceinline__ void row_load_f32(const float* src, int lane, float (&v)[4][8]) {
#pragma unroll
    for (int i = 0; i < 4; ++i) { const f32x4 a = *(const f32x4*)(src + (lane + 64 * i) * 8), b = *(const f32x4*)(src + (lane + 64 * i) * 8 + 4);
        v[i][0] = a.x; v[i][1] = a.y; v[i][2] = a.z; v[i][3] = a.w; v[i][4] = b.x; v[i][5] = b.y; v[i][6] = b.z; v[i][7] = b.w; }
}
__device__ __forceinline__ void row_store_f32(float* dst, int lane, const float (&v)[4][8]) {
#pragma unroll
    for (int i = 0; i < 4; ++i) { *(f32x4*)(dst + (lane + 64 * i) * 8) = (f32x4){v[i][0], v[i][1], v[i][2], v[i][3]}; *(f32x4*)(dst + (lane + 64 * i) * 8 + 4) = (f32x4){v[i][4], v[i][5], v[i][6], v[i][7]}; }
}
__device__ __forceinline__ float row_rstd(const float (&v)[4][8]) {
    float ss = 0.f;
#pragma unroll
    for (int i = 0; i < 4; ++i)
#pragma unroll
        for (int j = 0; j < 8; ++j) ss += v[i][j] * v[i][j];
    ss = wave_sum(ss);
    return 1.0f / sqrtf(ss * (1.0f / DM) + EPS);
}
__device__ __forceinline__ void norm_mod_store(const float (&v)[4][8], float rstd, const float* g, const float* sh, const float* sc, bf16_t* hrow, int lane) {
#pragma unroll
    for (int i = 0; i < 4; ++i) { const int col = (lane + 64 * i) * 8; float gg[8], ss[8], cc[8];
        *(f32x4*)&gg[0] = *(const f32x4*)(g + col); *(f32x4*)&gg[4] = *(const f32x4*)(g + col + 4);
        *(f32x4*)&ss[0] = *(const f32x4*)(sh + col); *(f32x4*)&ss[4] = *(const f32x4*)(sh + col + 4);
        *(f32x4*)&cc[0] = *(const f32x4*)(sc + col); *(f32x4*)&cc[4] = *(const f32x4*)(sc + col + 4);
        float y[8];
#pragma unroll
        for (int j = 0; j < 8; ++j) y[j] = (v[i][j] * rstd * gg[j]) * (1.f + cc[j]) + ss[j];
        u32x4 o; o.x = cvt_pk(y[0], y[1]); o.y = cvt_pk(y[2], y[3]); o.z = cvt_pk(y[4], y[5]); o.w = cvt_pk(y[6], y[7]);
        *(u32x4*)(hrow + col) = o; }
}

template <class RM>
__device__ __forceinline__ void transpose_item(const float* W, int K, int N, int item, LAS float* scr, int lane, const RM& rm) {
    const int nblk = N / 32, kb = item / nblk, nb = item - kb * nblk, k0 = 64 * kb, n0 = 32 * nb;
#pragma unroll 8
    for (int i = 0; i < 32; ++i) { const int kk = 2 * i + (lane >> 5); scr[kk * 33 + (lane & 31)] = W[(size_t)(k0 + kk) * N + n0 + (lane & 31)]; }
    LDS_WAIT(); asm volatile("" ::: "memory");
    const int c = lane & 7;
#pragma unroll
    for (int j = 0; j < 4; ++j) { const int n = (lane >> 3) + 8 * j; const LAS float* s = scr + (8 * c) * 33 + n;
        u32x4 o; o.x = cvt_pk(s[0], s[33]); o.y = cvt_pk(s[66], s[99]); o.z = cvt_pk(s[132], s[165]); o.w = cvt_pk(s[198], s[231]);
        *(u32x4*)(rm(n0 + n) + k0 + 8 * c) = o; }
    LDS_WAIT(); asm volatile("" ::: "memory");
}

__device__ __forceinline__ void p0a(const Ptrs& A, LAS unsigned char* L, int wave, int bid, int G) { asm volatile("" : "+s"(wave)); const int lane = lane_id(); const int tid = wave * 64 + lane; (void)tid;
    unsigned char* ws = A.ws(); LAUNDER_G(ws);
    {
        LAS float* sl = (LAS float*)L;
        LAS float* red = (LAS float*)(L + 40960);
        for (int i = tid; i < 5 * DM; i += NTHR) { const int r = i / DM, k = i - r * DM; const float c = r < 4 ? A.in(1)[r * DM + k] : A.in(3)[k]; sl[i] = c / (1.f + expf(-c)); }
        __syncthreads();
        float* MOD = (float*)(ws + WS_MOD);
        for (int u = bid; u < DEPTH * 192; u += G) {
            const int l = u / 192, nt = u - l * 192, cg = tid & 15, kg = tid >> 4;
            const float* wp = A.in(4) + ((size_t)l * DM + kg * 64) * NMOD + nt * 64 + cg * 4;
            f32x4 acc[5];
#pragma unroll
            for (int r = 0; r < 5; ++r) acc[r] = (f32x4){0.f, 0.f, 0.f, 0.f};
#pragma unroll 8
            for (int kk = 0; kk < 64; ++kk) { const f32x4 w = *(const f32x4*)(wp + (size_t)kk * NMOD); const int k = kg * 64 + kk;
#pragma unroll
                for (int r = 0; r < 5; ++r) acc[r] += w * sl[r * DM + k]; }
#pragma unroll
            for (int r = 0; r < 5; ++r) *(LAS f32x4*)(red + (kg * 5 + r) * 64 + cg * 4) = acc[r];
            __syncthreads();
            if (tid < 320) { const int r = tid >> 6, col = tid & 63; float s = 0.f;
                for (int g = 0; g < 32; ++g) s += red[(g * 5 + r) * 64 + col];
                MOD[((size_t)l * 5 + r) * NMOD + nt * 64 + col] = s + A.in(5)[l * NMOD + nt * 64 + col]; }
            __syncthreads();
        }
    }
    {
        LAS float* scr = (LAS float*)(L + wave * 16384);
        const int gw = bid * NWAVES + wave, NGW = G * NWAVES;
        constexpr int I_IN = 32 * 123, I_UQ = 8 * 48, I_UKV = 4 * 64, I_SQ = 32 * 64, I_L = I_IN + I_UQ + I_UKV + 2 * I_SQ;
        for (int it = gw; it < DEPTH * I_L; it += NGW) {
            const int l = it / I_L; int r = it - l * I_L;
            if (r < I_IN) {
                bf16_t* mainp = (bf16_t*)(ws + WS_WIN) + (size_t)l * PW * DM; bf16_t* sidep = (bf16_t*)(ws + WS_WSIDE) + (size_t)l * SIDEW * DM;
                transpose_item(A.in(8) + (size_t)l * DM * 3936, DM, 3936, r, scr, lane, [=](int n) -> bf16_t* {
                    return n < 768 ? mainp + (size_t)n * DM : n < 832 ? sidep + (size_t)(n - 768) * DM : n < 3904 ? mainp + (size_t)(n - 64) * DM : sidep + (size_t)(64 + n - 3904) * DM; });
                continue; }
            r -= I_IN;
            if (r < I_UQ) {
                bf16_t* dst = (bf16_t*)(ws + WS_WUQ) + (size_t)l * 1536 * 512;
                transpose_item(A.in(11) + (size_t)l * 512 * 1536, 512, 1536, r, scr, lane, [=](int n) -> bf16_t* {
                    const int hh = n / 192, j = n - hh * 192; const int jn = j < 128 ? j : (j < 160 ? 128 + 2 * (j - 128) : 128 + 2 * (j - 160) + 1); return dst + (size_t)(hh * 192 + jn) * 512; });
                continue; }
            r -= I_UQ;
            if (r < I_UKV) { bf16_t* dst = (bf16_t*)(ws + WS_WUKV) + (size_t)l * 2048 * 256;
                transpose_item(A.in(12) + (size_t)l * 256 * 2048, 256, 2048, r, scr, lane, [=](int n) -> bf16_t* { return dst + (size_t)n * 256; }); continue; }
            r -= I_UKV;
            if (r < I_SQ) { bf16_t* dst = (bf16_t*)(ws + WS_WOUT) + (size_t)l * DM * DM;
                transpose_item(A.in(16) + (size_t)l * DM * DM, DM, DM, r, scr, lane, [=](int n) -> bf16_t* { return dst + (size_t)n * DM; }); continue; }
            r -= I_SQ;
            { bf16_t* dst = (bf16_t*)(ws + WS_WQRY) + (size_t)l * DM * DM;
                transpose_item(A.in(17) + (size_t)l * DM * DM, DM, DM, r, scr, lane, [=](int n) -> bf16_t* { return dst + (size_t)n * DM; }); }
        }
    }
    {
        const size_t gt = (size_t)bid * NTHR + tid, NT = (size_t)G * NTHR;
        {
            const int gw = bid * NWAVES + wave, NGW = G * NWAVES;
            for (int rr = gw; rr < 2 * DEPTH * NEXP; rr += NGW) { const bool isu = rr < DEPTH * NEXP; const int row = isu ? rr : rr - DEPTH * NEXP;
                const float* src = (isu ? A.in(19) : A.in(20)) + (size_t)row * DM;
                f32x4 x[8]; float ss = 0.f;
#pragma unroll
                for (int i = 0; i < 8; ++i) { x[i] = *(const f32x4*)(src + (lane + 64 * i) * 4); ss += (x[i].x * x[i].x + x[i].y * x[i].y) + (x[i].z * x[i].z + x[i].w * x[i].w); }
                ss = wave_sum(ss); const float rms = sqrtf(ss * (1.0f / DM));
                u32x4 p; float sc;
                if (isu) { sc = rms > 0.f ? rms * (1.0f / 3.0f) : 1.0f; const float inv = 1.0f / sc;
#pragma unroll
                    for (int w = 0; w < 4; ++w) { const f32x4 a = x[2 * w], c = x[2 * w + 1]; const float av[4] = {a.x, a.y, a.z, a.w}, cv[4] = {c.x, c.y, c.z, c.w}; unsigned d = 0u;
#pragma unroll
                        for (int b = 0; b < 4; ++b) { const int n0 = (int)fminf(fmaxf(floorf(av[b] * inv + 8.0f), 0.f), 15.f), n1 = (int)fminf(fmaxf(floorf(cv[b] * inv + 8.0f), 0.f), 15.f);
                            d |= ((unsigned)n0 << (8 * b)) | ((unsigned)n1 << (8 * b + 4)); }
                        p[w] = d; }
                } else { sc = rms > 0.f ? rms * 0.5f : 1.0f; const float inv = 1.0f / sc;
#pragma unroll
                    for (int w = 0; w < 4; ++w) { const f32x4 a = x[2 * w], c = x[2 * w + 1]; unsigned d = 0u;
#define Q4C(v) fminf(fmaxf((v) * inv, -6.0f), 6.0f)
                        d = __builtin_amdgcn_cvt_scalef32_pk_fp4_f32(d, Q4C(a.x), Q4C(a.y), 1.0f, 0); d = __builtin_amdgcn_cvt_scalef32_pk_fp4_f32(d, Q4C(a.z), Q4C(a.w), 1.0f, 1);
                        d = __builtin_amdgcn_cvt_scalef32_pk_fp4_f32(d, Q4C(c.x), Q4C(c.y), 1.0f, 2); d = __builtin_amdgcn_cvt_scalef32_pk_fp4_f32(d, Q4C(c.z), Q4C(c.w), 1.0f, 3);
#undef Q4C
                        p[w] = d; } }
                unsigned char* dst = ws + (isu ? WS_EU : WS_EV) + (size_t)row * EROW;
                *(u32x4*)(dst + lane * 16) = p;
                if (lane == 0) ((float*)(ws + (isu ? WS_SU : WS_SV)))[row] = sc; } }
        const size_t s8 = (size_t)DEPTH * 2 * 8 * 128 * 128 / 8;
        for (size_t i = gt; i < s8; i += NT) { const float* src = A.in(18) + i * 8;
            const f32x4 a = *(const f32x4*)src, b = *(const f32x4*)(src + 4); u32x4 o; o.x = cvt_pk(a.x, a.y); o.y = cvt_pk(a.z, a.w); o.z = cvt_pk(b.x, b.y); o.w = cvt_pk(b.z, b.w);
            *(u32x4*)((bf16_t*)(ws + WS_SUBK) + i * 8) = o; }
        float* cosT = (float*)(ws + WS_ROPE); float* sinT = cosT + SEQ * 32;
        for (size_t i = gt; i < (size_t)SEQ * 32; i += NT) { const int t = (int)(i >> 5), a = (int)(i & 31), m = a & 15; const int pos = a < 16 ? (t >> 6) : (t & 63);
            const float inv = 1.0f / powf(10000.0f, (float)(2 * m) / 32.0f); const float ang = (float)pos * inv; cosT[i] = cosf(ang); sinT[i] = sinf(ang); }
    }
}

__device__ __forceinline__ void p0b(const Ptrs& A, int wave, int bid, int G) { asm volatile("" : "+s"(wave)); const int lane = lane_id();
    unsigned char* ws = A.ws(); LAUNDER_G(ws); const int gw = bid + G * wave, NGW = G * NWAVES;
    const float* MOD = (const float*)(ws + WS_MOD);
    for (int r = gw; r < NTOK; r += NGW) {
        const int b = r / RPB, j = r - b * RPB; const float* src = j < CTX ? A.in(2) + ((size_t)b * CTX + j) * DM : A.in(0) + ((size_t)b * SEQ + (j - CTX)) * DM;
        float v[4][8]; row_load_f32(src, lane, v); row_store_f32((float*)(ws + WS_XRES) + (size_t)r * DM, lane, v);
        const float rstd = row_rstd(v); const float* mp = MOD + (size_t)(j < CTX ? 4 : b) * NMOD;
        norm_mod_store(v, rstd, A.in(6), mp, mp + DM, (bf16_t*)(ws + WS_H) + (size_t)r * DM, lane);
    }
}

__device__ __forceinline__ void side_gemm(const Ptrs& A, LAS unsigned char* L, int l, int wave, int bid, int G) { asm volatile("" : "+s"(wave)); const int lane = lane_id(); const int tid = wave * 64 + lane;
    unsigned char* ws = A.ws(); LAUNDER_G(ws); const bf16_t* H = (const bf16_t*)(ws + WS_H); const bf16_t* W = (const bf16_t*)(ws + WS_WSIDE) + (size_t)l * SIDEW * DM; float* SIDE = (float*)(ws + WS_SIDE);
    LAS float* red = (LAS float*)L;
    for (int u = bid; u < NTOK / 32; u += G) {
        const int rbase = u * 32;
        f32x4 acc[2][6];
#pragma unroll
        for (int rb = 0; rb < 2; ++rb)
#pragma unroll
            for (int cb = 0; cb < 6; ++cb) acc[rb][cb] = (f32x4){0.f, 0.f, 0.f, 0.f};
        const bf16_t* ap = H + (size_t)(rbase + (lane & 15)) * DM + wave * 256 + 8 * (lane >> 4);
        const bf16_t* bp = W + (size_t)(lane & 15) * DM + wave * 256 + 8 * (lane >> 4);
#pragma unroll
        for (int kh = 0; kh < 2; ++kh) {
            bf16x8 a[2][4], bq[6][4];
#pragma unroll
            for (int ks = 0; ks < 4; ++ks) {
#pragma unroll
                for (int rb = 0; rb < 2; ++rb) a[rb][ks] = *(const bf16x8*)(ap + (size_t)rb * 16 * DM + (kh * 4 + ks) * 32);
#pragma unroll
                for (int cb = 0; cb < 6; ++cb) bq[cb][ks] = *(const bf16x8*)(bp + (size_t)cb * 16 * DM + (kh * 4 + ks) * 32); }
#pragma unroll
            for (int ks = 0; ks < 4; ++ks)
#pragma unroll
                for (int rb = 0; rb < 2; ++rb)
#pragma unroll
                    for (int cb = 0; cb < 6; ++cb) acc[rb][cb] = __builtin_amdgcn_mfma_f32_16x16x32_bf16(a[rb][ks], bq[cb][ks], acc[rb][cb], 0, 0, 0);
        }
#pragma unroll
        for (int rb = 0; rb < 2; ++rb)
#pragma unroll
            for (int cb = 0; cb < 6; ++cb)
#pragma unroll
                for (int rg = 0; rg < 4; ++rg) red[(wave * 32 + rb * 16 + (lane >> 4) * 4 + rg) * 96 + cb * 16 + (lane & 15)] = acc[rb][cb][rg];
        __syncthreads();
        for (int i = tid; i < 32 * 96 / 4; i += NTHR) { f32x4 s = *(const LAS f32x4*)(red + i * 4);
#pragma unroll
            for (int w = 1; w < 8; ++w) s += *(const LAS f32x4*)(red + w * 32 * 96 + i * 4);
            *(f32x4*)(SIDE + (size_t)rbase * SIDEW + i * 4) = s; }
        __syncthreads();
    }
}

constexpr int CG_A = 0, CG_B = 16384, CG_BUF = 49152;
template <class F>
__device__ __forceinline__ void ctx_gemm(LAS unsigned char* L, const bf16_t* Ab, int lda, const bf16_t* Wt, int ldb, int N, int K, int wave, int bid, int G, const F& f) { asm volatile("" : "+s"(wave)); const int lane = lane_id(); const int tid = wave * 64 + lane;
    const int r32 = lane & 31, hi = lane >> 5, wr = wave >> 2, wc = wave & 3, ncu = N / 128, nch = K / 128;
    for (int u = bid; u < 16 * ncu; u += G) {
        const int mt = u / ncu, nt = u - mt * ncu; const int m0 = mt * 64, row0 = (m0 >> 8) * RPB + (m0 & 255), col0 = nt * 128;
        const int cch = tid & 15, ra = tid >> 4;
        const bf16_t* ga = Ab + (size_t)(row0 + ra) * lda + cch * 8; const bf16_t* gb = Wt + (size_t)(col0 + ra) * ldb + cch * 8;
        u32x4 sa[2], sb[4];
#define CG_LOAD(k0) do { sa[0] = *(const u32x4*)(ga + (k0)); sa[1] = *(const u32x4*)(ga + (size_t)32 * lda + (k0)); \
        _Pragma("unroll") for (int i = 0; i < 4; ++i) sb[i] = *(const u32x4*)(gb + (size_t)(32 * i) * ldb + (k0)); } while (0)
#define CG_WRITE(buf) do { _Pragma("unroll") for (int i = 0; i < 2; ++i) { const int row = ra + 32 * i; *(LAS u32x4*)(L + (buf) * CG_BUF + CG_A + row * 256 + ((cch ^ (row & 15)) << 4)) = sa[i]; } \
        _Pragma("unroll") for (int i = 0; i < 4; ++i) { const int row = ra + 32 * i; *(LAS u32x4*)(L + (buf) * CG_BUF + CG_B + row * 256 + ((cch ^ (row & 15)) << 4)) = sb[i]; } } while (0)
        f32x16 acc;
#pragma unroll
        for (int r = 0; r < 16; ++r) acc[r] = 0.f;
        CG_LOAD(0); CG_WRITE(0);
        __syncthreads();
#pragma unroll 1
        for (int ch = 0; ch < nch; ++ch) { const int buf = ch & 1;
            if (ch + 1 < nch) CG_LOAD((ch + 1) * 128);
#pragma unroll
            for (int ks = 0; ks < 8; ++ks) { const int cc = ks * 2 + hi;
                const bf16x8 a = *(const LAS bf16x8*)(L + buf * CG_BUF + CG_A + (32 * wr + r32) * 256 + ((cc ^ (r32 & 15)) << 4)), bq = *(const LAS bf16x8*)(L + buf * CG_BUF + CG_B + (32 * wc + r32) * 256 + ((cc ^ (r32 & 15)) << 4));
                acc = __builtin_amdgcn_mfma_f32_32x32x16_bf16(a, bq, acc, 0, 0, 0); }
            if (ch + 1 < nch) CG_WRITE(buf ^ 1);
            __syncthreads(); }
#undef CG_LOAD
#undef CG_WRITE
#pragma unroll
        for (int r = 0; r < 16; ++r) f(row0 + 32 * wr + crow(r, hi), col0 + 32 * wc + r32, acc[r]);
    }
}

__device__ __forceinline__ void thin_rows(const Ptrs& A, int l, int wave, int bid, int G) { asm volatile("" : "+s"(wave)); const int lane = lane_id();
    unsigned char* ws = A.ws(); LAUNDER_G(ws); const int nx5 = (NGU % G) * 2 < G ? NGU % G : 0;
    if (bid < nx5) return;
    const int gw = (bid - nx5) + (G - nx5) * wave, NGW = (G - nx5) * NWAVES;
    bf16_t* P = (bf16_t*)(ws + WS_P); const float* SIDE = (const float*)(ws + WS_SIDE); bf16_t* KR = (bf16_t*)(ws + WS_KR);
    const float* cosT = (const float*)(ws + WS_ROPE); const float* sinT = cosT + SEQ * 32;
    const float* gq = A.in(9) + l * 512; const float* gkv = A.in(10) + l * 256;
    for (int r = gw; r < NTOK; r += NGW) {
        bf16_t* pr = P + (size_t)r * PW;
        { const u32x4 w = *(const u32x4*)(pr + P_CQ + lane * 8); float x[8] = {bflo(w.x), bfhi(w.x), bflo(w.y), bfhi(w.y), bflo(w.z), bfhi(w.z), bflo(w.w), bfhi(w.w)};
          float ss = 0.f;
#pragma unroll
          for (int j = 0; j < 8; ++j) ss += x[j] * x[j];
          ss = wave_sum(ss); const float rstd = 1.0f / sqrtf(ss * (1.0f / 512.f) + EPS);
          const f32x4 g0 = *(const f32x4*)(gq + lane * 8), g1 = *(const f32x4*)(gq + lane * 8 + 4);
          u32x4 o; o.x = cvt_pk(x[0] * rstd * g0.x, x[1] * rstd * g0.y); o.y = cvt_pk(x[2] * rstd * g0.z, x[3] * rstd * g0.w); o.z = cvt_pk(x[4] * rstd * g1.x, x[5] * rstd * g1.y); o.w = cvt_pk(x[6] * rstd * g1.z, x[7] * rstd * g1.w);
          *(u32x4*)(pr + P_CQ + lane * 8) = o; }
        { const u32x2 w = *(const u32x2*)(pr + P_CKV + lane * 4); float x[4] = {bflo(w.x), bfhi(w.x), bflo(w.y), bfhi(w.y)};
          float ss = x[0] * x[0] + x[1] * x[1] + x[2] * x[2] + x[3] * x[3];
          ss = wave_sum(ss); const float rstd = 1.0f / sqrtf(ss * (1.0f / 256.f) + EPS);
          const f32x4 g0 = *(const f32x4*)(gkv + lane * 4);
          u32x2 o; o.x = cvt_pk(x[0] * rstd * g0.x, x[1] * rstd * g0.y); o.y = cvt_pk(x[2] * rstd * g0.z, x[3] * rstd * g0.w);
          *(u32x2*)(pr + P_CKV + lane * 4) = o; }
        if (lane < 32) { const float x1 = SIDE[(size_t)r * SIDEW + lane], x2 = SIDE[(size_t)r * SIDEW + 32 + lane];
          const int b = r / RPB, t = r - b * RPB - CTX; float y1 = x1, y2 = x2;
          if (t >= 0) { const float cs = cosT[(size_t)t * 32 + lane], sn = sinT[(size_t)t * 32 + lane]; y1 = x1 * cs - x2 * sn; y2 = x1 * sn + x2 * cs; }
          *(unsigned*)(KR + (size_t)r * 64 + 2 * lane) = cvt_pk(y1, y2); }
    }
}

constexpr int G1_LR = 0, G1_WG = 8192, G1_BG = 24576, G1_GT = 25600, G1_QD = 29696, G1_KD = G1_QD + 64 * 272, G1_KET = G1_KD + 64 * 272, G1_VT = G1_KET + 128 * 144, G1_AS = G1_VT + 256 * 144, G1_END = G1_AS + 64 * 144;
constexpr int G1_RAWV = G1_QD;
constexpr int G1_RAW = G1_END;
static_assert(G1_RAWV + 32768 <= G1_VT && G1_RAW + 32768 <= LDS_CTL_OFF, "G1 LDS map");

__device__ __forceinline__ void g1_mma(LAS unsigned char* L, f32x16& Aacc, const bf16x8 (&av)[4], bf16_t* dsp, int lane, int wave) {
    const int r32 = lane & 31, hi = lane >> 5;
    if (wave < 4) { const int mb = wave >> 1, nb = wave & 1;
#pragma unroll
        for (int r = 0; r < 16; ++r) Aacc[r] = 0.f;
#pragma unroll
        for (int ks = 0; ks < 8; ++ks) { const bf16x8 a = *(const LAS bf16x8*)(L + G1_QD + (32 * mb + r32) * 272 + ks * 32 + hi * 16), bq = *(const LAS bf16x8*)(L + G1_KD + (32 * nb + r32) * 272 + ks * 32 + hi * 16);
            Aacc = __builtin_amdgcn_mfma_f32_32x32x16_bf16(a, bq, Aacc, 0, 0, 0); } }
#pragma unroll
    for (int db = 0; db < 4; ++db) { f32x16 acc;
#pragma unroll
        for (int r = 0; r < 16; ++r) acc[r] = 0.f;
#pragma unroll
        for (int ks = 0; ks < 4; ++ks) { const bf16x8 bk = *(const LAS bf16x8*)(L + G1_KET + (32 * db + r32) * 144 + ks * 32 + hi * 16); acc = __builtin_amdgcn_mfma_f32_32x32x16_bf16(av[ks], bk, acc, 0, 0, 0); }
        LAS unsigned char* slab = L + G1_RAW + wave * 4096;
#pragma unroll
        for (int r = 0; r < 16; r += 2) {
            const float x0 = acc[r], x1 = acc[r + 1];
            const float n0 = __builtin_bit_cast(float, __builtin_amdgcn_mov_dpp(__builtin_bit_cast(int, x0), 0xB1, 0xF, 0xF, true)), n1 = __builtin_bit_cast(float, __builtin_amdgcn_mov_dpp(__builtin_bit_cast(int, x1), 0xB1, 0xF, 0xF, true));
            const bool odd = r32 & 1;
            const unsigned pk = odd ? cvt_pk_safe(n1, x1) : cvt_pk_safe(x0, n0);
            *(LAS unsigned*)(slab + crow(r + (odd ? 1 : 0), hi) * 128 + (db & 1) * 64 + (r32 >> 1) * 4) = pk; }
        if (db & 1) {
#pragma unroll
            for (int i = 0; i < 4; ++i) { const int idx = lane + 64 * i, row = idx >> 3, ch = idx & 7;
                *(u32x4*)(dsp + (size_t)(32 * wave + row) * 128 + (db >> 1) * 64 + ch * 8) = *(const LAS u32x4*)(slab + row * 128 + ch * 16); } } }
}

template <int DIR>
__device__ __forceinline__ void g1_dir(const Ptrs& A, unsigned char* ws, LAS unsigned char* L, int l, int u, int bh, int c, int h, int r0, f32x16& Aacc, const bf16x8 (&av)[4], const float (&qv)[16], const float (&kv)[16], int tid, int lane, int wave) {
    LAS float* lr = (LAS float*)(L + G1_LR); LAS float* wg = (LAS float*)(L + G1_WG); LAS float* bg = (LAS float*)(L + G1_BG); LAS float* gt = (LAS float*)(L + G1_GT);
    const int d = tid & 127, pg = tid >> 7;
    float cum[16];
    {
        float wv[16];
#pragma unroll
        for (int rr = 0; rr < 16; ++rr) wv[rr] = wg[(DIR * 16 + rr) * 128 + d];
        const float bias = bg[DIR * 128 + d];
#pragma unroll
        for (int i = 0; i < 16; ++i) { const LAS float* lp = lr + (DIR * 64 + pg * 16 + i) * 16; float z = bias;
#pragma unroll
            for (int rr = 0; rr < 16; ++rr) z += lp[rr] * wv[rr];
            cum[i] = -(fmaxf(-z, 0.f) + __logf(1.0f + __expf(-fabsf(z)))) * (1.0f / 16.0f); }
    }
    if (DIR == 0) {
#pragma unroll
        for (int i = 1; i < 16; ++i) cum[i] += cum[i - 1];
        gt[(DIR * 4 + pg) * 128 + d] = cum[15];
    } else {
#pragma unroll
        for (int i = 14; i >= 0; --i) cum[i] += cum[i + 1];
        gt[(DIR * 4 + pg) * 128 + d] = cum[0];
    }
    __syncthreads();
    float off = 0.f, last = 0.f;
#pragma unroll
    for (int g = 0; g < 4; ++g) { const float t = gt[(DIR * 4 + g) * 128 + d]; last += t; if (DIR == 0 ? (g < pg) : (g > pg)) off += t; }
    bf16_t* qdec = (bf16_t*)(ws + WS_QDEC) + ((size_t)u * 2 + DIR) * 8192;
    const float elast = __expf(last);
    unsigned ke[8];
#pragma unroll
    for (int i = 0; i < 16; i += 2) {
        const int p = pg * 16 + i;
        const float q0 = qv[i], q1 = qv[i + 1], k0 = kv[i], k1 = kv[i + 1];
        const float c0 = cum[i] + off, c1 = cum[i + 1] + off;
        const float e0 = __expf(c0), e1 = __expf(c1), n0 = __expf(-c0), n1 = __expf(-c1);
        const bf16_t qa = f2bf(q0 * e0), qb = f2bf(q1 * e1);
        *(LAS bf16_t*)(L + G1_QD + p * 272 + d * 2) = qa; *(LAS bf16_t*)(L + G1_QD + (p + 1) * 272 + d * 2) = qb;
        *(LAS bf16_t*)(L + G1_KD + p * 272 + d * 2) = f2bf(k0 * n0); *(LAS bf16_t*)(L + G1_KD + (p + 1) * 272 + d * 2) = f2bf(k1 * n1);
        ke[i >> 1] = cvt_pk(k0 * n0 * elast, k1 * n1 * elast);
    }
    *(LAS u32x4*)(L + G1_KET + d * 144 + pg * 32) = (u32x4){ke[0], ke[1], ke[2], ke[3]};
    *(LAS u32x4*)(L + G1_KET + d * 144 + pg * 32 + 16) = (u32x4){ke[4], ke[5], ke[6], ke[7]};
    if (pg == 0) ((float*)(ws + WS_DEC))[((size_t)(DIR * 16 + bh) * NCH + c) * 128 + d] = elast;
    __syncthreads();
#pragma unroll
    for (int i = 0; i < 2; ++i) { const int idx = tid + 512 * i, row = idx >> 4, ch = idx & 15;
        *(u32x4*)(qdec + row * 128 + ch * 8) = *(const LAS u32x4*)(L + G1_QD + row * 272 + ch * 16); }
    g1_mma(L, Aacc, av, (bf16_t*)(ws + WS_DS) + ((size_t)(DIR * 16 + bh) * NCH + c) * 32768, lane, wave);
}

__device__ __forceinline__ void gla_g1(const Ptrs& A, LAS unsigned char* L, int l, int u, int wave) { asm volatile("" : "+s"(wave)); const int lane = lane_id(); const int tid = wave * 64 + lane; (void)tid;
    unsigned char* ws = A.ws(); LAUNDER_G(ws);
    const int bh = u / NCH, c = u - bh * NCH, b = bh >> 2, h = bh & 3, r0 = b * RPB + c * 64;
    const bf16_t* P = (const bf16_t*)(ws + WS_P); const float* SIDE = (const float*)(ws + WS_SIDE);
    LAS float* lr = (LAS float*)(L + G1_LR); LAS float* wg = (LAS float*)(L + G1_WG); LAS float* bg = (LAS float*)(L + G1_BG);
    { const int p = tid >> 3, q = tid & 7, dir = q >> 2, rr4 = (q & 3) * 4;
      *(LAS f32x4*)(lr + (dir * 64 + p) * 16 + rr4) = *(const f32x4*)(SIDE + (size_t)(r0 + p) * SIDEW + 64 + dir * 16 + rr4); }
#pragma unroll
    for (int i = 0; i < 2; ++i) { const int idx = (tid * 2 + i) * 4, dir = idx >> 11, rr = (idx >> 7) & 15, d4 = idx & 127;
      *(LAS f32x4*)(wg + idx) = *(const f32x4*)(A.in(13) + ((size_t)(l * 2 + dir) * 16 + rr) * 512 + h * 128 + d4); }
    if (tid < 256) bg[tid] = A.in(14)[(l * 2 + (tid >> 7)) * 512 + h * 128 + (tid & 127)];
#pragma unroll
    for (int i = 0; i < 2; ++i) { const int idx = tid + 512 * i, row = idx >> 4, ch = idx & 15; const bf16_t* src = P + (size_t)(r0 + row) * PW + h * 128 + ch * 8;
        *(LAS u32x4*)(L + G1_RAW + row * 256 + ch * 16) = *(const u32x4*)(src + P_GQ); *(LAS u32x4*)(L + G1_RAW + 16384 + row * 256 + ch * 16) = *(const u32x4*)(src + P_GK); }
#pragma unroll
    for (int i = 0; i < 4; ++i) { const int idx = tid + 512 * i, row = idx >> 5, ch = idx & 31;
        *(LAS u32x4*)(L + G1_RAWV + row * 512 + ch * 16) = *(const u32x4*)(P + (size_t)(r0 + row) * PW + P_GV + h * 256 + ch * 8); }
    __syncthreads();
    float qv[16], kv[16];
#pragma unroll
    for (int i = 0; i < 16; ++i) { const int off = ((tid >> 7) * 16 + i) * 256 + (tid & 127) * 2; qv[i] = bf2f(*(const LAS bf16_t*)(L + G1_RAW + off)) * 0.08838834764831845f; kv[i] = bf2f(*(const LAS bf16_t*)(L + G1_RAW + 16384 + off)); }
    { const int e = tid & 255, ph = tid >> 8;
      unsigned w[16];
#pragma unroll
      for (int i = 0; i < 16; ++i) w[i] = (unsigned)*(const LAS bf16_t*)(L + G1_RAWV + (ph * 32 + 2 * i) * 512 + e * 2) | ((unsigned)*(const LAS bf16_t*)(L + G1_RAWV + (ph * 32 + 2 * i + 1) * 512 + e * 2) << 16);
#pragma unroll
      for (int i = 0; i < 4; ++i) *(LAS u32x4*)(L + G1_VT + e * 144 + ph * 64 + i * 16) = (u32x4){w[4 * i], w[4 * i + 1], w[4 * i + 2], w[4 * i + 3]}; }
    __syncthreads();
    const int r32 = lane & 31, hi = lane >> 5;
    bf16x8 av[4];
#pragma unroll
    for (int ks = 0; ks < 4; ++ks) av[ks] = *(const LAS bf16x8*)(L + G1_VT + (32 * wave + r32) * 144 + ks * 32 + hi * 16);
    f32x16 Af, Ab;
    g1_dir<0>(A, ws, L, l, u, bh, c, h, r0, Af, av, qv, kv, tid, lane, wave);
    __syncthreads();
    g1_dir<1>(A, ws, L, l, u, bh, c, h, r0, Ab, av, qv, kv, tid, lane, wave);
    if (wave < 4) { const int mb = wave >> 1, nb = wave & 1;
#pragma unroll
        for (int r = 0; r < 16; ++r) { const int cc = 32 * mb + crow(r, hi), jj = 32 * nb + r32; const float v = (jj <= cc ? Af[r] : 0.f) + (jj >= cc ? Ab[r] : 0.f);
            *(LAS bf16_t*)(L + G1_AS + cc * 144 + jj * 2) = f2bf(v); } }
    __syncthreads();
    float* OI = (float*)(ws + WS_OINTRA);
#pragma unroll
    for (int mb = 0; mb < 2; ++mb) { f32x16 acc;
#pragma unroll
        for (int r = 0; r < 16; ++r) acc[r] = 0.f;
#pragma unroll
        for (int ks = 0; ks < 4; ++ks) { const bf16x8 a = *(const LAS bf16x8*)(L + G1_AS + (32 * mb + r32) * 144 + ks * 32 + hi * 16); acc = __builtin_amdgcn_mfma_f32_32x32x16_bf16(a, av[ks], acc, 0, 0, 0); }
        float* op = OI + (size_t)(r0 + 32 * mb) * 1024 + h * 256 + 32 * wave + r32;
#pragma unroll
        for (int r = 0; r < 16; ++r) op[(size_t)crow(r, hi) * 1024] = acc[r]; }
    __syncthreads();
}

__device__ __forceinline__ void gla_g2(const Ptrs& A, int wave, int bid, int G) { const int tid = wave * 64 + lane_id();
    unsigned char* ws = A.ws(); LAUNDER_G(ws); const bf16_t* DS = (const bf16_t*)(ws + WS_DS); const float* DEC = (const float*)(ws + WS_DEC); bf16_t* SENT = (bf16_t*)(ws + WS_SENT);
    const int NT = G * NTHR;
    for (int it = bid * NTHR + tid; it < 2 * 16 * 256 * 16; it += NT) {
        const int d8 = it & 15, e = (it >> 4) & 255, db = it >> 12;
        const int dir = db >> 4;
        const size_t base = (size_t)db * NCH * 32768 + (size_t)e * 128 + d8 * 8, dbase = (size_t)db * NCH * 128 + d8 * 8;
        f32x4 s0 = (f32x4){0.f, 0.f, 0.f, 0.f}, s1 = (f32x4){0.f, 0.f, 0.f, 0.f};
#pragma unroll 4
        for (int st = 0; st < NCH; ++st) { const int c = dir == 0 ? st : (st < 4 ? 3 - st : NCH + 3 - st);
            const u32x4 dw = *(const u32x4*)(DS + base + (size_t)c * 32768); const f32x4 dc0 = *(const f32x4*)(DEC + dbase + (size_t)c * 128), dc1 = *(const f32x4*)(DEC + dbase + (size_t)c * 128 + 4);
            const unsigned w0 = dw.x, w1 = dw.y, w2 = dw.z, w3 = dw.w;
            const f32x4 ds0 = (f32x4){bflo(w0), bfhi(w0), bflo(w1), bfhi(w1)}, ds1 = (f32x4){bflo(w2), bfhi(w2), bflo(w3), bfhi(w3)};
            u32x4 o; o.x = cvt_pk(s0.x, s0.y); o.y = cvt_pk(s0.z, s0.w); o.z = cvt_pk(s1.x, s1.y); o.w = cvt_pk(s1.z, s1.w); *(u32x4*)(SENT + base + (size_t)c * 32768) = o;
            s0 = dc0 * s0 + ds0; s1 = dc1 * s1 + ds1; }
    }
}

constexpr int G3_A = 0, G3_OUT = 32768, G3_ROWB = 528, G3_GG = G3_OUT + 64 * G3_ROWB, G3_SSQ = G3_GG + 64 * G3_ROWB, G3_RSTD = G3_SSQ + 2048, G3_END = G3_RSTD + 256;
static_assert(G3_END <= LDS_CTL_OFF, "G3 LDS map");
__device__ __forceinline__ void gla_g3(const Ptrs& A, LAS unsigned char* L, int l, int u, int wave) { asm volatile("" : "+s"(wave)); const int lane = lane_id(); const int tid = wave * 64 + lane;
    unsigned char* ws = A.ws(); LAUNDER_G(ws);
    const int bh = u / NCH, c = u - bh * NCH, b = bh >> 2, h = bh & 3, r0 = b * RPB + c * 64, r32 = lane & 31, hi = lane >> 5;
    const bf16_t* qa = (const bf16_t*)(ws + WS_QDEC) + (size_t)u * 2 * 8192; const bf16_t* SENT = (const bf16_t*)(ws + WS_SENT);
    const bf16_t* P = (const bf16_t*)(ws + WS_P); bf16_t* MIX = (bf16_t*)(ws + WS_MIX);
#pragma unroll
    for (int i = 0; i < 4; ++i) { const int idx = tid + 512 * i, dir = idx >> 10, rem = idx & 1023, row = rem >> 4, cc = rem & 15;
        *(LAS u32x4*)(L + G3_A + dir * 16384 + row * 256 + ((cc ^ (row & 15)) << 4)) = *(const u32x4*)(qa + dir * 8192 + row * 128 + cc * 8);
        const int grow = idx >> 5, gch = idx & 31;
        *(LAS u32x4*)(L + G3_GG + grow * G3_ROWB + gch * 16) = *(const u32x4*)(P + (size_t)(r0 + grow) * PW + P_GG + h * 256 + gch * 8); }
    bf16x8 bb[16];
#pragma unroll
    for (int ks = 0; ks < 16; ++ks) { const int dir = ks >> 3, kk = (ks & 7) * 16 + 8 * hi;
        bb[ks] = *(const bf16x8*)(SENT + ((size_t)(dir * 16 + bh) * NCH + c) * 32768 + (size_t)(32 * wave + r32) * 128 + kk); }
    float v[32];
    { const float* oi = (const float*)(ws + WS_OINTRA) + (size_t)r0 * 1024 + h * 256 + 32 * wave + r32;
#pragma unroll
      for (int r = 0; r < 16; ++r) { v[r] = oi[(size_t)crow(r, hi) * 1024]; v[16 + r] = oi[(size_t)(32 + crow(r, hi)) * 1024]; } }
    __syncthreads();
    f32x16 acc0, acc1;
#pragma unroll
    for (int r = 0; r < 16; ++r) { acc0[r] = 0.f; acc1[r] = 0.f; }
#pragma unroll
    for (int ks = 0; ks < 16; ++ks) { const int dir = ks >> 3, cc = (ks & 7) * 2 + hi;
        const bf16x8 a0 = *(const LAS bf16x8*)(L + G3_A + dir * 16384 + r32 * 256 + ((cc ^ (r32 & 15)) << 4)), a1 = *(const LAS bf16x8*)(L + G3_A + dir * 16384 + (32 + r32) * 256 + ((cc ^ (r32 & 15)) << 4));
        acc0 = __builtin_amdgcn_mfma_f32_32x32x16_bf16(a0, bb[ks], acc0, 0, 0, 0); acc1 = __builtin_amdgcn_mfma_f32_32x32x16_bf16(a1, bb[ks], acc1, 0, 0, 0); }
#pragma unroll
    for (int r = 0; r < 16; ++r) { v[r] += acc0[r]; v[16 + r] += acc1[r]; }
    {
        float t[32];
#pragma unroll
        for (int q = 0; q < 32; ++q) t[q] = v[q] * v[q];
#pragma unroll
        for (int s_ = 0; s_ < 5; ++s_) { const int half = 16 >> s_; const bool bit = (r32 >> s_) & 1;
#pragma unroll
            for (int i = 0; i < half; ++i) { const float send = bit ? t[i] : t[i + half], keep = bit ? t[i + half] : t[i]; t[i] = keep + shx_f(send, 1 << s_); } }
        const int q = ((r32 & 1) << 4) | ((r32 & 2) << 2) | (r32 & 4) | ((r32 & 8) >> 2) | ((r32 & 16) >> 4);
        const int row = 32 * (q >> 4) + crow(q & 15, hi);
        ((LAS float*)(L + G3_SSQ))[row * 8 + wave] = t[0];
    }
    __syncthreads();
    if (tid < 64) { const f32x4 sa = *(const LAS f32x4*)(L + G3_SSQ + tid * 32), sb = *(const LAS f32x4*)(L + G3_SSQ + tid * 32 + 16);
        ((LAS float*)(L + G3_RSTD))[tid] = 1.0f / sqrtf(((sa.x + sa.y) + (sa.z + sa.w) + (sb.x + sb.y) + (sb.z + sb.w)) * (1.0f / 256.f) + EPS); }
    __syncthreads();
    const float g = A.in(15)[l * 256 + 32 * wave + r32];
#pragma unroll
    for (int q = 0; q < 32; ++q) { const int row = 32 * (q >> 4) + crow(q & 15, hi);
        const float rstd = ((const LAS float*)(L + G3_RSTD))[row];
        const float gg = bf2f(*(const LAS bf16_t*)(L + G3_GG + row * G3_ROWB + (32 * wave + r32) * 2));
        *(LAS bf16_t*)(L + G3_OUT + row * G3_ROWB + (32 * wave + r32) * 2) = f2bf((v[q] * rstd * g) * (gg / (1.f + __expf(-gg)))); }
    __syncthreads();
#pragma unroll
    for (int i = 0; i < 4; ++i) { const int idx = tid + 512 * i, row = idx >> 5, ch = idx & 31;
        *(u32x4*)(MIX + (size_t)(r0 + row) * DM + 1024 + h * 256 + ch * 8) = *(const LAS u32x4*)(L + G3_OUT + row * G3_ROWB + ch * 16); }
    __syncthreads();
}

#ifndef QR_REG
#define QR_REG 1
#endif
namespace att {
constexpr int NW = 8, QBLK = 32, KVBLK = 64;
constexpr float SCALE = 0.07216878364870323f;
constexpr float THR = 8.f;
constexpr int LDQ = 1536, LDKV = 2048, LDKR = 64, LDO = 2048;
constexpr int SHM_V = 16384, SHM_K = 16384, SHM_R = 8192;
constexpr int OFF_V = 0, OFF_K = 2 * SHM_V, OFF_R = OFF_K + 2 * SHM_K, OFF_WS = OFF_R + 2 * SHM_R, OFF_QR = OFF_WS + NW * 64 * 4, LDS_NEED = OFF_QR + NW * 8704;
static_assert(LDS_NEED <= LDS_CTL_OFF, "attention LDS map");
#define KSWZ(row, colB) ((row) * 256 + ((colB) ^ (((row) & 15) << 4)))
#define RSWZ(row, colB) ((row) * 128 + ((colB) ^ ((((row) >> 1) & 7) << 4)))

__device__ __forceinline__ void partialSM(f32x16& p0, f32x16& p1, float& m_reg, float& mn, float& alpha) {
  constexpr float C = SCALE * 1.4426950408889634f;
  float pmax = p0[0];
#pragma unroll
  for (int r = 1; r < 16; ++r) pmax = fmaxf(pmax, p0[r]);
#pragma unroll
  for (int r = 0; r < 16; ++r) pmax = fmaxf(pmax, p1[r]);
  { auto rr = __builtin_amdgcn_permlane32_swap(__float_as_uint(pmax), __float_as_uint(pmax), false, false);
    pmax = fmaxf(__uint_as_float(rr[0]), __uint_as_float(rr[1])); }
  if (__builtin_expect(__all(pmax - m_reg <= THR / SCALE), 1)) { mn = m_reg; alpha = 1.f; }
  else { mn = fmaxf(m_reg, pmax); alpha = __builtin_amdgcn_exp2f((m_reg - mn) * C); m_reg = mn; }
  const float mnC = -mn * C;
#pragma unroll
  for (int r = 0; r < 16; ++r) p0[r] = fmaf(p0[r], C, mnC);
#pragma unroll
  for (int r = 0; r < 16; ++r) p1[r] = fmaf(p1[r], C, mnC);
#pragma unroll
  for (int r = 0; r < 16; ++r) p0[r] = __builtin_amdgcn_exp2f(p0[r]);
}
__device__ __forceinline__ void finishSM(f32x16& p0, f32x16& p1, float alpha, float& l_reg, bf16x8& pa0, bf16x8& pa1, bf16x8& pa2, bf16x8& pa3) {
#pragma unroll
  for (int r = 0; r < 16; ++r) p1[r] = __builtin_amdgcn_exp2f(p1[r]);
  float ps = 0;
#pragma unroll
  for (int r = 0; r < 16; ++r) ps += p0[r];
#pragma unroll
  for (int r = 0; r < 16; ++r) ps += p1[r];
  { auto rr = __builtin_amdgcn_permlane32_swap(__float_as_uint(ps), __float_as_uint(ps), false, false);
    ps = __uint_as_float(rr[0]) + __uint_as_float(rr[1]); }
  l_reg = l_reg * alpha + ps;
#define PK4(P, BASE, OUT) do { unsigned a0 = cvt_pk_asm(P[BASE + 0], P[BASE + 1]), a1 = cvt_pk_asm(P[BASE + 2], P[BASE + 3]);   \
    unsigned b0 = cvt_pk_asm(P[BASE + 4], P[BASE + 5]), b1 = cvt_pk_asm(P[BASE + 6], P[BASE + 7]);                              \
    auto r0 = __builtin_amdgcn_permlane32_swap(a0, b0, false, false); auto r1 = __builtin_amdgcn_permlane32_swap(a1, b1, false, false); \
    u32x4 w = {r0[0], r1[0], r0[1], r1[1]}; OUT = __builtin_bit_cast(bf16x8, w); } while (0)
  PK4(p0, 0, pa0); PK4(p0, 8, pa1); PK4(p1, 0, pa2); PK4(p1, 8, pa3);
#undef PK4
}
__device__ __forceinline__ void qkt(f32x16& p0, f32x16& p1, const LAS unsigned char* Ks, const LAS unsigned char* Rs, const bf16x8 (&qr)[8], const bf16x8 (&qrr)[4], const LAS unsigned char* QRl, int r32, int hi) {
#pragma unroll
  for (int r = 0; r < 16; ++r) { p0[r] = 0.f; p1[r] = 0.f; }
#pragma unroll
  for (int d0 = 0; d0 < 8; ++d0) { const int cb = d0 * 32 + hi * 16;
    const bf16x8 b0 = *(const LAS bf16x8*)(Ks + KSWZ(r32, cb)), b1 = *(const LAS bf16x8*)(Ks + KSWZ(32 + r32, cb));
    p0 = __builtin_amdgcn_mfma_f32_32x32x16_bf16(b0, qr[d0], p0, 0, 0, 0);
    p1 = __builtin_amdgcn_mfma_f32_32x32x16_bf16(b1, qr[d0], p1, 0, 0, 0); }
#pragma unroll
  for (int d0 = 0; d0 < 4; ++d0) { const int cb = d0 * 32 + hi * 16;
    const bf16x8 b0 = *(const LAS bf16x8*)(Rs + RSWZ(r32, cb)), b1 = *(const LAS bf16x8*)(Rs + RSWZ(32 + r32, cb));
#if QR_REG
    const bf16x8 qq = qrr[d0];
#else
    const bf16x8 qq = *(const LAS bf16x8*)(QRl + d0 * 1024);
#endif
    p0 = __builtin_amdgcn_mfma_f32_32x32x16_bf16(b0, qq, p0, 0, 0, 0);
    p1 = __builtin_amdgcn_mfma_f32_32x32x16_bf16(b1, qq, p1, 0, 0, 0); }
}
__device__ __forceinline__ int v_st(int k, int c) { const int kk = (k & ~0xC) | ((k & 4) << 1) | ((k & 8) >> 1); return ((kk >> 3) * 4 + (c >> 5)) * 512 + ((kk & 7) * 32 + (c & 31)) * 2; }
__device__ __forceinline__ int v_rd_base(int lane) { return ((lane & 3) << 3) | (((lane >> 2) & 3) << 6) | (((lane >> 4) & 1) << 5) | (((lane >> 5) & 1) << 8); }
constexpr int v_rd_off(int d0, int ks, int half) { return d0 * 512 + ks * 4096 + half * 2048; }
template <int OFF> __device__ __forceinline__ s16x4 tr_read(int vb) {
  s16x4 r; asm volatile("ds_read_b64_tr_b16 %0, %1 offset:%2" : "=&v"(r) : "v"(vb), "i"(OFF) : "memory"); return r;
}
template <int D0> __device__ __forceinline__ void pv_one(f32x16& od, int vb, bf16x8 pa0, bf16x8 pa1, bf16x8 pa2, bf16x8 pa3) {
  const s16x4 l0 = tr_read<v_rd_off(D0, 0, 0)>(vb), h0 = tr_read<v_rd_off(D0, 0, 1)>(vb), l1 = tr_read<v_rd_off(D0, 1, 0)>(vb), h1 = tr_read<v_rd_off(D0, 1, 1)>(vb);
  const s16x4 l2 = tr_read<v_rd_off(D0, 2, 0)>(vb), h2 = tr_read<v_rd_off(D0, 2, 1)>(vb), l3 = tr_read<v_rd_off(D0, 3, 0)>(vb), h3 = tr_read<v_rd_off(D0, 3, 1)>(vb);
  asm volatile("s_waitcnt lgkmcnt(0)" ::: "memory"); SBAR();
#define PKV(L_, H_) (bf16x8){L_[0], L_[1], L_[2], L_[3], H_[0], H_[1], H_[2], H_[3]}
  od = __builtin_amdgcn_mfma_f32_32x32x16_bf16(pa0, PKV(l0, h0), od, 0, 0, 0);
  od = __builtin_amdgcn_mfma_f32_32x32x16_bf16(pa1, PKV(l1, h1), od, 0, 0, 0);
  od = __builtin_amdgcn_mfma_f32_32x32x16_bf16(pa2, PKV(l2, h2), od, 0, 0, 0);
  od = __builtin_amdgcn_mfma_f32_32x32x16_bf16(pa3, PKV(l3, h3), od, 0, 0, 0);
#undef PKV
}
__device__ __forceinline__ void pv_d0(f32x16 (&o)[4], int vb, bf16x8 pa0, bf16x8 pa1, bf16x8 pa2, bf16x8 pa3) {
  pv_one<0>(o[0], vb, pa0, pa1, pa2, pa3); pv_one<1>(o[1], vb, pa0, pa1, pa2, pa3); pv_one<2>(o[2], vb, pa0, pa1, pa2, pa3); pv_one<3>(o[3], vb, pa0, pa1, pa2, pa3);
}

__device__ __forceinline__ void attn_unit(const bf16_t* __restrict__ Qb, const bf16_t* __restrict__ Kn, const bf16_t* __restrict__ Kr, const bf16_t* __restrict__ Vh,
                                          bf16_t* __restrict__ Ob, int nkeys, LAS unsigned char* lds, int wid) {
  asm volatile("" : "+s"(wid));
  const int lane = lane_id(), tid = wid * 64 + lane, r32 = lane & 31, hi = lane >> 5;
  LAS unsigned char* V_lds = lds + OFF_V; LAS unsigned char* K_lds = lds + OFF_K; LAS unsigned char* R_lds = lds + OFF_R;
  LAS float* wsf = (LAS float*)(lds + OFF_WS) + wid * 64; LAS float* li_l = wsf; LAS float* al_l = wsf + 32;
  float m_reg = -1e30f, l_reg = 0.f; f32x16 o[4]; bf16x8 qr[8];
  LAS unsigned char* QRl = lds + OFF_QR + wid * 4096 + lane * 16;
#pragma unroll
  for (int d = 0; d < 4; ++d)
#pragma unroll
    for (int r = 0; r < 16; ++r) o[d][r] = 0.f;
  const bf16_t* Qw = Qb + (size_t)(wid * QBLK + r32) * LDQ + hi * 8;
#pragma unroll
  for (int d0 = 0; d0 < 8; ++d0) qr[d0] = *(const bf16x8*)(Qw + d0 * 16);
  bf16x8 qrr[4];
#pragma unroll
  for (int d0 = 0; d0 < 4; ++d0) { qrr[d0] = *(const bf16x8*)(Qw + (8 + d0) * 16);
#if !QR_REG
    *(LAS bf16x8*)(QRl + d0 * 1024) = qrr[d0];
#endif
  }
  const int sr = tid >> 4, sc = (tid & 15) * 8, vst0 = v_st(sr, sc), vst1 = v_st(32 + sr, sc);
  const int rr_ = tid >> 3, rc_ = (tid & 7) * 8;
  const int vb0 = (int)(unsigned)(uintptr_t)V_lds + v_rd_base(lane);
  bf16x8 vs0, vs1, ks0, ks1, rs0;
#define SLOAD(k0) do { vs0 = *(const bf16x8*)(Vh + (size_t)((k0) + sr) * LDKV + sc); vs1 = *(const bf16x8*)(Vh + (size_t)((k0) + 32 + sr) * LDKV + sc); \
    ks0 = *(const bf16x8*)(Kn + (size_t)((k0) + sr) * LDKV + sc); ks1 = *(const bf16x8*)(Kn + (size_t)((k0) + 32 + sr) * LDKV + sc); \
    rs0 = *(const bf16x8*)(Kr + (size_t)((k0) + rr_) * LDKR + rc_); } while (0)
#define SWRITE(b) do { *(LAS bf16x8*)(V_lds + (b) * SHM_V + vst0) = vs0; *(LAS bf16x8*)(V_lds + (b) * SHM_V + vst1) = vs1; const int kc = sc * 2; \
    *(LAS bf16x8*)(K_lds + (b) * SHM_K + KSWZ(sr, kc)) = ks0; *(LAS bf16x8*)(K_lds + (b) * SHM_K + KSWZ(32 + sr, kc)) = ks1; \
    *(LAS bf16x8*)(R_lds + (b) * SHM_R + RSWZ(rr_, rc_ * 2)) = rs0; } while (0)
#define SWAIT() asm volatile("s_waitcnt vmcnt(0)" ::: "memory")
#define RESC(a) do { if (__any((a) < 1.f)) { if (hi == 0) al_l[r32] = (a); asm volatile("s_waitcnt lgkmcnt(0)" ::: "memory"); \
    _Pragma("unroll") for (int d = 0; d < 4; ++d) _Pragma("unroll") for (int r = 0; r < 16; ++r) o[d][r] *= al_l[crow(r, hi)]; } } while (0)
  f32x16 pA0, pA1, pB0, pB1; float mnA, mnB, alA, alB; bf16x8 pa0, pa1, pa2, pa3; const int NT = nkeys / KVBLK;
  SLOAD(0); SWAIT(); SWRITE(0); __syncthreads();
  qkt(pA0, pA1, K_lds, R_lds, qr, qrr, QRl, r32, hi); partialSM(pA0, pA1, m_reg, mnA, alA);
  SLOAD(KVBLK);
  SWAIT(); SWRITE(1); __syncthreads();
  for (int j = 1; j + 1 < NT; j += 2) {
    SBAR(); qkt(pB0, pB1, K_lds + SHM_K, R_lds + SHM_R, qr, qrr, QRl, r32, hi);
    finishSM(pA0, pA1, alA, l_reg, pa0, pa1, pa2, pa3); SBAR();
    SLOAD((j + 1) * KVBLK); SBAR();
    pv_d0(o, vb0, pa0, pa1, pa2, pa3); partialSM(pB0, pB1, m_reg, mnB, alB);
    __syncthreads(); SWAIT(); SWRITE(0);
    RESC(alB); __syncthreads();
    SBAR(); qkt(pA0, pA1, K_lds, R_lds, qr, qrr, QRl, r32, hi);
    finishSM(pB0, pB1, alB, l_reg, pa0, pa1, pa2, pa3); SBAR();
    SLOAD((j + 2) * KVBLK); SBAR();
    pv_d0(o, vb0 + SHM_V, pa0, pa1, pa2, pa3); partialSM(pA0, pA1, m_reg, mnA, alA);
    __syncthreads(); SWAIT(); SWRITE(1);
    RESC(alA); __syncthreads();
  }
  SBAR(); qkt(pB0, pB1, K_lds + SHM_K, R_lds + SHM_R, qr, qrr, QRl, r32, hi);
  finishSM(pA0, pA1, alA, l_reg, pa0, pa1, pa2, pa3); SBAR();
  pv_d0(o, vb0, pa0, pa1, pa2, pa3); partialSM(pB0, pB1, m_reg, mnB, alB);
  __syncthreads(); RESC(alB);
  finishSM(pB0, pB1, alB, l_reg, pa0, pa1, pa2, pa3); SBAR();
  pv_d0(o, vb0 + SHM_V, pa0, pa1, pa2, pa3);
  if (hi == 0) li_l[r32] = l_reg; asm volatile("s_waitcnt lgkmcnt(0)" ::: "memory");
  float rli[16];
#pragma unroll
  for (int r = 0; r < 16; ++r) rli[r] = __builtin_amdgcn_rcpf(li_l[crow(r, hi)]);
  bf16_t* Ow = Ob + (size_t)(wid * QBLK) * LDO;
#if QR_REG
  { LAS unsigned char* slab = lds + OFF_QR + wid * 8704;
#pragma unroll
    for (int r = 0; r < 16; ++r) { const int orow = crow(r, hi);
#pragma unroll
      for (int d0 = 0; d0 < 4; ++d0) *(LAS bf16_t*)(slab + orow * 272 + (d0 * 32 + r32) * 2) = f2bf(o[d0][r] * rli[r]); }
#pragma unroll
    for (int i = 0; i < 8; ++i) { const int idx = lane + 64 * i, row = idx >> 4, ch = idx & 15;
      *(u32x4*)(Ow + (size_t)row * LDO + ch * 8) = *(const LAS u32x4*)(slab + row * 272 + ch * 16); } }
#else
#pragma unroll
  for (int r = 0; r < 16; ++r) { const int orow = crow(r, hi);
#pragma unroll
    for (int d0 = 0; d0 < 4; ++d0) Ow[(size_t)orow * LDO + d0 * 32 + r32] = f2bf(o[d0][r] * rli[r]); }
#endif
  __syncthreads();
#undef SLOAD
#undef SWRITE
#undef SWAIT
#undef RESC
}
}

constexpr int TK_S = 0, TK_SSTR = 260, TK_SBYTES = 64 * TK_SSTR * 4, TK_TV = 2 * TK_SBYTES, TK_TI = TK_TV + 64 * 2 * 16 * 4, TK_TAB = TK_TI + 64 * 2 * 16 * 4, TK_END = TK_TAB + 64 * 4;
static_assert(TK_END <= LDS_CTL_OFF, "topk LDS map");
constexpr int TK_COFF[17] = {0, 16, 24, 29, 33, 36, 38, 40, 42, 43, 44, 45, 46, 47, 48, 49, 50};
__device__ __forceinline__ unsigned f2mono(float f) { const unsigned u = __float_as_uint(f); return (u & 0x80000000u) ? ~u : (u | 0x80000000u); }
template <int N> __device__ __forceinline__ void bitonic_merge_desc(unsigned (&a)[N]) {
#pragma unroll
    for (int d = N >> 1; d > 0; d >>= 1)
#pragma unroll
        for (int i = 0; i < N; ++i) { const int p = i ^ d; if (p > i) { const unsigned lo = a[i] < a[p] ? a[i] : a[p], hi = a[i] < a[p] ? a[p] : a[i]; a[i] = hi; a[p] = lo; } }
}
template <int N> __device__ __forceinline__ void bitonic_sort_desc(unsigned (&a)[N]) {
#pragma unroll
    for (int k = 2; k <= N; k <<= 1)
#pragma unroll
        for (int d = k >> 1; d > 0; d >>= 1)
#pragma unroll
            for (int i = 0; i < N; ++i) { const int p = i ^ d; if (p > i) { const bool desc = ((i & k) == 0) || (k == N); const unsigned lo = a[i] < a[p] ? a[i] : a[p], hi = a[i] < a[p] ? a[p] : a[i]; a[i] = desc ? hi : lo; a[p] = desc ? lo : hi; } }
}
__device__ __forceinline__ void tk_scores(unsigned char* ws, LAS float* S, int l, int u, int half, int kb0, int nkb, int lane) {
    const int tile = u >> 3, h = u & 7, r0 = tile * 64, r32 = lane & 31, hi = lane >> 5;
    const bf16_t* qp = (const bf16_t*)(ws + WS_QP) + (size_t)(r0 + r32) * DM + h * 256 + half * 128 + 8 * hi;
    bf16x8 q0[8], q1[8];
#pragma unroll
    for (int ks = 0; ks < 8; ++ks) { q0[ks] = *(const bf16x8*)(qp + ks * 16); q1[ks] = *(const bf16x8*)(qp + (size_t)32 * DM + ks * 16); }
    for (int kb = kb0; kb < kb0 + nkb; ++kb) {
        const bf16_t* kp = (const bf16_t*)(ws + WS_SUBK) + ((size_t)((l * 2 + half) * 8 + h) * 128 + kb * 32 + r32) * 128 + 8 * hi;
        f32x16 a0, a1;
#pragma unroll
        for (int r = 0; r < 16; ++r) { a0[r] = 0.f; a1[r] = 0.f; }
#pragma unroll
        for (int ks = 0; ks < 8; ++ks) { const bf16x8 kk = *(const bf16x8*)(kp + ks * 16);
            a0 = __builtin_amdgcn_mfma_f32_32x32x16_bf16(q0[ks], kk, a0, 0, 0, 0); a1 = __builtin_amdgcn_mfma_f32_32x32x16_bf16(q1[ks], kk, a1, 0, 0, 0); }
#pragma unroll
        for (int r = 0; r < 16; ++r) { S[crow(r, hi) * TK_SSTR + half * 128 + kb * 32 + r32] = a0[r]; S[(32 + crow(r, hi)) * TK_SSTR + half * 128 + kb * 32 + r32] = a1[r]; }
    }
}
__device__ __forceinline__ void peer_topk_phase(const Ptrs& A, LAS unsigned char* L, int l, int wave, int bid, int G) { asm volatile("" : "+s"(wave));
    unsigned char* ws = A.ws(); LAUNDER_G(ws);
    const int NU = (NTOK / 64) * 8;
    LAS float* TV = (LAS float*)(L + TK_TV); LAS int* TI = (LAS int*)(L + TK_TI); LAS int* TAB = (LAS int*)(L + TK_TAB);
    { const int lane = lane_id(); const int tid = wave * 64 + lane;
      if (bid < NU) tk_scores(ws, (LAS float*)(L + TK_S), l, bid, wave >> 2, wave & 3, 1, lane);
      if (tid < 50) { int row = 0;
#pragma unroll
          for (int i = 1; i < 16; ++i) row = tid >= TK_COFF[i] ? i : row;
          int base = 0;
#pragma unroll
          for (int i = 1; i < 16; ++i) base = row == i ? TK_COFF[i] : base;
          TAB[tid] = row * 16 + (tid - base); } }
    __syncthreads();
    int n = 0;
    for (int u = bid; u < NU; u += G, ++n) {
        const int lane = lane_id(); const int tid = wave * 64 + lane;
        const int tile = u >> 3, h = u & 7, r0 = tile * 64;
        LAS float* S = (LAS float*)(L + TK_S + (n & 1) * TK_SBYTES);
    {
        const int item = tid >> 2, q = tid & 3, tok = item & 63, half = item >> 6;
        unsigned k0[16], k1[16];
#pragma unroll
        for (int j = 0; j < 4; ++j) { const f32x4 x = *(const LAS f32x4*)(S + tok * TK_SSTR + half * 128 + q * 32 + j * 4), y = *(const LAS f32x4*)(S + tok * TK_SSTR + half * 128 + q * 32 + 16 + j * 4);
            const int ib = 127 - (q * 32 + 4 * j);
            k0[4 * j] = (f2mono(x.x) & ~127u) | (unsigned)ib; k0[4 * j + 1] = (f2mono(x.y) & ~127u) | (unsigned)(ib - 1); k0[4 * j + 2] = (f2mono(x.z) & ~127u) | (unsigned)(ib - 2); k0[4 * j + 3] = (f2mono(x.w) & ~127u) | (unsigned)(ib - 3);
            k1[4 * j] = (f2mono(y.x) & ~127u) | (unsigned)(ib - 16); k1[4 * j + 1] = (f2mono(y.y) & ~127u) | (unsigned)(ib - 17); k1[4 * j + 2] = (f2mono(y.z) & ~127u) | (unsigned)(ib - 18); k1[4 * j + 3] = (f2mono(y.w) & ~127u) | (unsigned)(ib - 19); }
        bitonic_sort_desc<16>(k0); bitonic_sort_desc<16>(k1);
#pragma unroll
        for (int i = 0; i < 16; ++i) k0[i] = k0[i] > k1[15 - i] ? k0[i] : k1[15 - i];
        bitonic_merge_desc<16>(k0);
#pragma unroll
        for (int o = 1; o < 4; o <<= 1) {
#pragma unroll
            for (int i = 0; i < 16; ++i) k1[i] = (unsigned)shx_i((int)k0[i], o);
#pragma unroll
            for (int i = 0; i < 16; ++i) k0[i] = k0[i] > k1[15 - i] ? k0[i] : k1[15 - i];
            bitonic_merge_desc<16>(k0); }
#pragma unroll
        for (int i = 0; i < 16; ++i) if ((i >> 2) == q) { const int idx = 127 - (int)(k0[i] & 127u); TI[(tok * 2 + half) * 16 + i] = idx; TV[(tok * 2 + half) * 16 + i] = S[tok * TK_SSTR + half * 128 + idx]; }
    }
    __syncthreads();
        if (wave >= 4) { if (u + G < NU) tk_scores(ws, (LAS float*)(L + TK_S + ((n + 1) & 1) * TK_SBYTES), l, u + G, (wave - 4) >> 1, ((wave - 4) & 1) * 2, 2, lane); }
        else
    {
        const int tok = tid >> 2, q = tid & 3;
        unsigned ck[13];
#pragma unroll
        for (int sl = 0; sl < 13; ++sl) { const int n = 4 * sl + q; unsigned key = 0u;
            if (n < 50) { const int code = TAB[n]; const float sum = TV[(tok * 2) * 16 + (code >> 4)] + TV[(tok * 2 + 1) * 16 + (code & 15)]; key = (f2mono(sum) & ~63u) | (unsigned)(63 - n); }
            ck[sl] = key; }
        unsigned win[4] = {0u, 0u, 0u, 0u};
#pragma unroll
        for (int pass = 0; pass < 16; ++pass) {
            unsigned best = ck[0];
#pragma unroll
            for (int sl = 1; sl < 13; ++sl) best = ck[sl] > best ? ck[sl] : best;
#pragma unroll
            for (int o = 1; o < 4; o <<= 1) { const unsigned ob = (unsigned)shx_i((int)best, o); best = ob > best ? ob : best; }
#pragma unroll
            for (int sl = 0; sl < 13; ++sl) ck[sl] = ck[sl] == best ? 0u : ck[sl];
            if ((pass >> 2) == q) win[pass & 3] = best;
        }
        float sm[4]; int ex_idx[4];
#pragma unroll
        for (int w = 0; w < 4; ++w) { const int n = 63 - (int)(win[w] & 63u); const int code = TAB[n]; const int i = code >> 4, j = code & 15;
            sm[w] = TV[(tok * 2) * 16 + i] + TV[(tok * 2 + 1) * 16 + j]; ex_idx[w] = TI[(tok * 2) * 16 + i] * 128 + TI[(tok * 2 + 1) * 16 + j]; }
        const float mx = DPP_F(sm[0], 0x00);
        float ex[4], den = 0.f;
#pragma unroll
        for (int w = 0; w < 4; ++w) { ex[w] = __expf(sm[w] - mx); den += ex[w]; }
        den += shx_f(den, 1); den += shx_f(den, 2);
        const float inv = 1.0f / den;
        int* IDX = (int*)(ws + WS_IDX) + (size_t)(r0 + tok) * 128 + h * 16 + 4 * q; float* GATE = (float*)(ws + WS_GATE) + (size_t)(r0 + tok) * 128 + h * 16 + 4 * q;
        *(u32x4*)IDX = (u32x4){(unsigned)ex_idx[0], (unsigned)ex_idx[1], (unsigned)ex_idx[2], (unsigned)ex_idx[3]};
        *(f32x4*)GATE = (f32x4){ex[0] * inv, ex[1] * inv, ex[2] * inv, ex[3] * inv};
    }
    __syncthreads();
    }
}

__device__ __forceinline__ float gelu_tanh(float x) { const float y = 0.7978845608028654f * (x + 0.044715f * x * x * x); const float t = 1.f - 2.f * __builtin_amdgcn_rcpf(__expf(2.f * y) + 1.f); return 0.5f * x * (1.f + t); }
#ifndef PEER_NEB
#define PEER_NEB 4
#endif
#ifndef PEER_NEC
#define PEER_NEC 4
#endif
template <int NTK>
__device__ __forceinline__ void peer_tokens(const Ptrs& A, unsigned char* ws, const int (&rows)[NTK], int l, int lane) {
    constexpr int NE = PEER_NEB / NTK, NEC = PEER_NEC / NTK;
    const unsigned char* EU = ws + WS_EU + (size_t)l * NEXP * EROW; const unsigned char* EV = ws + WS_EV + (size_t)l * NEXP * EROW;
    const float* SU = (const float*)(ws + WS_SU) + (size_t)l * NEXP; const float* SV = (const float*)(ws + WS_SV) + (size_t)l * NEXP;
    const float* MOD = (const float*)(ws + WS_MOD);
    int hq[NTK][8]; float hoff[NTK]; float out[NTK][32]; unsigned k_lo[NTK], k_hi[NTK]; float g_lo[NTK], g_hi[NTK], s_lo[NTK], s_hi[NTK];
    { const int lane = lane_id();
#pragma unroll
    for (int t = 0; t < NTK; ++t) { const int r = rows[t];
        const bf16_t* hrow = (const bf16_t*)(ws + WS_H) + (size_t)r * DM;
        u32x2 hb[8]; float am = 0.f;
#pragma unroll
        for (int i = 0; i < 8; ++i) { hb[i] = *(const u32x2*)(hrow + (lane + 64 * i) * 4);
            am = fmaxf(am, fmaxf(fmaxf(fabsf(bflo(hb[i].x)), fabsf(bfhi(hb[i].x))), fmaxf(fabsf(bflo(hb[i].y)), fabsf(bfhi(hb[i].y))))); }
        am = wave_max(am);
        const float hs = am > 0.f ? am * (1.0f / 127.0f) : 1.0f, hinv = 1.0f / hs; int hsum = 0;
#pragma unroll
        for (int i = 0; i < 8; ++i) { const int q0 = (int)rintf(bflo(hb[i].x) * hinv), q1 = (int)rintf(bfhi(hb[i].x) * hinv), q2 = (int)rintf(bflo(hb[i].y) * hinv), q3 = (int)rintf(bfhi(hb[i].y) * hinv);
            hsum += (q0 + q1) + (q2 + q3);
            hq[t][i] = (int)(((unsigned)q0 & 255u) | (((unsigned)q1 & 255u) << 8) | (((unsigned)q2 & 255u) << 16) | ((unsigned)q3 << 24)); }
        hsum = wave_sum_i(hsum);
        hoff[t] = 7.5f * (float)hsum;
        const int* ip = (const int*)(ws + WS_IDX) + (size_t)r * 128; const float* gp = (const float*)(ws + WS_GATE) + (size_t)r * 128;
        const int i_lo = ip[lane], i_hi = ip[64 + lane]; g_lo[t] = gp[lane] * SV[i_lo]; g_hi[t] = gp[64 + lane] * SV[i_hi]; s_lo[t] = SU[i_lo] * hs; s_hi[t] = SU[i_hi] * hs;
        unsigned kl = ((unsigned)i_lo << 7) | (unsigned)lane, kh = ((unsigned)i_hi << 7) | (unsigned)(64 + lane);
#pragma unroll
        for (int k = 2; k <= 128; k <<= 1)
#pragma unroll
            for (int d = k >> 1; d > 0; d >>= 1) {
                if (d == 64) { const unsigned a = kl < kh ? kl : kh, c = kl < kh ? kh : kl; kl = a; kh = c; }
                else { const unsigned o0 = (unsigned)shx_i((int)kl, d), o1 = (unsigned)shx_i((int)kh, d);
                    const bool up0 = k == 128 ? true : (k == 64 ? true : ((lane & k) == 0)), up1 = k == 128 ? true : (k == 64 ? false : ((lane & k) == 0));
                    const bool lowhalf = (lane & d) == 0;
                    const unsigned mn0 = kl < o0 ? kl : o0, mx0 = kl < o0 ? o0 : kl, mn1 = kh < o1 ? kh : o1, mx1 = kh < o1 ? o1 : kh;
                    kl = (lowhalf == up0) ? mn0 : mx0; kh = (lowhalf == up1) ? mn1 : mx1; } }
        k_lo[t] = kl; k_hi[t] = kh;
#pragma unroll
        for (int jj = 0; jj < 32; ++jj) out[t][jj] = 0.f;
    }
    }
    const unsigned l16 = (unsigned)lane_id() * 16u;
    float a_lo[NTK], a_hi[NTK];
    {
        int sa_lo[NTK], sa_hi[NTK];
#pragma unroll
        for (int t = 0; t < NTK; ++t) { sa_lo[t] = 0; sa_hi[t] = 0; }
        constexpr int NU = 8 / NTK;
        for (int k0 = 0; k0 < 128; k0 += NU) {
            u32x4 ua[NTK][NU];
#pragma unroll
            for (int t = 0; t < NTK; ++t)
#pragma unroll
                for (int k = 0; k < NU; ++k) { const int kk = k0 + k;
                    const int e = (int)((unsigned)__builtin_amdgcn_readlane((int)(kk < 64 ? k_lo[t] : k_hi[t]), kk & 63) >> 7);
                    ua[t][k] = *(const u32x4*)((EU + (size_t)e * EROW) + l16); }
#pragma unroll
            for (int sub = 0; sub < NU; sub += 4 / NTK) {
                constexpr int NC = 4 / NTK; int si[NTK][NC];
#pragma unroll
                for (int t = 0; t < NTK; ++t)
#pragma unroll
                    for (int k = 0; k < NC; ++k) { const u32x4 pa = ua[t][sub + k]; const unsigned pw[4] = {pa.x, pa.y, pa.z, pa.w};
                        int a0 = 0, a1 = 0;
#pragma unroll
                        for (int w = 0; w < 4; ++w) { a0 = __builtin_amdgcn_sdot4((int)(pw[w] & 0x0F0F0F0Fu), hq[t][2 * w], a0, false); a1 = __builtin_amdgcn_sdot4((int)((pw[w] >> 4) & 0x0F0F0F0Fu), hq[t][2 * w + 1], a1, false); }
                        si[t][k] = a0 + a1; }
#define PEER_DPP_STEP(ctrl) _Pragma("unroll") for (int t = 0; t < NTK; ++t) _Pragma("unroll") for (int k = 0; k < NC; ++k) si[t][k] += __builtin_amdgcn_update_dpp(0, si[t][k], ctrl, 0xF, 0xF, true);
                PEER_DPP_STEP(0xB1) PEER_DPP_STEP(0x4E) PEER_DPP_STEP(0x141) PEER_DPP_STEP(0x140)
#undef PEER_DPP_STEP
#pragma unroll
                for (int t = 0; t < NTK; ++t)
#pragma unroll
                    for (int k = 0; k < NC; ++k) { const int kk = k0 + sub + k;
                        const int tot = (__builtin_amdgcn_readlane(si[t][k], 0) + __builtin_amdgcn_readlane(si[t][k], 16)) + (__builtin_amdgcn_readlane(si[t][k], 32) + __builtin_amdgcn_readlane(si[t][k], 48));
                        const int wl = kk & 63;
                        unsigned keep;
                        if (kk < 64) asm volatile("s_mov_b32 %1, m0\n\ts_mov_b32 m0, %3\n\tv_writelane_b32 %0, %2, m0\n\ts_mov_b32 m0, %1" : "+v"(sa_lo[t]), "=&s"(keep) : "s"(tot), "s"(wl));
                        else asm volatile("s_mov_b32 %1, m0\n\ts_mov_b32 m0, %3\n\tv_writelane_b32 %0, %2, m0\n\ts_mov_b32 m0, %1" : "+v"(sa_hi[t]), "=&s"(keep) : "s"(tot), "s"(wl)); }
                __builtin_amdgcn_sched_barrier(0);
            }
        }
        const int lane = lane_id();
#pragma unroll
        for (int t = 0; t < NTK; ++t) {
            const int ps_lo = (int)(k_lo[t] & 127u), ps_hi = (int)(k_hi[t] & 127u);
#define BPF(idx, v) __builtin_bit_cast(float, __builtin_amdgcn_ds_bpermute(((idx) & 63) << 2, __builtin_bit_cast(int, (v))))
            const float su_l0 = BPF(ps_lo, s_lo[t]), su_l1 = BPF(ps_lo, s_hi[t]), su_h0 = BPF(ps_hi, s_lo[t]), su_h1 = BPF(ps_hi, s_hi[t]);
            const float gt_l0 = BPF(ps_lo, g_lo[t]), gt_l1 = BPF(ps_lo, g_hi[t]), gt_h0 = BPF(ps_hi, g_lo[t]), gt_h1 = BPF(ps_hi, g_hi[t]);
#undef BPF
            const float su_l = ps_lo < 64 ? su_l0 : su_l1, su_h = ps_hi < 64 ? su_h0 : su_h1, gt_l = ps_lo < 64 ? gt_l0 : gt_l1, gt_h = ps_hi < 64 ? gt_h0 : gt_h1;
            a_lo[t] = gelu_tanh(((float)sa_lo[t] - hoff[t]) * su_l) * gt_l;
            a_hi[t] = gelu_tanh(((float)sa_hi[t] - hoff[t]) * su_h) * gt_h; }
        (void)lane;
    }
    {
        constexpr int NV = 8 / NTK;
        for (int k0 = 0; k0 < 128; k0 += NV) {
            u32x4 va[NTK][NV];
#pragma unroll
            for (int t = 0; t < NTK; ++t)
#pragma unroll
                for (int k = 0; k < NV; ++k) { const int kk = k0 + k;
                    const int e = (int)((unsigned)__builtin_amdgcn_readlane((int)(kk < 64 ? k_lo[t] : k_hi[t]), kk & 63) >> 7);
                    va[t][k] = *(const u32x4*)((EV + (size_t)e * EROW) + l16); }
#pragma unroll
            for (int t = 0; t < NTK; ++t)
#pragma unroll
                for (int k = 0; k < NV; ++k) { const int kk = k0 + k; if (((t * NV + k) & 1) == 0) __builtin_amdgcn_sched_barrier(0);
                    const float act = __builtin_bit_cast(float, __builtin_amdgcn_readlane(__builtin_bit_cast(int, kk < 64 ? a_lo[t] : a_hi[t]), kk & 63));
                    const u32x4 pa = va[t][k]; const unsigned pw[4] = {pa.x, pa.y, pa.z, pa.w};
#pragma unroll
                    for (int w = 0; w < 4; ++w) {
                        const f32x2 f0 = __builtin_amdgcn_cvt_scalef32_pk_f32_fp4(pw[w], 1.0f, 0), f1 = __builtin_amdgcn_cvt_scalef32_pk_f32_fp4(pw[w], 1.0f, 1), f2 = __builtin_amdgcn_cvt_scalef32_pk_f32_fp4(pw[w], 1.0f, 2), f3 = __builtin_amdgcn_cvt_scalef32_pk_f32_fp4(pw[w], 1.0f, 3);
                        out[t][8 * w + 0] = fmaf(act, f0.x, out[t][8 * w + 0]); out[t][8 * w + 1] = fmaf(act, f0.y, out[t][8 * w + 1]); out[t][8 * w + 2] = fmaf(act, f1.x, out[t][8 * w + 2]); out[t][8 * w + 3] = fmaf(act, f1.y, out[t][8 * w + 3]);
                        out[t][8 * w + 4] = fmaf(act, f2.x, out[t][8 * w + 4]); out[t][8 * w + 5] = fmaf(act, f2.y, out[t][8 * w + 5]); out[t][8 * w + 6] = fmaf(act, f3.x, out[t][8 * w + 6]); out[t][8 * w + 7] = fmaf(act, f3.y, out[t][8 * w + 7]); } }
        }
    }
    const int lane_e = lane_id();
#pragma unroll
    for (int t = 0; t < NTK; ++t) { const int r = rows[t]; const int b = r / RPB, j = r - b * RPB; const bool isctx = j < CTX;
        float* xrow = (float*)(ws + WS_XRES) + (size_t)r * DM; const int mr = isctx ? 4 : b;
        const float* gf = MOD + ((size_t)l * 5 + mr) * NMOD + 5 * DM;
        float ss = 0.f;
#pragma unroll
        for (int i = 0; i < 8; ++i) { const int col = (lane_e + 64 * i) * 4; const f32x4 g4 = *(const f32x4*)(gf + col); f32x4 x4 = *(const f32x4*)(xrow + col);
            x4.x += g4.x * out[t][4 * i]; x4.y += g4.y * out[t][4 * i + 1]; x4.z += g4.z * out[t][4 * i + 2]; x4.w += g4.w * out[t][4 * i + 3];
            out[t][4 * i] = x4.x; out[t][4 * i + 1] = x4.y; out[t][4 * i + 2] = x4.z; out[t][4 * i + 3] = x4.w;
            ss += (x4.x * x4.x + x4.y * x4.y) + (x4.z * x4.z + x4.w * x4.w); }
        ss = wave_sum(ss); const float rstd = 1.0f / sqrtf(ss * (1.0f / DM) + EPS);
        if (l < DEPTH - 1) {
            const float* mp = MOD + ((size_t)(l + 1) * 5 + mr) * NMOD; const float* gn = A.in(6) + (l + 1) * DM; bf16_t* hw = (bf16_t*)(ws + WS_H) + (size_t)r * DM;
#pragma unroll
            for (int i = 0; i < 8; ++i) { const int col = (lane_e + 64 * i) * 4;
                *(f32x4*)(xrow + col) = (f32x4){out[t][4 * i], out[t][4 * i + 1], out[t][4 * i + 2], out[t][4 * i + 3]};
                const f32x4 g4 = *(const f32x4*)(gn + col), sh = *(const f32x4*)(mp + col), sc = *(const f32x4*)(mp + DM + col);
                *(u32x2*)(hw + col) = (u32x2){cvt_pk((out[t][4 * i] * rstd * g4.x) * (1.f + sc.x) + sh.x, (out[t][4 * i + 1] * rstd * g4.y) * (1.f + sc.y) + sh.y),
                                              cvt_pk((out[t][4 * i + 2] * rstd * g4.z) * (1.f + sc.z) + sh.z, (out[t][4 * i + 3] * rstd * g4.w) * (1.f + sc.w) + sh.w)}; }
        } else {
            float* orow = A.out() + ((size_t)b * SEQ + (j - CTX)) * DM; const float* fg = A.in(21);
#pragma unroll
            for (int i = 0; i < 8; ++i) { const int col = (lane_e + 64 * i) * 4; const f32x4 g4 = *(const f32x4*)(fg + col);
                *(f32x4*)(orow + col) = (f32x4){out[t][4 * i] * rstd * g4.x, out[t][4 * i + 1] * rstd * g4.y, out[t][4 * i + 2] * rstd * g4.z, out[t][4 * i + 3] * rstd * g4.w}; }
        }
    }
}
#ifndef PEER_NTK
#define PEER_NTK 2
#endif
__device__ __forceinline__ void peer_rows(const Ptrs& A, LAS unsigned char* L, unsigned xcc, int l, int wave, int bid, int G) { asm volatile("" : "+s"(wave));
    unsigned char* ws = A.ws(); LAUNDER_G(ws); const int gw = bid + G * wave, NGW = G * NWAVES;
    for (int r = gw; r < NTOK; ) {
        const int lane = lane_id();
        int rr[3] = {-1, -1, -1}; int n = 0;
#pragma unroll
        for (int t = 0; t < PEER_NTK; ++t) { while (r < NTOK && rr[t] < 0) { if (!(l == DEPTH - 1 && (r % RPB) < CTX)) { rr[t] = r; ++n; } r += NGW; } }
        if (n == 0) break;
        if (PEER_NTK >= 3 && n == 3) { const int rows[3] = {rr[0], rr[1], rr[2]}; peer_tokens<3>(A, ws, rows, l, lane); }
        else if (PEER_NTK >= 2 && n >= 2) { const int rows[2] = {rr[0], rr[1]}; peer_tokens<2>(A, ws, rows, l, lane); }
        else { const int rows[1] = {rr[0]}; peer_tokens<1>(A, ws, rows, l, lane); }
    }
}

__device__ __forceinline__ void norm2_rows(const Ptrs& A, int l, int wave, int bid, int G) { asm volatile("" : "+s"(wave)); const int lane = lane_id();
    unsigned char* ws = A.ws(); LAUNDER_G(ws); const int gw = bid + G * wave, NGW = G * NWAVES; const float* MOD = (const float*)(ws + WS_MOD);
    for (int r = gw; r < NTOK; r += NGW) {
        float v[4][8]; row_load_f32((const float*)(ws + WS_XRES) + (size_t)r * DM, lane, v);
        const float rstd = row_rstd(v); const float* mp = MOD + ((size_t)l * 5 + modrow(r)) * NMOD;
        norm_mod_store(v, rstd, A.in(7) + l * DM, mp + 3 * DM, mp + 4 * DM, (bf16_t*)(ws + WS_H) + (size_t)r * DM, lane);
    }
}

constexpr int PH_P0A = 0, PH_P0B = 1, PH_L0 = 2, NPL = 9, N_PHASES = PH_L0 + DEPTH * NPL;
__global__ void __launch_bounds__(NTHR, 2) mk_fwd(Args args) {
    extern __shared__ __attribute__((aligned(16))) unsigned char lds_raw[];
    LAS unsigned char* L = (LAS unsigned char*)lds_raw;
    const int wave = __builtin_amdgcn_readfirstlane(threadIdx.x >> 6), bid = blockIdx.x, G = gridDim.x;
    if (wave == 0) { const int ln = lane_id(); if (ln < 16) ((LAS unsigned*)(L + LDS_CTL_OFF))[ln] = 0u;
        if (ln == 0) { LAS unsigned long long* pt = (LAS unsigned long long*)(L + LDS_CTL_OFF + 64);
#pragma unroll
            for (int i = 0; i < 22; ++i) pt[i] = (unsigned long long)(uintptr_t)args.in[i];
            pt[22] = (unsigned long long)(uintptr_t)args.out; pt[23] = (unsigned long long)(uintptr_t)args.ws; } }
    __syncthreads();
    const Ptrs PT{L};
    unsigned* ctl = (unsigned*)(PT.ws() + WS_CTL);
    XcdBarrier bar; bar.bar = ctl + CW_BAR; bar.x = 0; bar.st = nullptr; bar.wv = (unsigned)wave;
#if !MK_MULTI
    bar = xcd_barrier_post(ctl + CW_BAR, (volatile LAS unsigned*)(L + LDS_CTL_OFF) + 8);
    bar.wv = (unsigned)wave;
#endif
    const int lo = args.ph_lo, hi = args.ph_hi;
#ifndef PH_MASK
#define PH_MASK 0x7ff
#endif
#define PHSEL(n) (((PH_MASK) >> (n)) & 1)
#define IN(k) (lo <= (k) && (k) < hi)
#if MK_MULTI
#define SEAM(k) do { } while (0)
#else
#define SEAM(k) do { if (IN(k) && IN((k) + 1)) xcd_barrier(bar); } while (0)
#endif
    if (PHSEL(0) && IN(PH_P0A)) p0a(PT, L, wave, bid, G);
    SEAM(PH_P0A);
    if (PHSEL(1) && IN(PH_P0B)) p0b(PT, wave, bid, G);
    SEAM(PH_P0B);
    for (int l = 0; l < DEPTH; ++l) {
        const int pb = PH_L0 + l * NPL;
        if (PHSEL(2) && IN(pb + 0)) {
            unsigned char* ws = PT.ws(); LAUNDER_G(ws);
            pg8::Gemm g{(const bf16_t*)(ws + WS_H), (const bf16_t*)(ws + WS_WIN) + (size_t)l * PW * DM, NTOK, PW, DM, DM, DM};
            pg8::StaticOrder S; S.init(NTOK, PW, G, bid);
            pg8::EpiBf16<0> E{(bf16_t*)(ws + WS_P), PW, nullptr, 0, 0, 1.f};
#ifndef DBL_GIN
#define DBL_GIN 1
#endif
            for (int rep = 0; rep < DBL_GIN; ++rep)
            pg8::gemm_phase<pg8::EpiBf16<0>, pg8::StaticOrder, true, true>(L, g, S, E, wave);
#ifndef DBL_SIDE
#define DBL_SIDE 1
#endif
            for (int rep = 0; rep < DBL_SIDE; ++rep)
            side_gemm(PT, L, l, wave, bid, G);
        }
        SEAM(pb + 0);
        if (PHSEL(3) && IN(pb + 1)) {
            unsigned char* ws = PT.ws(); LAUNDER_G(ws);
#ifndef NO_THIN
            thin_rows(PT, l, wave, bid, G);
#endif
#ifndef NO_G1
#ifndef DBL_GLA
#define DBL_GLA 1
#endif
#ifndef DBL_G1
#define DBL_G1 DBL_GLA
#endif
            for (int rep = 0; rep < DBL_G1; ++rep)
            for (int u = bid; u < NGU; u += G) gla_g1(PT, L, l, u, wave);
#endif
        }
        SEAM(pb + 1);
        if (PHSEL(4) && IN(pb + 2)) {
            unsigned char* ws = PT.ws(); LAUNDER_G(ws);
#ifndef NO_UQ
            { pg8::Gemm g{(const bf16_t*)(ws + WS_P) + P_CQ, (const bf16_t*)(ws + WS_WUQ) + (size_t)l * 1536 * 512, NTOK, 1536, 512, PW, 512};
              pg8::StaticOrder S; S.init(NTOK, 1536, G, bid);
              pg8::EpiQRope E{(bf16_t*)(ws + WS_Q), (const float*)(ws + WS_ROPE), (const float*)(ws + WS_ROPE) + SEQ * 32};
              pg8::gemm_phase<pg8::EpiQRope, pg8::StaticOrder, true, true>(L, g, S, E, wave); }
#endif
#ifndef NO_UKV
            { pg8::Gemm g{(const bf16_t*)(ws + WS_P) + P_CKV, (const bf16_t*)(ws + WS_WUKV) + (size_t)l * 2048 * 256, NTOK, 2048, 256, PW, 256};
              pg8::LatentOrder S; S.init(2048, G, bid);
              pg8::EpiBf16<0> E{(bf16_t*)(ws + WS_KV), 2048, nullptr, 0, 0, 1.f};
              pg8::gemm_phase<pg8::EpiBf16<0>, pg8::LatentOrder, true, true>(L, g, S, E, wave);
              bf16_t* KVo = (bf16_t*)(ws + WS_KV);
              ctx_gemm(L, (const bf16_t*)(ws + WS_P) + P_CKV, PW, (const bf16_t*)(ws + WS_WUKV) + (size_t)l * 2048 * 256, 256, 2048, 256, wave, bid, G, [=](int row, int col, float v) { KVo[(size_t)row * 2048 + col] = f2bf_safe(v); }); }
#endif
#ifndef NO_G2
#ifndef DBL_G2
#define DBL_G2 DBL_GLA
#endif
            for (int rep = 0; rep < DBL_G2; ++rep) gla_g2(PT, wave, bid, G);
#endif
        }
        SEAM(pb + 2);
        if (PHSEL(5) && IN(pb + 3)) {
            unsigned char* ws = PT.ws(); LAUNDER_G(ws);
            const bf16_t* Q = (const bf16_t*)(ws + WS_Q); const bf16_t* KV = (const bf16_t*)(ws + WS_KV); const bf16_t* KR = (const bf16_t*)(ws + WS_KR); bf16_t* MIX = (bf16_t*)(ws + WS_MIX);
            const int nau = NB * 8 * 16 + (l < DEPTH - 1 ? NB * 8 : 0);
#ifndef DBL_ATT
#define DBL_ATT 1
#endif
#ifndef DBL_G3
#define DBL_G3 DBL_GLA
#endif
            const bool g3first = ((bid >> 3) & 1) != 0;
            for (int step = 0; step < 2; ++step) {
                if ((step == 0) == g3first) {
            for (int rep = 0; rep < DBL_G3; ++rep)
            for (int u = G - 1 - bid; u < NGU; u += G) gla_g3(PT, L, l, u, wave);
                } else {
            for (int rep = 0; rep < DBL_ATT; ++rep)
            for (int u = bid; u < nau; u += G) {
                int b, h, q0, nk;
                if (u < NB * 8 * 16) {
                    int uu = u; if ((G & 7) == 0 && G * 2 == NB * 8 * 16) { const int xcd = bid & 7, idx = (bid >> 3) + (G >> 3) * (u / G); uu = (4 * xcd + (idx >> 4)) * 16 + (idx & 15); }
                    b = uu >> 7; h = (uu >> 4) & 7; q0 = b * RPB + CTX + (uu & 15) * 256; nk = RPB; }
                else { const int v = u - NB * 8 * 16; b = v >> 3; h = v & 7; q0 = b * RPB; nk = CTX; }
                att::attn_unit(Q + (size_t)q0 * 1536 + h * 192, KV + (size_t)b * RPB * 2048 + h * 256, KR + (size_t)b * RPB * 64, KV + (size_t)b * RPB * 2048 + h * 256 + 128,
                               MIX + (size_t)q0 * DM + h * 128, nk, L, wave);
            }
                }
            }
        }
        SEAM(pb + 3);
        if (PHSEL(6) && IN(pb + 4)) {
            unsigned char* ws = PT.ws(); LAUNDER_G(ws);
            pg8::Gemm g{(const bf16_t*)(ws + WS_MIX), (const bf16_t*)(ws + WS_WOUT) + (size_t)l * DM * DM, NTOK, DM, DM, DM, DM};
            pg8::LatentOrder S; S.init(DM, G, bid);
            pg8::EpiResid E{(float*)(ws + WS_XRES), (const float*)(ws + WS_MOD) + (size_t)l * 5 * NMOD + 2 * DM};
            const bool cfirst = ((bid >> 3) & 1) != 0 && (l < DEPTH - 1);
            float* X = (float*)(ws + WS_XRES); const float* gate = (const float*)(ws + WS_MOD) + ((size_t)l * 5 + 4) * NMOD + 2 * DM;
            for (int step = 0; step < 2; ++step) {
                if ((step == 0) != cfirst) pg8::gemm_phase<pg8::EpiResid, pg8::LatentOrder, true, true>(L, g, S, E, wave);
                else if (l < DEPTH - 1) {
                ctx_gemm(L, (const bf16_t*)(ws + WS_MIX), DM, (const bf16_t*)(ws + WS_WOUT) + (size_t)l * DM * DM, DM, DM, DM, wave, bid, G, [=](int row, int col, float v) { X[(size_t)row * DM + col] += gate[col] * v; });
                }
            }
        }
        SEAM(pb + 4);
        if (PHSEL(7) && IN(pb + 5)) norm2_rows(PT, l, wave, bid, G);
        SEAM(pb + 5);
        if (PHSEL(8) && IN(pb + 6)) {
            unsigned char* ws = PT.ws(); LAUNDER_G(ws);
            pg8::Gemm g{(const bf16_t*)(ws + WS_H), (const bf16_t*)(ws + WS_WQRY) + (size_t)l * DM * DM, NTOK, DM, DM, DM, DM};
            pg8::LatentOrder S; S.init(DM, G, bid);
            pg8::EpiBf16<0> E{(bf16_t*)(ws + WS_QP), DM, nullptr, 0, 0, 1.f};
            pg8::gemm_phase<pg8::EpiBf16<0>, pg8::LatentOrder, true, true>(L, g, S, E, wave);
            if (l < DEPTH - 1) { bf16_t* QPo = (bf16_t*)(ws + WS_QP);
                ctx_gemm(L, (const bf16_t*)(ws + WS_H), DM, (const bf16_t*)(ws + WS_WQRY) + (size_t)l * DM * DM, DM, DM, DM, wave, bid, G, [=](int row, int col, float v) { QPo[(size_t)row * DM + col] = f2bf_safe(v); }); }
        }
        SEAM(pb + 6);
#ifndef DBL_TOPK
#define DBL_TOPK 1
#endif
        if (PHSEL(9) && IN(pb + 7)) { for (int rep = 0; rep < DBL_TOPK; ++rep) { peer_topk_phase(PT, L, l, wave, bid, G); __syncthreads(); } }
        SEAM(pb + 7);
        if (PHSEL(10) && IN(pb + 8)) peer_rows(PT, L, bar.x, l, wave, bid, G);
        SEAM(pb + 8);
    }
}

extern "C" void kernel_launch(void* const* d_in, const int* in_sizes, int n_in, void* d_out, int out_size, void* d_ws, size_t ws_size, hipStream_t stream) {
    static int grid = 0;
    if (grid == 0) {
        if (n_in != 22 || out_size != NB * SEQ * DM || ws_size < WS_END) { fprintf(stderr, "kernel_launch: unexpected shapes: n_in %d out %d ws %zu (need %zu)\n", n_in, out_size, ws_size, (size_t)WS_END); grid = -1; return; }
        int dev = 0, cus = 0, per_cu = 0;
        if (hipGetDevice(&dev) != hipSuccess || hipDeviceGetAttribute(&cus, hipDeviceAttributeMultiprocessorCount, dev) != hipSuccess) { grid = -1; return; }
        if (hipFuncSetAttribute((const void*)mk_fwd, hipFuncAttributeMaxDynamicSharedMemorySize, LDS_BYTES) != hipSuccess) { fprintf(stderr, "kernel_launch: hipFuncSetAttribute failed\n"); grid = -1; return; }
        if (hipOccupancyMaxActiveBlocksPerMultiprocessor(&per_cu, mk_fwd, NTHR, LDS_BYTES) != hipSuccess || per_cu < 1) { fprintf(stderr, "kernel_launch: occupancy query says %d\n", per_cu); grid = -1; return; }
        grid = cus;
    }
    if (grid < 0) return;
    (void)hipMemsetAsync((char*)d_ws + WS_CTL, 0, CTL_BYTES, stream);
    Args a{};
    for (int i = 0; i < 22; ++i) a.in[i] = (const float*)d_in[i];
    a.out = (float*)d_out; a.ws = (unsigned char*)d_ws;
#if MK_MULTI
    for (int p = 0; p < N_PHASES; ++p) { a.ph_lo = p; a.ph_hi = p + 1; hipLaunchKernelGGL(mk_fwd, dim3(grid), dim3(NTHR), LDS_BYTES, stream, a); }
#else
    a.ph_lo = 0; a.ph_hi = N_PHASES;
    hipLaunchKernelGGL(mk_fwd, dim3(grid), dim3(NTHR), LDS_BYTES, stream, a);
#endif
    const hipError_t le = hipPeekAtLastError();
    if (le != hipSuccess) fprintf(stderr, "kernel_launch: launch failed: %s\n", hipGetErrorName(le));
}
```

```cpp
#include <hip/hip_runtime.h>
#include <cstdio>
#include <cstdint>

#ifndef MK_MULTI
#define MK_MULTI 0
#endif

#define GAS __attribute__((address_space(1)))
#define LAS __attribute__((address_space(3)))
typedef unsigned short bf16_t;
typedef short bf16x8 __attribute__((ext_vector_type(8)));
typedef short s16x4 __attribute__((ext_vector_type(4)));
typedef float f32x2 __attribute__((ext_vector_type(2)));
typedef float f32x4 __attribute__((ext_vector_type(4)));
typedef float f32x16 __attribute__((ext_vector_type(16)));
typedef unsigned u32x2 __attribute__((ext_vector_type(2)));
typedef unsigned u32x4 __attribute__((ext_vector_type(4)));
typedef __bf16 bf16v2 __attribute__((ext_vector_type(2)));
typedef unsigned u32x6 __attribute__((ext_vector_type(6)));
typedef float f32x32 __attribute__((ext_vector_type(32)));
typedef __bf16 bf16x32v __attribute__((ext_vector_type(32)));
typedef unsigned u32x16 __attribute__((ext_vector_type(16)));

constexpr int DM = 2048, NB = 4, SEQ = 4096, CTX = 256, RPB = SEQ + CTX, NTOK = NB * RPB, DEPTH = 4;
constexpr int NMOD = 6 * DM;
constexpr int PW = 3840;
constexpr int P_CQ = 0, P_CKV = 512, P_GQ = 768, P_GK = 1280, P_GV = 1792, P_GG = 2816;
constexpr int SIDEW = 96;
constexpr int NCH = RPB / 64;
constexpr int NGU = NB * 4 * NCH;
constexpr int NEXP = 16384;
constexpr float EPS = 1e-6f;
constexpr int NTHR = 512, NWAVES = 8;

constexpr size_t al256(size_t x) { return (x + 255) & ~(size_t)255; }
constexpr size_t WS_CTL = 0, CTL_BYTES = 1u << 20;
constexpr size_t WS_MOD = WS_CTL + CTL_BYTES;
constexpr size_t WS_ROPE = WS_MOD + al256((size_t)DEPTH * 5 * NMOD * 4);
constexpr size_t WS_WIN = WS_ROPE + al256((size_t)2 * SEQ * 32 * 4);
constexpr size_t WS_WSIDE = WS_WIN + (size_t)DEPTH * PW * DM * 2;
constexpr size_t WS_WUQ = WS_WSIDE + (size_t)DEPTH * SIDEW * DM * 2;
constexpr size_t WS_WUKV = WS_WUQ + (size_t)DEPTH * 1536 * 512 * 2;
constexpr size_t WS_WOUT = WS_WUKV + (size_t)DEPTH * 2048 * 256 * 2;
constexpr size_t WS_WQRY = WS_WOUT + (size_t)DEPTH * DM * DM * 2;
constexpr size_t WS_SUBK = WS_WQRY + (size_t)DEPTH * DM * DM * 2;
constexpr int EROW = 1024;
constexpr size_t WS_EU = WS_SUBK + (size_t)DEPTH * 2 * 8 * 128 * 128 * 2;
constexpr size_t WS_EV = WS_EU + (size_t)DEPTH * NEXP * EROW;
constexpr size_t WS_SU = WS_EV + (size_t)DEPTH * NEXP * EROW;
constexpr size_t WS_SV = WS_SU + (size_t)DEPTH * NEXP * 4;
constexpr size_t WS_XRES = WS_SV + (size_t)DEPTH * NEXP * 4;
constexpr size_t WS_H = WS_XRES + (size_t)NTOK * DM * 4;
constexpr size_t WS_P = WS_H + (size_t)NTOK * DM * 2;
constexpr size_t WS_SIDE = WS_P + (size_t)NTOK * PW * 2;
constexpr size_t WS_Q = WS_SIDE + (size_t)NTOK * SIDEW * 4;
constexpr size_t WS_KV = WS_Q + (size_t)NTOK * 1536 * 2;
constexpr size_t WS_KR = WS_KV + (size_t)NTOK * 2048 * 2;
constexpr size_t WS_MIX = WS_KR + (size_t)NTOK * 64 * 2;
constexpr size_t WS_QDEC = WS_MIX + (size_t)NTOK * DM * 2;
constexpr size_t WS_OINTRA = WS_QDEC + (size_t)NGU * 2 * 64 * 128 * 2;
constexpr size_t WS_DS = WS_OINTRA + (size_t)NTOK * 1024 * 4;
constexpr size_t WS_DEC = WS_DS + (size_t)2 * 16 * NCH * 32768 * 2;
constexpr size_t WS_SENT = WS_DEC + al256((size_t)2 * 16 * NCH * 128 * 4);
constexpr size_t WS_QP = WS_SENT + (size_t)2 * 16 * NCH * 32768 * 2;
constexpr size_t WS_IDX = WS_QP + (size_t)NTOK * DM * 2;
constexpr size_t WS_GATE = WS_IDX + (size_t)NTOK * 128 * 4;
constexpr size_t WS_END = WS_GATE + (size_t)NTOK * 128 * 4;

constexpr int CW_DBG = 8;
constexpr int CW_BAR = 4096;
constexpr int CW_RND = 8192;

constexpr int LDS_BYTES = 163840;
constexpr int LDS_CTL_OFF = LDS_BYTES - 256;

__device__ __forceinline__ unsigned cvt_pk(float lo, float hi) { unsigned r; asm volatile("v_cvt_pk_bf16_f32 %0, %1, %2" : "=v"(r) : "v"(lo), "v"(hi)); return r; }
__device__ __forceinline__ unsigned cvt_pk_safe(float lo, float hi) { const f32x2 v = {lo, hi}; const bf16v2 b = __builtin_convertvector(v, bf16v2); return __builtin_bit_cast(unsigned, b); }
__device__ __forceinline__ unsigned cvt_pk_asm(float lo, float hi) { unsigned r; asm volatile("v_cvt_pk_bf16_f32 %0, %1, %2" : "=v"(r) : "v"(lo), "v"(hi)); return r; }
__device__ __forceinline__ float bflo(unsigned w) { return __builtin_bit_cast(float, w << 16); }
__device__ __forceinline__ float bfhi(unsigned w) { return __builtin_bit_cast(float, w & 0xffff0000u); }
__device__ __forceinline__ float bf2f(bf16_t b) { return __builtin_bit_cast(float, (unsigned)b << 16); }
__device__ __forceinline__ bf16_t f2bf_safe(float f) { return (bf16_t)(cvt_pk_safe(f, 0.f) & 0xffffu); }
__device__ __forceinline__ bf16_t f2bf(float f) { return (bf16_t)(cvt_pk(f, 0.f) & 0xffffu); }
#define DPP_I(v, ctrl) __builtin_amdgcn_update_dpp(0, (v), (ctrl), 0xF, 0xF, true)
__device__ __forceinline__ int lane_id();
__device__ __forceinline__ int shx_i(int v, int o) {
    switch (o) {
    case 1: return DPP_I(v, 0xB1);
    case 2: return DPP_I(v, 0x4E);
    case 4: return DPP_I(DPP_I(v, 0x1B), 0x141);
    case 8: return DPP_I(v, 0x128);
    default: return __builtin_amdgcn_ds_bpermute((lane_id() ^ o) << 2, v);
    }
}
__device__ __forceinline__ float shx_f(float v, int o) { return __builtin_bit_cast(float, shx_i(__builtin_bit_cast(int, v), o)); }
#define DPP_F(v, ctrl) __builtin_bit_cast(float, DPP_I(__builtin_bit_cast(int, (v)), (ctrl)))
#define RL_F(v, l) __builtin_bit_cast(float, __builtin_amdgcn_readlane(__builtin_bit_cast(int, (v)), (l)))
__device__ __forceinline__ float wave_sum(float v) {
    v += DPP_F(v, 0xB1); v += DPP_F(v, 0x4E); v += DPP_F(v, 0x141); v += DPP_F(v, 0x140);
    return (RL_F(v, 0) + RL_F(v, 16)) + (RL_F(v, 32) + RL_F(v, 48));
}
__device__ __forceinline__ float wave_max(float v) {
    v = fmaxf(v, DPP_F(v, 0xB1)); v = fmaxf(v, DPP_F(v, 0x4E)); v = fmaxf(v, DPP_F(v, 0x141)); v = fmaxf(v, DPP_F(v, 0x140));
    return fmaxf(fmaxf(RL_F(v, 0), RL_F(v, 16)), fmaxf(RL_F(v, 32), RL_F(v, 48)));
}
__device__ __forceinline__ int wave_sum_i(int v) {
    v += DPP_I(v, 0xB1); v += DPP_I(v, 0x4E); v += DPP_I(v, 0x141); v += DPP_I(v, 0x140);
    return (__builtin_amdgcn_readlane(v, 0) + __builtin_amdgcn_readlane(v, 16)) + (__builtin_amdgcn_readlane(v, 32) + __builtin_amdgcn_readlane(v, 48));
}
__device__ __forceinline__ int crow(int r, int hi) { return (r & 3) + 8 * (r >> 2) + 4 * hi; }
__device__ __forceinline__ int modrow(int r) { const int b = r / RPB; return (r - b * RPB) < CTX ? 4 : b; }
__device__ __forceinline__ int lane_id() { int l; asm volatile("v_mbcnt_lo_u32_b32 %0, -1, 0\n\tv_mbcnt_hi_u32_b32 %0, -1, %0" : "=&v"(l)); return l; }
#define LDS_WAIT() asm volatile("s_waitcnt lgkmcnt(0)" ::: "memory")
#define VM_WAIT() asm volatile("s_waitcnt vmcnt(0)" ::: "memory")
#define SBAR() __builtin_amdgcn_sched_barrier(0)
#define LAUNDER_G(p) do { GAS unsigned char* _g = (GAS unsigned char*)(p); asm volatile("" : "+s"(_g)); (p) = (unsigned char*)_g; } while (0)

namespace pg8 {
#define PG8_LAS __attribute__((address_space(3)))
typedef unsigned short bf16_t;
typedef short bf16x8 __attribute__((ext_vector_type(8)));
typedef float f32x4 __attribute__((ext_vector_type(4)));
typedef unsigned u32x4 __attribute__((ext_vector_type(4)));
constexpr int BM = 256, BK = 64, HALF = 128, HTB = HALF * BK * 2  , STAGE_BYTES = 8 * HTB, NXCD = 8, WGM = 8;

__host__ __device__ __forceinline__ int lds_byte(int r, int c) { const int st = (r >> 4) * 2 + (c >> 5), rr = r & 15, cc = c & 31, ob = rr * 64 + cc * 2; return st * 1024 + (ob ^ (((ob >> 9) & 1) << 5)); }
__host__ __device__ __forceinline__ void stage_rc(int b, int& R, int& C) { const int st = b / 1024, sb = b % 1024, swz = sb ^ (((sb >> 9) & 1) << 5); R = (st >> 1) * 16 + swz / 64; C = (st & 1) * 32 + (swz % 64) / 2; }
__host__ __device__ __forceinline__ int perm32(int rho) { const int n = rho >> 4, i = rho & 15; return 8 * (i >> 2) + 4 * n + (i & 3); }

struct Unit { int pm, pn; };
struct Gemm { const bf16_t* A; const bf16_t* Bt; int M, N, K, lda, ldb; };

struct StaticOrder {
    int nM, nN, nwg, G, c;
    __host__ __device__ void init(int M, int N, int G_, int c_) { nM = M / BM; nN = N / BM; nwg = nM * nN; G = G_; c = c_; }
    __host__ __device__ bool next(int i, Unit& u) const {
        const long L = (long)i * G + c; if (L >= nwg) return false;
        int wgid = (int)L; { const int q = nwg / NXCD, r = nwg % NXCD, xcd = wgid % NXCD, off = wgid / NXCD; wgid = (xcd < r ? xcd * (q + 1) : r * (q + 1) + (xcd - r) * q) + off; }
        const int nig = WGM * nN, gid = wgid / nig, fm = gid * WGM, gsz = (nM - fm) < WGM ? (nM - fm) : WGM;
        u.pm = fm + ((wgid % nig) % gsz); u.pn = (wgid % nig) / gsz; return true;
    }
    __device__ __forceinline__ void a_ready(const Unit&) const {}
    __device__ __forceinline__ void done(const Unit&) const {}
};
struct LatentOrder : StaticOrder {
    __host__ __device__ void init(int N, int G_, int c_) { StaticOrder::init(16384, N, G_, c_); }
    __host__ __device__ bool next(int i, Unit& u) const { if (!StaticOrder::next(i, u)) return false; u.pm = u.pm + (u.pm >> 4) + 1; return true; }
};


__device__ __forceinline__ unsigned cvt_pk_bf16(float lo, float hi) { return ::cvt_pk_asm(lo, hi); }

template <int ACT  > struct EpiBf16 {
    static constexpr bool PERM = true, AFTER_DRAIN = false; static_assert(ACT == 0, "EpiBf16: no activation here");
    bf16_t* O; int ldc; const float* bias; int split_cols; size_t split_stride; float scale0;
    __device__ __forceinline__ void operator()(const f32x4 (&acc)[2][2][4][2], const Unit& u, int wr, int wc, int fr, int fq) const {
        const int row0 = u.pm * BM + wr * 64 + fr; int colt = u.pn * BM; bf16_t* base = O;
        float sc = 1.f; if (split_cols) { const int t = colt / split_cols; base += (size_t)t * split_stride; colt -= t * split_cols; if (t == 0) sc = scale0; }
        const int col0 = colt + wc * 32 + 8 * fq, bcol0 = u.pn * BM + wc * 32 + 8 * fq;
        f32x4 bv[2][2];
#pragma unroll
        for (int bj = 0; bj < 2; ++bj)
#pragma unroll
            for (int n = 0; n < 2; ++n) bv[bj][n] = bias ? *(const f32x4*)(bias + bcol0 + bj * HALF + 4 * n) : (f32x4){0.f, 0.f, 0.f, 0.f};
#pragma unroll
        for (int ai = 0; ai < 2; ++ai)
#pragma unroll
            for (int m = 0; m < 4; ++m) { bf16_t* rowp = base + (size_t)(row0 + ai * HALF + m * 16) * ldc + col0;
#pragma unroll
                for (int bj = 0; bj < 2; ++bj) { f32x4 v0 = acc[ai][bj][m][0] + bv[bj][0], v1 = acc[ai][bj][m][1] + bv[bj][1];
                    v0 = v0 * sc; v1 = v1 * sc; u32x4 w; w.x = cvt_pk_bf16(v0[0], v0[1]); w.y = cvt_pk_bf16(v0[2], v0[3]); w.z = cvt_pk_bf16(v1[0], v1[1]); w.w = cvt_pk_bf16(v1[2], v1[3]);
                    *(u32x4*)(rowp + bj * HALF) = w; } }
    }
};


template <class Epi, class Sched, bool ALIGN_EPI = false, bool SP2 = false>
__device__ __forceinline__ void gemm_phase(PG8_LAS unsigned char* lds, const Gemm g, const Sched& S, const Epi& E, int wid) {
    asm volatile("" : "+s"(wid));
    const int lane = lane_id(), tid = wid * 64 + lane, wr = wid >> 2, wc = wid & 3, fr = lane & 15, fq = lane >> 4;
    const int K = g.K, nt = K / BK;
    unsigned voffA[2], voffB[2];
#pragma unroll
    for (int i = 0; i < 2; ++i) { int R, C; stage_rc(tid * 16 + i * 8192, R, C); const int Rb = Epi::PERM ? ((R & ~31) + perm32(R & 31)) : R;
        voffA[i] = (unsigned)(R * g.lda + C) * 2u; voffB[i] = (unsigned)(Rb * g.ldb + C) * 2u; }
    const size_t kstep = (size_t)(BK * 2);
    const size_t hstepA = (size_t)HALF * g.lda * 2, hstepB = (size_t)HALF * g.ldb * 2;
    const size_t tstepA = 2 * hstepA, tstepB = 2 * hstepB;
    const unsigned ldsw = (unsigned)wid * 1024u;
    const int aoff = lds_byte(wr * 64 + fr, fq * 8), boff = lds_byte(wc * 32 + fr, fq * 8);
#define PG8_SA(b, h) (((b) * 2 + (h)) * HTB)
#define PG8_SB(b, h) ((4 + (b) * 2 + (h)) * HTB)
#define PG8_STAGE(bufoff, gbase, voff) do { _Pragma("unroll") for (int _i = 0; _i < 2; ++_i) \
        __builtin_amdgcn_global_load_lds((const unsigned*)((const char*)(gbase) + (voff)[_i]), (PG8_LAS unsigned*)(lds + (bufoff) + ldsw + _i * 8192), 16, 0, 0); } while (0)
#define PG8_LDA(dst, b, h) do { _Pragma("unroll") for (int m = 0; m < 4; ++m) _Pragma("unroll") for (int k = 0; k < 2; ++k) dst[m][k] = *(const PG8_LAS bf16x8*)(lds + PG8_SA(b, h) + aoff + m * 2048 + k * 1024); } while (0)
#define PG8_LDB(dst, b, h) do { _Pragma("unroll") for (int n = 0; n < 2; ++n) _Pragma("unroll") for (int k = 0; k < 2; ++k) dst[n][k] = *(const PG8_LAS bf16x8*)(lds + PG8_SB(b, h) + boff + n * 2048 + k * 1024); } while (0)
#define PG8_MMA(ai, bj, At, Bt) do { __builtin_amdgcn_s_setprio(1); _Pragma("unroll") for (int m = 0; m < 4; ++m) _Pragma("unroll") for (int n = 0; n < 2; ++n) _Pragma("unroll") for (int k = 0; k < 2; ++k) \
        acc[ai][bj][m][n] = __builtin_amdgcn_mfma_f32_16x16x32_bf16(Bt[n][k], At[m][k], acc[ai][bj][m][n], 0, 0, 0); __builtin_amdgcn_s_setprio(0); } while (0)
#define PG8_WAIT_V(n) asm volatile("s_waitcnt vmcnt(" #n ")" ::: "memory")
#define PG8_WAIT_L(n) asm volatile("s_waitcnt lgkmcnt(" #n ")" ::: "memory")
#define PG8_BAR __builtin_amdgcn_s_barrier()
#define PG8_SCHED __builtin_amdgcn_sched_barrier(0)
    Unit cur, nxt; int ui = 0;
    if (!S.next(0, cur)) return;
    f32x4 acc[2][2][4][2];
#pragma unroll
    for (int a = 0; a < 2; ++a)
#pragma unroll
        for (int b = 0; b < 2; ++b)
#pragma unroll
            for (int m = 0; m < 4; ++m)
#pragma unroll
                for (int n = 0; n < 2; ++n) acc[a][b][m][n] = (f32x4){0.f, 0.f, 0.f, 0.f};
    bf16x8 At[4][2], B0[2][2], B1[2][2];
    const char* cA = (const char*)g.A + (size_t)cur.pm * tstepA; const char* cB = (const char*)g.Bt + (size_t)cur.pn * tstepB;
    S.a_ready(cur);
    if constexpr (SP2) {
        PG8_STAGE(PG8_SB(0, 0), cB, voffB); PG8_STAGE(PG8_SB(0, 1), cB + hstepB, voffB); PG8_STAGE(PG8_SA(0, 0), cA, voffA); PG8_STAGE(PG8_SA(0, 1), cA + hstepA, voffA);
        if (wr == 1) PG8_BAR;
        PG8_WAIT_V(2); PG8_BAR;
        PG8_STAGE(PG8_SB(1, 0), cB + kstep, voffB); PG8_STAGE(PG8_SA(1, 0), cA + kstep, voffA); PG8_STAGE(PG8_SB(1, 1), cB + hstepB + kstep, voffB);
        PG8_WAIT_V(6); PG8_BAR;
    } else {
        PG8_STAGE(PG8_SB(0, 0), cB, voffB); PG8_STAGE(PG8_SA(0, 0), cA, voffA); PG8_STAGE(PG8_SB(0, 1), cB + hstepB, voffB); PG8_STAGE(PG8_SA(0, 1), cA + hstepA, voffA);
        if (wr == 1) PG8_BAR;
        PG8_WAIT_V(4); PG8_BAR;
        PG8_STAGE(PG8_SB(1, 0), cB + kstep, voffB); PG8_STAGE(PG8_SA(1, 0), cA + kstep, voffA); PG8_STAGE(PG8_SB(1, 1), cB + hstepB + kstep, voffB);
        PG8_WAIT_V(6); PG8_BAR;
    }
    for (;;) {
        const bool has_next = S.next(ui + 1, nxt);
        const char* nA = has_next ? (const char*)g.A + (size_t)nxt.pm * tstepA : cA; const char* nB = has_next ? (const char*)g.Bt + (size_t)nxt.pn * tstepB : cB;
#pragma unroll 1
        for (int t = 0; t < nt; t += 2) {
            const bool last = (t == nt - 2);
            const char* a1 = cA + (size_t)(t + 1) * kstep;
            const char* a2 = last ? nA : cA + (size_t)(t + 2) * kstep; const char* b2 = last ? nB : cB + (size_t)(t + 2) * kstep;
            const char* a3 = a2 + kstep; const char* b3 = b2 + kstep;
            if (last && has_next) S.a_ready(nxt);
            if constexpr (SP2) {
            PG8_LDB(B0, 0, 0); PG8_LDB(B1, 0, 1); PG8_SCHED; PG8_LDA(At, 0, 0); PG8_STAGE(PG8_SA(1, 1), a1 + hstepA, voffA);
            PG8_WAIT_V(8); PG8_WAIT_L(0); PG8_BAR; PG8_MMA(0, 0, At, B0); PG8_MMA(0, 1, At, B1); PG8_BAR; PG8_SCHED;
            PG8_LDA(At, 0, 1); PG8_STAGE(PG8_SB(0, 0), b2, voffB); PG8_STAGE(PG8_SB(0, 1), b2 + hstepB, voffB); PG8_STAGE(PG8_SA(0, 0), a2, voffA);
            PG8_WAIT_V(8); PG8_WAIT_L(0); PG8_BAR; PG8_MMA(1, 0, At, B0); PG8_MMA(1, 1, At, B1); PG8_BAR; PG8_SCHED;
            PG8_LDB(B0, 1, 0); PG8_LDB(B1, 1, 1); PG8_SCHED; PG8_LDA(At, 1, 0); PG8_STAGE(PG8_SA(0, 1), a2 + hstepA, voffA);
            PG8_WAIT_V(8); PG8_WAIT_L(0); PG8_BAR; PG8_MMA(0, 0, At, B0); PG8_MMA(0, 1, At, B1); PG8_BAR; PG8_SCHED;
            PG8_LDA(At, 1, 1); PG8_STAGE(PG8_SB(1, 0), b3, voffB); PG8_STAGE(PG8_SB(1, 1), b3 + hstepB, voffB); PG8_STAGE(PG8_SA(1, 0), a3, voffA);
            PG8_WAIT_V(8); PG8_WAIT_L(0); PG8_BAR; PG8_MMA(1, 0, At, B0); PG8_MMA(1, 1, At, B1); PG8_BAR; PG8_SCHED;
            } else {
            PG8_LDB(B0, 0, 0); PG8_SCHED; PG8_LDA(At, 0, 0); PG8_STAGE(PG8_SA(1, 1), a1 + hstepA, voffA);
            PG8_WAIT_L(8); PG8_BAR; PG8_WAIT_L(0); PG8_MMA(0, 0, At, B0); PG8_BAR; PG8_SCHED;
            PG8_LDB(B1, 0, 1); PG8_STAGE(PG8_SB(0, 0), b2, voffB);
            PG8_BAR; PG8_WAIT_L(0); PG8_MMA(0, 1, At, B1); PG8_BAR;
            PG8_LDA(At, 0, 1); PG8_STAGE(PG8_SA(0, 0), a2, voffA);
            PG8_BAR; PG8_WAIT_L(0); PG8_MMA(1, 0, At, B0); PG8_BAR; PG8_SCHED;
            PG8_STAGE(PG8_SB(0, 1), b2 + hstepB, voffB);
            PG8_WAIT_V(6); PG8_BAR; PG8_MMA(1, 1, At, B1); PG8_BAR;
            PG8_LDB(B0, 1, 0); PG8_SCHED; PG8_LDA(At, 1, 0); PG8_STAGE(PG8_SA(0, 1), a2 + hstepA, voffA);
            PG8_WAIT_L(8); PG8_BAR; PG8_WAIT_L(0); PG8_MMA(0, 0, At, B0); PG8_BAR; PG8_SCHED;
            PG8_LDB(B1, 1, 1); PG8_STAGE(PG8_SB(1, 0), b3, voffB);
            PG8_BAR; PG8_WAIT_L(0); PG8_MMA(0, 1, At, B1); PG8_BAR;
            PG8_LDA(At, 1, 1); PG8_STAGE(PG8_SA(1, 0), a3, voffA);
            PG8_BAR; PG8_WAIT_L(0); PG8_MMA(1, 0, At, B0); PG8_BAR; PG8_SCHED;
            PG8_STAGE(PG8_SB(1, 1), b3 + hstepB, voffB);
            PG8_WAIT_V(6); PG8_BAR; PG8_MMA(1, 1, At, B1); PG8_BAR;
            }
        }
        if constexpr (ALIGN_EPI) { if (wr == 0) PG8_BAR; }
        if constexpr (!Epi::AFTER_DRAIN) { E(acc, cur, wr, wc, fr, fq); S.done(cur); }
        if (!has_next) break;
#pragma unroll
        for (int a = 0; a < 2; ++a)
#pragma unroll
            for (int b = 0; b < 2; ++b)
#pragma unroll
                for (int m = 0; m < 4; ++m)
#pragma unroll
                    for (int n = 0; n < 2; ++n) acc[a][b][m][n] = (f32x4){0.f, 0.f, 0.f, 0.f};
        cur = nxt; cA = nA; cB = nB; ++ui;
        if constexpr (ALIGN_EPI) { if (wr == 1) PG8_BAR; }
    }
    PG8_WAIT_V(0);
    if constexpr (!ALIGN_EPI) { if (wr == 0) PG8_BAR; }
    PG8_BAR;
    if constexpr (Epi::AFTER_DRAIN) { E.fused(acc, cur, wr, wc, fr, fq, lds, wid, lane); S.done(cur); }
#undef PG8_SA
#undef PG8_SB
#undef PG8_STAGE
#undef PG8_LDA
#undef PG8_LDB
#undef PG8_MMA
#undef PG8_WAIT_V
#undef PG8_WAIT_L
#undef PG8_BAR
#undef PG8_SCHED
}
}
#define XB_TMO      128
#define XB_XCNT(j)  (256  + 64 * (j))
#define XB_XSUB(j)  (1280 + 64 * (j))
#define XB_XGEN(j)  (2304 + 64 * (j))
#define XB_TOP      3328
#define XB_TOPGEN   3392
#define XCD_BAR_WORDS 3456
#define XB_SPIN_CAP (1u << 22)

__device__ __forceinline__ unsigned xb_ld(unsigned* p)              { return __hip_atomic_load(p, __ATOMIC_RELAXED, __HIP_MEMORY_SCOPE_AGENT); }
__device__ __forceinline__ unsigned xb_add(unsigned* p, unsigned v) { return __hip_atomic_fetch_add(p, v, __ATOMIC_RELAXED, __HIP_MEMORY_SCOPE_AGENT); }
__device__ __forceinline__ unsigned xb_xcc_id() { return (unsigned)__builtin_amdgcn_s_getreg((3 << 11) | 20) & 0xFu; }
#define XB_SPIN(cond, bar) do { unsigned _sp = 0; while (cond) { __builtin_amdgcn_s_sleep(1); \
    if ((++_sp & 255u) == 0u) { if (xb_ld(&(bar)[XB_TMO])) break; if (_sp > XB_SPIN_CAP) { atomicAdd(&(bar)[XB_TMO], 1u); break; } } } } while (0)

struct XcdBarrier {
    unsigned* bar; unsigned x; unsigned wv;
    volatile LAS unsigned* st;
};

__device__ __forceinline__ XcdBarrier xcd_barrier_post(unsigned* bar, volatile LAS unsigned* st) {
    XcdBarrier b; b.bar = bar; b.x = xb_xcc_id(); b.st = st; b.wv = 0u;
    if (threadIdx.x == 0) (void)xb_add(&bar[XB_XCNT(b.x)], 1u);
    return b;
}
__device__ __forceinline__ void xcd_barrier_complete(unsigned* bar, unsigned x, unsigned& nloc, unsigned& nx) {
    const unsigned G = gridDim.x * gridDim.y * gridDim.z;
    unsigned sum, cnt, mine, sp = 0u;
    for (;;) {
        sum = 0u; cnt = 0u; mine = 0u;
#pragma unroll
        for (unsigned j = 0; j < 16; ++j) { const unsigned c = xb_ld(&bar[XB_XCNT(j)]); sum += c; cnt += (c > 0u) ? 1u : 0u; mine = (j == x) ? c : mine; }
        if (sum == G) break;
        __builtin_amdgcn_s_sleep(1);
        if ((++sp & 255u) == 0u) { if (xb_ld(&bar[XB_TMO])) break; if (sp > XB_SPIN_CAP) { atomicAdd(&bar[XB_TMO], 1u); break; } }
    }
    nloc = mine > 0u ? mine : 1u; nx = cnt > 0u ? cnt : 1u;
}

__device__ __forceinline__ void xcd_barrier(const XcdBarrier& b) {
    asm volatile("s_waitcnt vmcnt(0)" ::: "memory");
    __syncthreads();
    if (b.wv == 0u && lane_id() == 0) {
        unsigned* bar = b.bar;
        __builtin_amdgcn_s_waitcnt(0);
        unsigned nloc = b.st[0], nx = b.st[1];
        if (nloc == 0u) { xcd_barrier_complete(bar, b.x, nloc, nx); b.st[0] = nloc; b.st[1] = nx; }
        const unsigned old = xb_add(&bar[XB_XSUB(b.x)], 1u);
        const unsigned gen = old / nloc;
        if (old + 1u == (gen + 1u) * nloc) {
            __builtin_amdgcn_fence(__ATOMIC_RELEASE, "agent");
            asm volatile("s_waitcnt vmcnt(0)" ::: "memory");
            const unsigned og = xb_add(&bar[XB_TOP], 1u);
            const unsigned tg = og / nx;
            if (og + 1u == (tg + 1u) * nx) xb_add(&bar[XB_TOPGEN], 1u);
            else XB_SPIN(xb_ld(&bar[XB_TOPGEN]) == tg, bar);
            __builtin_amdgcn_fence(__ATOMIC_ACQUIRE, "agent");
            xb_add(&bar[XB_XGEN(b.x)], 1u);
            asm volatile("s_waitcnt vmcnt(0)" ::: "memory");
        } else {
            XB_SPIN(xb_ld(&bar[XB_XGEN(b.x)]) == gen, bar);
            __builtin_amdgcn_fence(__ATOMIC_ACQUIRE, "agent");
            asm volatile("s_waitcnt vmcnt(0)" ::: "memory");
        }
    }
    __syncthreads();
}

namespace pg8 {
struct EpiQRope {
    static constexpr bool PERM = true, AFTER_DRAIN = false;
    bf16_t* O; const float* cosT; const float* sinT;
    __device__ __forceinline__ void operator()(const f32x4 (&acc)[2][2][4][2], const Unit& u, int wr, int wc, int fr, int fq) const {
        const int row0 = u.pm * BM + wr * 64 + fr, colb = u.pn * BM + wc * 32 + 8 * fq;
#pragma unroll
        for (int ai = 0; ai < 2; ++ai)
#pragma unroll
            for (int m = 0; m < 4; ++m) {
                const int row = row0 + ai * HALF + m * 16; const int b = row / RPB, t = row - b * RPB - CTX;
                bf16_t* rowp = O + (size_t)row * 1536;
#pragma unroll
                for (int bj = 0; bj < 2; ++bj) {
                    const int col = colb + bj * HALF; const int hh = col / 192, jj = col - hh * 192;
                    f32x4 v0 = acc[ai][bj][m][0], v1 = acc[ai][bj][m][1];
                    if (jj >= 128 && t >= 0) {
                        const int i0 = (jj - 128) >> 1;
                        const f32x4 c4 = *(const f32x4*)(cosT + (size_t)t * 32 + i0), s4 = *(const f32x4*)(sinT + (size_t)t * 32 + i0);
                        f32x4 w0, w1;
                        w0.x = v0.x * c4.x - v0.y * s4.x; w0.y = v0.x * s4.x + v0.y * c4.x;
                        w0.z = v0.z * c4.y - v0.w * s4.y; w0.w = v0.z * s4.y + v0.w * c4.y;
                        w1.x = v1.x * c4.z - v1.y * s4.z; w1.y = v1.x * s4.z + v1.y * c4.z;
                        w1.z = v1.z * c4.w - v1.w * s4.w; w1.w = v1.z * s4.w + v1.w * c4.w;
                        v0 = w0; v1 = w1;
                    }
                    u32x4 w; w.x = cvt_pk_bf16(v0[0], v0[1]); w.y = cvt_pk_bf16(v0[2], v0[3]); w.z = cvt_pk_bf16(v1[0], v1[1]); w.w = cvt_pk_bf16(v1[2], v1[3]);
                    *(u32x4*)(rowp + col) = w;
                }
            }
    }
};
struct EpiResid {
    static constexpr bool PERM = false, AFTER_DRAIN = false;
    float* X; const float* gate;
    __device__ __forceinline__ void operator()(const f32x4 (&acc)[2][2][4][2], const Unit& u, int wr, int wc, int fr, int fq) const {
        const int row0 = u.pm * BM + wr * 64 + fr, col0 = u.pn * BM + wc * 32 + 4 * fq;
#pragma unroll
        for (int ai = 0; ai < 2; ++ai)
#pragma unroll
            for (int m = 0; m < 4; ++m) {
                const int row = row0 + ai * HALF + m * 16; const float* gp = gate + (size_t)modrow(row) * NMOD + col0; float* xp = X + (size_t)row * DM + col0;
#pragma unroll
                for (int bj = 0; bj < 2; ++bj)
#pragma unroll
                    for (int n = 0; n < 2; ++n) { const int c = bj * HALF + n * 16; const f32x4 g4 = *(const f32x4*)(gp + c); f32x4 x4 = *(const f32x4*)(xp + c); x4 += g4 * acc[ai][bj][m][n]; *(f32x4*)(xp + c) = x4; }
            }
    }
};
}

struct Args { const float* in[22]; float* out; unsigned char* ws; int ph_lo, ph_hi; };
struct Ptrs {
    LAS unsigned char* L;
    __device__ __forceinline__ unsigned long long raw(int i) const { const unsigned long long v = *(volatile LAS unsigned long long*)(L + LDS_CTL_OFF + 64 + 8 * i);
        const unsigned lo = __builtin_amdgcn_readfirstlane((unsigned)v), hi = __builtin_amdgcn_readfirstlane((unsigned)(v >> 32)); return ((unsigned long long)hi << 32) | lo; }
    __device__ __forceinline__ const float* in(int i) const { return (const float*)(GAS const float*)raw(i); }
    __device__ __forceinline__ float* out() const { return (float*)(GAS float*)raw(22); }
    __device__ __forceinline__ unsigned char* ws() const { return (unsigned char*)(GAS unsigned char*)raw(23); }
};

__device__ __forceinline__ void row_load_f32(const float* src, int lane, float (&v)[4][8]) {
#pragma unroll
    for (int i = 0; i < 4; ++i) { const f32x4 a = *(const f32x4*)(src + (lane + 64 * i) * 8), b = *(const f32x4*)(src + (lane + 64 * i) * 8 + 4);
        v[i][0] = a.x; v[i][1] = a.y; v[i][2] = a.z; v[i][3] = a.w; v[i][4] = b.x; v[i][5] = b.y; v[i][6] = b.z; v[i][7] = b.w; }
}
__device__ __forceinline__ void row_store_f32(float* dst, int lane, const float (&v)[4][8]) {
#pragma unroll
    for (int i = 0; i < 4; ++i) { *(f32x4*)(dst + (lane + 64 * i) * 8) = (f32x4){v[i][0], v[i][1], v[i][2], v[i][3]}; *(f32x4*)(dst + (lane + 64 * i) * 8 + 4) = (f32x4){v[i][4], v[i][5], v[i][6], v[i][7]}; }
}
__device__ __forceinline__ float row_rstd(const float (&v)[4][8]) {
    float ss = 0.f;
#pragma unroll
    for (int i = 0; i < 4; ++i)
#pragma unroll
        for (int j = 0; j < 8; ++j) ss += v[i][j] * v[i][j];
    ss = wave_sum(ss);
    return 1.0f / sqrtf(ss * (1.0f / DM) + EPS);
}
__device__ __forceinline__ void norm_mod_store(const float (&v)[4][8], float rstd, const float* g, const float* sh, const float* sc, bf16_t* hrow, int lane) {
#pragma unroll
    for (int i = 0; i < 4; ++i) { const int col = (lane + 64 * i) * 8; float gg[8], ss[8], cc[8];
        *(f32x4*)&gg[0] = *(const f32x4*)(g + col); *(f32x4*)&gg[4] = *(const f32x4*)(g + col + 4);
        *(f32x4*)&ss[0] = *(const f32x4*)(sh + col); *(f32x4*)&ss[4] = *(const f32x4*)(sh + col + 4);
        *(f32x4*)&cc[0] = *(const f32x4*)(sc + col); *(f32x4*)&cc[4] = *(const f32x4*)(sc + col + 4);
        float y[8];
#pragma unroll
        for (int j = 0; j < 8; ++j) y[j] = (v[i][j] * rstd * gg[j]) * (1.f + cc[j]) + ss[j];
        u32x4 o; o.x = cvt_pk(y[0], y[1]); o.y = cvt_pk(y[2], y[3]); o.z = cvt_pk(y[4], y[5]); o.w = cvt_pk(y[6], y[7]);
        *(u32x4*)(hrow + col) = o; }
}

template <class RM>
__device__ __forceinline__ void transpose_item(const float* W, int K, int N, int item, LAS float* scr, int lane, const RM& rm) {
    const int nblk = N / 32, kb = item / nblk, nb = item - kb * nblk, k0 = 64 * kb, n0 = 32 * nb;
#pragma unroll 8
    for (int i = 0; i < 32; ++i) { const int kk = 2 * i + (lane >> 5); scr[kk * 33 + (lane & 31)] = W[(size_t)(k0 + kk) * N + n0 + (lane & 31)]; }
    LDS_WAIT(); asm volatile("" ::: "memory");
    const int c = lane & 7;
#pragma unroll
    for (int j = 0; j < 4; ++j) { const int n = (lane >> 3) + 8 * j; const LAS float* s = scr + (8 * c) * 33 + n;
        u32x4 o; o.x = cvt_pk(s[0], s[33]); o.y = cvt_pk(s[66], s[99]); o.z = cvt_pk(s[132], s[165]); o.w = cvt_pk(s[198], s[231]);
        *(u32x4*)(rm(n0 + n) + k0 + 8 * c) = o; }
    LDS_WAIT(); asm volatile("" ::: "memory");
}

__device__ __forceinline__ void p0a(const Ptrs& A, LAS unsigned char* L, int wave, int bid, int G) { asm volatile("" : "+s"(wave)); const int lane = lane_id(); const int tid = wave * 64 + lane; (void)tid;
    unsigned char* ws = A.ws(); LAUNDER_G(ws);
    {
        LAS float* sl = (LAS float*)L;
        LAS float* red = (LAS float*)(L + 40960);
        for (int i = tid; i < 5 * DM; i += NTHR) { const int r = i / DM, k = i - r * DM; const float c = r < 4 ? A.in(1)[r * DM + k] : A.in(3)[k]; sl[i] = c / (1.f + expf(-c)); }
        __syncthreads();
        float* MOD = (float*)(ws + WS_MOD);
        for (int u = bid; u < DEPTH * 192; u += G) {
            const int l = u / 192, nt = u - l * 192, cg = tid & 15, kg = tid >> 4;
            const float* wp = A.in(4) + ((size_t)l * DM + kg * 64) * NMOD + nt * 64 + cg * 4;
            f32x4 acc[5];
#pragma unroll
            for (int r = 0; r < 5; ++r) acc[r] = (f32x4){0.f, 0.f, 0.f, 0.f};
#pragma unroll 8
            for (int kk = 0; kk < 64; ++kk) { const f32x4 w = *(const f32x4*)(wp + (size_t)kk * NMOD); const int k = kg * 64 + kk;
#pragma unroll
                for (int r = 0; r < 5; ++r) acc[r] += w * sl[r * DM + k]; }
#pragma unroll
            for (int r = 0; r < 5; ++r) *(LAS f32x4*)(red + (kg * 5 + r) * 64 + cg * 4) = acc[r];
            __syncthreads();
            if (tid < 320) { const int r = tid >> 6, col = tid & 63; float s = 0.f;
                for (int g = 0; g < 32; ++g) s += red[(g * 5 + r) * 64 + col];
                MOD[((size_t)l * 5 + r) * NMOD + nt * 64 + col] = s + A.in(5)[l * NMOD + nt * 64 + col]; }
            __syncthreads();
        }
    }
    {
        LAS float* scr = (LAS float*)(L + wave * 16384);
        const int gw = bid * NWAVES + wave, NGW = G * NWAVES;
        constexpr int I_IN = 32 * 123, I_UQ = 8 * 48, I_UKV = 4 * 64, I_SQ = 32 * 64, I_L = I_IN + I_UQ + I_UKV + 2 * I_SQ;
        for (int it = gw; it < DEPTH * I_L; it += NGW) {
            const int l = it / I_L; int r = it - l * I_L;
            if (r < I_IN) {
                bf16_t* mainp = (bf16_t*)(ws + WS_WIN) + (size_t)l * PW * DM; bf16_t* sidep = (bf16_t*)(ws + WS_WSIDE) + (size_t)l * SIDEW * DM;
                transpose_item(A.in(8) + (size_t)l * DM * 3936, DM, 3936, r, scr, lane, [=](int n) -> bf16_t* {
                    return n < 768 ? mainp + (size_t)n * DM : n < 832 ? sidep + (size_t)(n - 768) * DM : n < 3904 ? mainp + (size_t)(n - 64) * DM : sidep + (size_t)(64 + n - 3904) * DM; });
                continue; }
            r -= I_IN;
            if (r < I_UQ) {
                bf16_t* dst = (bf16_t*)(ws + WS_WUQ) + (size_t)l * 1536 * 512;
                transpose_item(A.in(11) + (size_t)l * 512 * 1536, 512, 1536, r, scr, lane, [=](int n) -> bf16_t* {
                    const int hh = n / 192, j = n - hh * 192; const int jn = j < 128 ? j : (j < 160 ? 128 + 2 * (j - 128) : 128 + 2 * (j - 160) + 1); return dst + (size_t)(hh * 192 + jn) * 512; });
                continue; }
            r -= I_UQ;
            if (r < I_UKV) { bf16_t* dst = (bf16_t*)(ws + WS_WUKV) + (size_t)l * 2048 * 256;
                transpose_item(A.in(12) + (size_t)l * 256 * 2048, 256, 2048, r, scr, lane, [=](int n) -> bf16_t* { return dst + (size_t)n * 256; }); continue; }
            r -= I_UKV;
            if (r < I_SQ) { bf16_t* dst = (bf16_t*)(ws + WS_WOUT) + (size_t)l * DM * DM;
                transpose_item(A.in(16) + (size_t)l * DM * DM, DM, DM, r, scr, lane, [=](int n) -> bf16_t* { return dst + (size_t)n * DM; }); continue; }
            r -= I_SQ;
            { bf16_t* dst = (bf16_t*)(ws + WS_WQRY) + (size_t)l * DM * DM;
                transpose_item(A.in(17) + (size_t)l * DM * DM, DM, DM, r, scr, lane, [=](int n) -> bf16_t* { return dst + (size_t)n * DM; }); }
        }
    }
    {
        const size_t gt = (size_t)bid * NTHR + tid, NT = (size_t)G * NTHR;
        {
            const int gw = bid * NWAVES + wave, NGW = G * NWAVES;
            for (int rr = gw; rr < 2 * DEPTH * NEXP; rr += NGW) { const bool isu = rr < DEPTH * NEXP; const int row = isu ? rr : rr - DEPTH * NEXP;
                const float* src = (isu ? A.in(19) : A.in(20)) + (size_t)row * DM;
                f32x4 x[8]; float ss = 0.f;
#pragma unroll
                for (int i = 0; i < 8; ++i) { x[i] = *(const f32x4*)(src + (lane + 64 * i) * 4); ss += (x[i].x * x[i].x + x[i].y * x[i].y) + (x[i].z * x[i].z + x[i].w * x[i].w); }
                ss = wave_sum(ss); const float rms = sqrtf(ss * (1.0f / DM));
                u32x4 p; float sc;
                if (isu) { sc = rms > 0.f ? rms * 0.5f : 1.0f; const float inv = 1.0f / sc;
#define Q4C(v) fminf(fmaxf((v) * inv, -6.0f), 6.0f)
                    LAS unsigned short* xs = (LAS unsigned short*)(L + wave * 16384);
#pragma unroll
                    for (int i = 0; i < 8; ++i) { unsigned d = 0u; d = __builtin_amdgcn_cvt_scalef32_pk_fp4_f32(d, Q4C(x[i].x), Q4C(x[i].y), 1.0f, 0); d = __builtin_amdgcn_cvt_scalef32_pk_fp4_f32(d, Q4C(x[i].z), Q4C(x[i].w), 1.0f, 1);
                        xs[lane + 64 * i] = (unsigned short)d; }
#undef Q4C
                    p = *(const LAS u32x4*)(L + wave * 16384 + lane * 16);
                } else { sc = rms > 0.f ? rms * 0.5f : 1.0f; const float inv = 1.0f / sc;
#pragma unroll
                    for (int w = 0; w < 4; ++w) { const f32x4 a = x[2 * w], c = x[2 * w + 1]; unsigned d = 0u;
#define Q4C(v) fminf(fmaxf((v) * inv, -6.0f), 6.0f)
                        d = __builtin_amdgcn_cvt_scalef32_pk_fp4_f32(d, Q4C(a.x), Q4C(a.y), 1.0f, 0); d = __builtin_amdgcn_cvt_scalef32_pk_fp4_f32(d, Q4C(a.z), Q4C(a.w), 1.0f, 1);
                        d = __builtin_amdgcn_cvt_scalef32_pk_fp4_f32(d, Q4C(c.x), Q4C(c.y), 1.0f, 2); d = __builtin_amdgcn_cvt_scalef32_pk_fp4_f32(d, Q4C(c.z), Q4C(c.w), 1.0f, 3);
#undef Q4C
                        p[w] = d; } }
                unsigned char* dst = ws + (isu ? WS_EU : WS_EV) + (size_t)row * EROW;
                *(u32x4*)(dst + lane * 16) = p;
                if (lane == 0) ((float*)(ws + (isu ? WS_SU : WS_SV)))[row] = sc; } }
        const size_t s8 = (size_t)DEPTH * 2 * 8 * 128 * 128 / 8;
        for (size_t i = gt; i < s8; i += NT) { const float* src = A.in(18) + i * 8;
            const f32x4 a = *(const f32x4*)src, b = *(const f32x4*)(src + 4); u32x4 o; o.x = cvt_pk(a.x, a.y); o.y = cvt_pk(a.z, a.w); o.z = cvt_pk(b.x, b.y); o.w = cvt_pk(b.z, b.w);
            *(u32x4*)((bf16_t*)(ws + WS_SUBK) + i * 8) = o; }
        float* cosT = (float*)(ws + WS_ROPE); float* sinT = cosT + SEQ * 32;
        for (size_t i = gt; i < (size_t)SEQ * 32; i += NT) { const int t = (int)(i >> 5), a = (int)(i & 31), m = a & 15; const int pos = a < 16 ? (t >> 6) : (t & 63);
            const float inv = 1.0f / powf(10000.0f, (float)(2 * m) / 32.0f); const float ang = (float)pos * inv; cosT[i] = cosf(ang); sinT[i] = sinf(ang); }
    }
}

__device__ __forceinline__ void p0b(const Ptrs& A, int wave, int bid, int G) { asm volatile("" : "+s"(wave)); const int lane = lane_id();
    unsigned char* ws = A.ws(); LAUNDER_G(ws); const int gw = bid + G * wave, NGW = G * NWAVES;
    const float* MOD = (const float*)(ws + WS_MOD);
    for (int r = gw; r < NTOK; r += NGW) {
        const int b = r / RPB, j = r - b * RPB; const float* src = j < CTX ? A.in(2) + ((size_t)b * CTX + j) * DM : A.in(0) + ((size_t)b * SEQ + (j - CTX)) * DM;
        float v[4][8]; row_load_f32(src, lane, v); row_store_f32((float*)(ws + WS_XRES) + (size_t)r * DM, lane, v);
        const float rstd = row_rstd(v); const float* mp = MOD + (size_t)(j < CTX ? 4 : b) * NMOD;
        norm_mod_store(v, rstd, A.in(6), mp, mp + DM, (bf16_t*)(ws + WS_H) + (size_t)r * DM, lane);
    }
}

__device__ __forceinline__ void side_gemm(const Ptrs& A, LAS unsigned char* L, int l, int wave, int bid, int G) { asm volatile("" : "+s"(wave)); const int lane = lane_id(); const int tid = wave * 64 + lane;
    unsigned char* ws = A.ws(); LAUNDER_G(ws); const bf16_t* H = (const bf16_t*)(ws + WS_H); const bf16_t* W = (const bf16_t*)(ws + WS_WSIDE) + (size_t)l * SIDEW * DM; float* SIDE = (float*)(ws + WS_SIDE);
    LAS float* red = (LAS float*)L;
    for (int u = bid; u < NTOK / 32; u += G) {
        const int rbase = u * 32;
        f32x4 acc[2][6];
#pragma unroll
        for (int rb = 0; rb < 2; ++rb)
#pragma unroll
            for (int cb = 0; cb < 6; ++cb) acc[rb][cb] = (f32x4){0.f, 0.f, 0.f, 0.f};
        const bf16_t* ap = H + (size_t)(rbase + (lane & 15)) * DM + wave * 256 + 8 * (lane >> 4);
        const bf16_t* bp = W + (size_t)(lane & 15) * DM + wave * 256 + 8 * (lane >> 4);
#pragma unroll
        for (int kh = 0; kh < 2; ++kh) {
            bf16x8 a[2][4], bq[6][4];
#pragma unroll
            for (int ks = 0; ks < 4; ++ks) {
#pragma unroll
                for (int rb = 0; rb < 2; ++rb) a[rb][ks] = *(const bf16x8*)(ap + (size_t)rb * 16 * DM + (kh * 4 + ks) * 32);
#pragma unroll
                for (int cb = 0; cb < 6; ++cb) bq[cb][ks] = *(const bf16x8*)(bp + (size_t)cb * 16 * DM + (kh * 4 + ks) * 32); }
#pragma unroll
            for (int ks = 0; ks < 4; ++ks)
#pragma unroll
                for (int rb = 0; rb < 2; ++rb)
#pragma unroll
                    for (int cb = 0; cb < 6; ++cb) acc[rb][cb] = __builtin_amdgcn_mfma_f32_16x16x32_bf16(a[rb][ks], bq[cb][ks], acc[rb][cb], 0, 0, 0);
        }
#pragma unroll
        for (int rb = 0; rb < 2; ++rb)
#pragma unroll
            for (int cb = 0; cb < 6; ++cb)
#pragma unroll
                for (int rg = 0; rg < 4; ++rg) red[(wave * 32 + rb * 16 + (lane >> 4) * 4 + rg) * 96 + cb * 16 + (lane & 15)] = acc[rb][cb][rg];
        __syncthreads();
        for (int i = tid; i < 32 * 96 / 4; i += NTHR) { f32x4 s = *(const LAS f32x4*)(red + i * 4);
#pragma unroll
            for (int w = 1; w < 8; ++w) s += *(const LAS f32x4*)(red + w * 32 * 96 + i * 4);
            *(f32x4*)(SIDE + (size_t)rbase * SIDEW + i * 4) = s; }
        __syncthreads();
    }
}

constexpr int CG_A = 0, CG_B = 16384, CG_BUF = 49152;
template <class F>
__device__ __forceinline__ void ctx_gemm(LAS unsigned char* L, const bf16_t* Ab, int lda, const bf16_t* Wt, int ldb, int N, int K, int wave, int bid, int G, const F& f) { asm volatile("" : "+s"(wave)); const int lane = lane_id(); const int tid = wave * 64 + lane;
    const int r32 = lane & 31, hi = lane >> 5, wr = wave >> 2, wc = wave & 3, ncu = N / 128, nch = K / 128;
    for (int u = bid; u < 16 * ncu; u += G) {
        const int mt = u / ncu, nt = u - mt * ncu; const int m0 = mt * 64, row0 = (m0 >> 8) * RPB + (m0 & 255), col0 = nt * 128;
        const int cch = tid & 15, ra = tid >> 4;
        const bf16_t* ga = Ab + (size_t)(row0 + ra) * lda + cch * 8; const bf16_t* gb = Wt + (size_t)(col0 + ra) * ldb + cch * 8;
        u32x4 sa[2], sb[4];
#define CG_LOAD(k0) do { sa[0] = *(const u32x4*)(ga + (k0)); sa[1] = *(const u32x4*)(ga + (size_t)32 * lda + (k0)); \
        _Pragma("unroll") for (int i = 0; i < 4; ++i) sb[i] = *(const u32x4*)(gb + (size_t)(32 * i) * ldb + (k0)); } while (0)
#define CG_WRITE(buf) do { _Pragma("unroll") for (int i = 0; i < 2; ++i) { const int row = ra + 32 * i; *(LAS u32x4*)(L + (buf) * CG_BUF + CG_A + row * 256 + ((cch ^ (row & 15)) << 4)) = sa[i]; } \
        _Pragma("unroll") for (int i = 0; i < 4; ++i) { const int row = ra + 32 * i; *(LAS u32x4*)(L + (buf) * CG_BUF + CG_B + row * 256 + ((cch ^ (row & 15)) << 4)) = sb[i]; } } while (0)
        f32x16 acc;
#pragma unroll
        for (int r = 0; r < 16; ++r) acc[r] = 0.f;
        CG_LOAD(0); CG_WRITE(0);
        __syncthreads();
#pragma unroll 1
        for (int ch = 0; ch < nch; ++ch) { const int buf = ch & 1;
            if (ch + 1 < nch) CG_LOAD((ch + 1) * 128);
#pragma unroll
            for (int ks = 0; ks < 8; ++ks) { const int cc = ks * 2 + hi;
                const bf16x8 a = *(const LAS bf16x8*)(L + buf * CG_BUF + CG_A + (32 * wr + r32) * 256 + ((cc ^ (r32 & 15)) << 4)), bq = *(const LAS bf16x8*)(L + buf * CG_BUF + CG_B + (32 * wc + r32) * 256 + ((cc ^ (r32 & 15)) << 4));
                acc = __builtin_amdgcn_mfma_f32_32x32x16_bf16(a, bq, acc, 0, 0, 0); }
            if (ch + 1 < nch) CG_WRITE(buf ^ 1);
            __syncthreads(); }
#undef CG_LOAD
#undef CG_WRITE
#pragma unroll
        for (int r = 0; r < 16; ++r) f(row0 + 32 * wr + crow(r, hi), col0 + 32 * wc + r32, acc[r]);
    }
}

__device__ __forceinline__ void thin_rows(const Ptrs& A, int l, int wave, int bid, int G) { asm volatile("" : "+s"(wave)); const int lane = lane_id();
    unsigned char* ws = A.ws(); LAUNDER_G(ws); const int nx5 = (NGU % G) * 2 < G ? NGU % G : 0;
    if (bid < nx5) return;
    const int gw = (bid - nx5) + (G - nx5) * wave, NGW = (G - nx5) * NWAVES;
    bf16_t* P = (bf16_t*)(ws + WS_P); const float* SIDE = (const float*)(ws + WS_SIDE); bf16_t* KR = (bf16_t*)(ws + WS_KR);
    const float* cosT = (const float*)(ws + WS_ROPE); const float* sinT = cosT + SEQ * 32;
    const float* gq = A.in(9) + l * 512; const float* gkv = A.in(10) + l * 256;
    for (int r = gw; r < NTOK; r += NGW) {
        bf16_t* pr = P + (size_t)r * PW;
        { const u32x4 w = *(const u32x4*)(pr + P_CQ + lane * 8); float x[8] = {bflo(w.x), bfhi(w.x), bflo(w.y), bfhi(w.y), bflo(w.z), bfhi(w.z), bflo(w.w), bfhi(w.w)};
          float ss = 0.f;
#pragma unroll
          for (int j = 0; j < 8; ++j) ss += x[j] * x[j];
          ss = wave_sum(ss); const float rstd = 1.0f / sqrtf(ss * (1.0f / 512.f) + EPS);
          const f32x4 g0 = *(const f32x4*)(gq + lane * 8), g1 = *(const f32x4*)(gq + lane * 8 + 4);
          u32x4 o; o.x = cvt_pk(x[0] * rstd * g0.x, x[1] * rstd * g0.y); o.y = cvt_pk(x[2] * rstd * g0.z, x[3] * rstd * g0.w); o.z = cvt_pk(x[4] * rstd * g1.x, x[5] * rstd * g1.y); o.w = cvt_pk(x[6] * rstd * g1.z, x[7] * rstd * g1.w);
          *(u32x4*)(pr + P_CQ + lane * 8) = o; }
        { const u32x2 w = *(const u32x2*)(pr + P_CKV + lane * 4); float x[4] = {bflo(w.x), bfhi(w.x), bflo(w.y), bfhi(w.y)};
          float ss = x[0] * x[0] + x[1] * x[1] + x[2] * x[2] + x[3] * x[3];
          ss = wave_sum(ss); const float rstd = 1.0f / sqrtf(ss * (1.0f / 256.f) + EPS);
          const f32x4 g0 = *(const f32x4*)(gkv + lane * 4);
          u32x2 o; o.x = cvt_pk(x[0] * rstd * g0.x, x[1] * rstd * g0.y); o.y = cvt_pk(x[2] * rstd * g0.z, x[3] * rstd * g0.w);
          *(u32x2*)(pr + P_CKV + lane * 4) = o; }
        if (lane < 32) { const float x1 = SIDE[(size_t)r * SIDEW + lane], x2 = SIDE[(size_t)r * SIDEW + 32 + lane];
          const int b = r / RPB, t = r - b * RPB - CTX; float y1 = x1, y2 = x2;
          if (t >= 0) { const float cs = cosT[(size_t)t * 32 + lane], sn = sinT[(size_t)t * 32 + lane]; y1 = x1 * cs - x2 * sn; y2 = x1 * sn + x2 * cs; }
          *(unsigned*)(KR + (size_t)r * 64 + 2 * lane) = cvt_pk(y1, y2); }
    }
}

constexpr int G1_LR = 0, G1_WG = 8192, G1_BG = 24576, G1_GT = 25600, G1_QD = 29696, G1_KD = G1_QD + 64 * 272, G1_KET = G1_KD + 64 * 272, G1_VT = G1_KET + 128 * 144, G1_AS = G1_VT + 256 * 144, G1_END = G1_AS + 64 * 144;
constexpr int G1_RAWV = G1_QD;
constexpr int G1_RAW = G1_END;
static_assert(G1_RAWV + 32768 <= G1_VT && G1_RAW + 32768 <= LDS_CTL_OFF, "G1 LDS map");

__device__ __forceinline__ void g1_mma(LAS unsigned char* L, f32x16& Aacc, const bf16x8 (&av)[4], bf16_t* dsp, int lane, int wave) {
    const int r32 = lane & 31, hi = lane >> 5;
    if (wave < 4) { const int mb = wave >> 1, nb = wave & 1;
#pragma unroll
        for (int r = 0; r < 16; ++r) Aacc[r] = 0.f;
#pragma unroll
        for (int ks = 0; ks < 8; ++ks) { const bf16x8 a = *(const LAS bf16x8*)(L + G1_QD + (32 * mb + r32) * 272 + ks * 32 + hi * 16), bq = *(const LAS bf16x8*)(L + G1_KD + (32 * nb + r32) * 272 + ks * 32 + hi * 16);
            Aacc = __builtin_amdgcn_mfma_f32_32x32x16_bf16(a, bq, Aacc, 0, 0, 0); } }
#pragma unroll
    for (int db = 0; db < 4; ++db) { f32x16 acc;
#pragma unroll
        for (int r = 0; r < 16; ++r) acc[r] = 0.f;
#pragma unroll
        for (int ks = 0; ks < 4; ++ks) { const bf16x8 bk = *(const LAS bf16x8*)(L + G1_KET + (32 * db + r32) * 144 + ks * 32 + hi * 16); acc = __builtin_amdgcn_mfma_f32_32x32x16_bf16(av[ks], bk, acc, 0, 0, 0); }
        LAS unsigned char* slab = L + G1_RAW + wave * 4096;
#pragma unroll
        for (int r = 0; r < 16; r += 2) {
            const float x0 = acc[r], x1 = acc[r + 1];
            const float n0 = __builtin_bit_cast(float, __builtin_amdgcn_mov_dpp(__builtin_bit_cast(int, x0), 0xB1, 0xF, 0xF, true)), n1 = __builtin_bit_cast(float, __builtin_amdgcn_mov_dpp(__builtin_bit_cast(int, x1), 0xB1, 0xF, 0xF, true));
            const bool odd = r32 & 1;
            const unsigned pk = odd ? cvt_pk_safe(n1, x1) : cvt_pk_safe(x0, n0);
            *(LAS unsigned*)(slab + crow(r + (odd ? 1 : 0), hi) * 128 + (db & 1) * 64 + (r32 >> 1) * 4) = pk; }
        if (db & 1) {
#pragma unroll
            for (int i = 0; i < 4; ++i) { const int idx = lane + 64 * i, row = idx >> 3, ch = idx & 7;
                *(u32x4*)(dsp + (size_t)(32 * wave + row) * 128 + (db >> 1) * 64 + ch * 8) = *(const LAS u32x4*)(slab + row * 128 + ch * 16); } } }
}

template <int DIR>
__device__ __forceinline__ void g1_dir(const Ptrs& A, unsigned char* ws, LAS unsigned char* L, int l, int u, int bh, int c, int h, int r0, f32x16& Aacc, const bf16x8 (&av)[4], const float (&qv)[16], const float (&kv)[16], int tid, int lane, int wave) {
    LAS float* lr = (LAS float*)(L + G1_LR); LAS float* wg = (LAS float*)(L + G1_WG); LAS float* bg = (LAS float*)(L + G1_BG); LAS float* gt = (LAS float*)(L + G1_GT);
    const int d = tid & 127, pg = tid >> 7;
    float cum[16];
    {
        float wv[16];
#pragma unroll
        for (int rr = 0; rr < 16; ++rr) wv[rr] = wg[(DIR * 16 + rr) * 128 + d];
        const float bias = bg[DIR * 128 + d];
#pragma unroll
        for (int i = 0; i < 16; ++i) { const LAS float* lp = lr + (DIR * 64 + pg * 16 + i) * 16; float z = bias;
#pragma unroll
            for (int rr = 0; rr < 16; ++rr) z += lp[rr] * wv[rr];
            cum[i] = -(fmaxf(-z, 0.f) + __logf(1.0f + __expf(-fabsf(z)))) * (1.0f / 16.0f); }
    }
    if (DIR == 0) {
#pragma unroll
        for (int i = 1; i < 16; ++i) cum[i] += cum[i - 1];
        gt[(DIR * 4 + pg) * 128 + d] = cum[15];
    } else {
#pragma unroll
        for (int i = 14; i >= 0; --i) cum[i] += cum[i + 1];
        gt[(DIR * 4 + pg) * 128 + d] = cum[0];
    }
    __syncthreads();
    float off = 0.f, last = 0.f;
#pragma unroll
    for (int g = 0; g < 4; ++g) { const float t = gt[(DIR * 4 + g) * 128 + d]; last += t; if (DIR == 0 ? (g < pg) : (g > pg)) off += t; }
    bf16_t* qdec = (bf16_t*)(ws + WS_QDEC) + ((size_t)u * 2 + DIR) * 8192;
    const float elast = __expf(last);
    unsigned ke[8];
#pragma unroll
    for (int i = 0; i < 16; i += 2) {
        const int p = pg * 16 + i;
        const float q0 = qv[i], q1 = qv[i + 1], k0 = kv[i], k1 = kv[i + 1];
        const float c0 = cum[i] + off, c1 = cum[i + 1] + off;
        const float e0 = __expf(c0), e1 = __expf(c1), n0 = __expf(-c0), n1 = __expf(-c1);
        const bf16_t qa = f2bf(q0 * e0), qb = f2bf(q1 * e1);
        *(LAS bf16_t*)(L + G1_QD + p * 272 + d * 2) = qa; *(LAS bf16_t*)(L + G1_QD + (p + 1) * 272 + d * 2) = qb;
        *(LAS bf16_t*)(L + G1_KD + p * 272 + d * 2) = f2bf(k0 * n0); *(LAS bf16_t*)(L + G1_KD + (p + 1) * 272 + d * 2) = f2bf(k1 * n1);
        ke[i >> 1] = cvt_pk(k0 * n0 * elast, k1 * n1 * elast);
    }
    *(LAS u32x4*)(L + G1_KET + d * 144 + pg * 32) = (u32x4){ke[0], ke[1], ke[2], ke[3]};
    *(LAS u32x4*)(L + G1_KET + d * 144 + pg * 32 + 16) = (u32x4){ke[4], ke[5], ke[6], ke[7]};
    if (pg == 0) ((float*)(ws + WS_DEC))[((size_t)(DIR * 16 + bh) * NCH + c) * 128 + d] = elast;
    __syncthreads();
#pragma unroll
    for (int i = 0; i < 2; ++i) { const int idx = tid + 512 * i, row = idx >> 4, ch = idx & 15;
        *(u32x4*)(qdec + row * 128 + ch * 8) = *(const LAS u32x4*)(L + G1_QD + row * 272 + ch * 16); }
    g1_mma(L, Aacc, av, (bf16_t*)(ws + WS_DS) + ((size_t)(DIR * 16 + bh) * NCH + c) * 32768, lane, wave);
}

__device__ __forceinline__ void gla_g1(const Ptrs& A, LAS unsigned char* L, int l, int u, int wave) { asm volatile("" : "+s"(wave)); const int lane = lane_id(); const int tid = wave * 64 + lane; (void)tid;
    unsigned char* ws = A.ws(); LAUNDER_G(ws);
    const int bh = u / NCH, c = u - bh * NCH, b = bh >> 2, h = bh & 3, r0 = b * RPB + c * 64;
    const bf16_t* P = (const bf16_t*)(ws + WS_P); const float* SIDE = (const float*)(ws + WS_SIDE);
    LAS float* lr = (LAS float*)(L + G1_LR); LAS float* wg = (LAS float*)(L + G1_WG); LAS float* bg = (LAS float*)(L + G1_BG);
    { const int p = tid >> 3, q = tid & 7, dir = q >> 2, rr4 = (q & 3) * 4;
      *(LAS f32x4*)(lr + (dir * 64 + p) * 16 + rr4) = *(const f32x4*)(SIDE + (size_t)(r0 + p) * SIDEW + 64 + dir * 16 + rr4); }
#pragma unroll
    for (int i = 0; i < 2; ++i) { const int idx = (tid * 2 + i) * 4, dir = idx >> 11, rr = (idx >> 7) & 15, d4 = idx & 127;
      *(LAS f32x4*)(wg + idx) = *(const f32x4*)(A.in(13) + ((size_t)(l * 2 + dir) * 16 + rr) * 512 + h * 128 + d4); }
    if (tid < 256) bg[tid] = A.in(14)[(l * 2 + (tid >> 7)) * 512 + h * 128 + (tid & 127)];
#pragma unroll
    for (int i = 0; i < 2; ++i) { const int idx = tid + 512 * i, row = idx >> 4, ch = idx & 15; const bf16_t* src = P + (size_t)(r0 + row) * PW + h * 128 + ch * 8;
        *(LAS u32x4*)(L + G1_RAW + row * 256 + ch * 16) = *(const u32x4*)(src + P_GQ); *(LAS u32x4*)(L + G1_RAW + 16384 + row * 256 + ch * 16) = *(const u32x4*)(src + P_GK); }
#pragma unroll
    for (int i = 0; i < 4; ++i) { const int idx = tid + 512 * i, row = idx >> 5, ch = idx & 31;
        *(LAS u32x4*)(L + G1_RAWV + row * 512 + ch * 16) = *(const u32x4*)(P + (size_t)(r0 + row) * PW + P_GV + h * 256 + ch * 8); }
    __syncthreads();
    float qv[16], kv[16];
#pragma unroll
    for (int i = 0; i < 16; ++i) { const int off = ((tid >> 7) * 16 + i) * 256 + (tid & 127) * 2; qv[i] = bf2f(*(const LAS bf16_t*)(L + G1_RAW + off)) * 0.08838834764831845f; kv[i] = bf2f(*(const LAS bf16_t*)(L + G1_RAW + 16384 + off)); }
    { const int e = tid & 255, ph = tid >> 8;
      unsigned w[16];
#pragma unroll
      for (int i = 0; i < 16; ++i) w[i] = (unsigned)*(const LAS bf16_t*)(L + G1_RAWV + (ph * 32 + 2 * i) * 512 + e * 2) | ((unsigned)*(const LAS bf16_t*)(L + G1_RAWV + (ph * 32 + 2 * i + 1) * 512 + e * 2) << 16);
#pragma unroll
      for (int i = 0; i < 4; ++i) *(LAS u32x4*)(L + G1_VT + e * 144 + ph * 64 + i * 16) = (u32x4){w[4 * i], w[4 * i + 1], w[4 * i + 2], w[4 * i + 3]}; }
    __syncthreads();
    const int r32 = lane & 31, hi = lane >> 5;
    bf16x8 av[4];
#pragma unroll
    for (int ks = 0; ks < 4; ++ks) av[ks] = *(const LAS bf16x8*)(L + G1_VT + (32 * wave + r32) * 144 + ks * 32 + hi * 16);
    f32x16 Af, Ab;
    g1_dir<0>(A, ws, L, l, u, bh, c, h, r0, Af, av, qv, kv, tid, lane, wave);
    __syncthreads();
    g1_dir<1>(A, ws, L, l, u, bh, c, h, r0, Ab, av, qv, kv, tid, lane, wave);
    if (wave < 4) { const int mb = wave >> 1, nb = wave & 1;
#pragma unroll
        for (int r = 0; r < 16; ++r) { const int cc = 32 * mb + crow(r, hi), jj = 32 * nb + r32; const float v = (jj <= cc ? Af[r] : 0.f) + (jj >= cc ? Ab[r] : 0.f);
            *(LAS bf16_t*)(L + G1_AS + cc * 144 + jj * 2) = f2bf(v); } }
    __syncthreads();
    float* OI = (float*)(ws + WS_OINTRA);
#pragma unroll
    for (int mb = 0; mb < 2; ++mb) { f32x16 acc;
#pragma unroll
        for (int r = 0; r < 16; ++r) acc[r] = 0.f;
#pragma unroll
        for (int ks = 0; ks < 4; ++ks) { const bf16x8 a = *(const LAS bf16x8*)(L + G1_AS + (32 * mb + r32) * 144 + ks * 32 + hi * 16); acc = __builtin_amdgcn_mfma_f32_32x32x16_bf16(a, av[ks], acc, 0, 0, 0); }
        float* op = OI + (size_t)(r0 + 32 * mb) * 1024 + h * 256 + 32 * wave + r32;
#pragma unroll
        for (int r = 0; r < 16; ++r) op[(size_t)crow(r, hi) * 1024] = acc[r]; }
    __syncthreads();
}

__device__ __forceinline__ void gla_g2(const Ptrs& A, int wave, int bid, int G) { const int tid = wave * 64 + lane_id();
    unsigned char* ws = A.ws(); LAUNDER_G(ws); const bf16_t* DS = (const bf16_t*)(ws + WS_DS); const float* DEC = (const float*)(ws + WS_DEC); bf16_t* SENT = (bf16_t*)(ws + WS_SENT);
    const int NT = G * NTHR;
    for (int it = bid * NTHR + tid; it < 2 * 16 * 256 * 16; it += NT) {
        const int d8 = it & 15, e = (it >> 4) & 255, db = it >> 12;
        const int dir = db >> 4;
        const size_t base = (size_t)db * NCH * 32768 + (size_t)e * 128 + d8 * 8, dbase = (size_t)db * NCH * 128 + d8 * 8;
        f32x4 s0 = (f32x4){0.f, 0.f, 0.f, 0.f}, s1 = (f32x4){0.f, 0.f, 0.f, 0.f};
#pragma unroll 4
        for (int st = 0; st < NCH; ++st) { const int c = dir == 0 ? st : (st < 4 ? 3 - st : NCH + 3 - st);
            const u32x4 dw = *(const u32x4*)(DS + base + (size_t)c * 32768); const f32x4 dc0 = *(const f32x4*)(DEC + dbase + (size_t)c * 128), dc1 = *(const f32x4*)(DEC + dbase + (size_t)c * 128 + 4);
            const unsigned w0 = dw.x, w1 = dw.y, w2 = dw.z, w3 = dw.w;
            const f32x4 ds0 = (f32x4){bflo(w0), bfhi(w0), bflo(w1), bfhi(w1)}, ds1 = (f32x4){bflo(w2), bfhi(w2), bflo(w3), bfhi(w3)};
            u32x4 o; o.x = cvt_pk(s0.x, s0.y); o.y = cvt_pk(s0.z, s0.w); o.z = cvt_pk(s1.x, s1.y); o.w = cvt_pk(s1.z, s1.w); *(u32x4*)(SENT + base + (size_t)c * 32768) = o;
            s0 = dc0 * s0 + ds0; s1 = dc1 * s1 + ds1; }
    }
}

constexpr int G3_A = 0, G3_OUT = 32768, G3_ROWB = 528, G3_GG = G3_OUT + 64 * G3_ROWB, G3_SSQ = G3_GG + 64 * G3_ROWB, G3_RSTD = G3_SSQ + 2048, G3_END = G3_RSTD + 256;
static_assert(G3_END <= LDS_CTL_OFF, "G3 LDS map");
__device__ __forceinline__ void gla_g3(const Ptrs& A, LAS unsigned char* L, int l, int u, int wave) { asm volatile("" : "+s"(wave)); const int lane = lane_id(); const int tid = wave * 64 + lane;
    unsigned char* ws = A.ws(); LAUNDER_G(ws);
    const int bh = u / NCH, c = u - bh * NCH, b = bh >> 2, h = bh & 3, r0 = b * RPB + c * 64, r32 = lane & 31, hi = lane >> 5;
    const bf16_t* qa = (const bf16_t*)(ws + WS_QDEC) + (size_t)u * 2 * 8192; const bf16_t* SENT = (const bf16_t*)(ws + WS_SENT);
    const bf16_t* P = (const bf16_t*)(ws + WS_P); bf16_t* MIX = (bf16_t*)(ws + WS_MIX);
#pragma unroll
    for (int i = 0; i < 4; ++i) { const int idx = tid + 512 * i, dir = idx >> 10, rem = idx & 1023, row = rem >> 4, cc = rem & 15;
        *(LAS u32x4*)(L + G3_A + dir * 16384 + row * 256 + ((cc ^ (row & 15)) << 4)) = *(const u32x4*)(qa + dir * 8192 + row * 128 + cc * 8);
        const int grow = idx >> 5, gch = idx & 31;
        *(LAS u32x4*)(L + G3_GG + grow * G3_ROWB + gch * 16) = *(const u32x4*)(P + (size_t)(r0 + grow) * PW + P_GG + h * 256 + gch * 8); }
    bf16x8 bb[16];
#pragma unroll
    for (int ks = 0; ks < 16; ++ks) { const int dir = ks >> 3, kk = (ks & 7) * 16 + 8 * hi;
        bb[ks] = *(const bf16x8*)(SENT + ((size_t)(dir * 16 + bh) * NCH + c) * 32768 + (size_t)(32 * wave + r32) * 128 + kk); }
    float v[32];
    { const float* oi = (const float*)(ws + WS_OINTRA) + (size_t)r0 * 1024 + h * 256 + 32 * wave + r32;
#pragma unroll
      for (int r = 0; r < 16; ++r) { v[r] = oi[(size_t)crow(r, hi) * 1024]; v[16 + r] = oi[(size_t)(32 + crow(r, hi)) * 1024]; } }
    __syncthreads();
    f32x16 acc0, acc1;
#pragma unroll
    for (int r = 0; r < 16; ++r) { acc0[r] = 0.f; acc1[r] = 0.f; }
#pragma unroll
    for (int ks = 0; ks < 16; ++ks) { const int dir = ks >> 3, cc = (ks & 7) * 2 + hi;
        const bf16x8 a0 = *(const LAS bf16x8*)(L + G3_A + dir * 16384 + r32 * 256 + ((cc ^ (r32 & 15)) << 4)), a1 = *(const LAS bf16x8*)(L + G3_A + dir * 16384 + (32 + r32) * 256 + ((cc ^ (r32 & 15)) << 4));
        acc0 = __builtin_amdgcn_mfma_f32_32x32x16_bf16(a0, bb[ks], acc0, 0, 0, 0); acc1 = __builtin_amdgcn_mfma_f32_32x32x16_bf16(a1, bb[ks], acc1, 0, 0, 0); }
#pragma unroll
    for (int r = 0; r < 16; ++r) { v[r] += acc0[r]; v[16 + r] += acc1[r]; }
    {
        float t[32];
#pragma unroll
        for (int q = 0; q < 32; ++q) t[q] = v[q] * v[q];
#pragma unroll
        for (int s_ = 0; s_ < 5; ++s_) { const int half = 16 >> s_; const bool bit = (r32 >> s_) & 1;
#pragma unroll
            for (int i = 0; i < half; ++i) { const float send = bit ? t[i] : t[i + half], keep = bit ? t[i + half] : t[i]; t[i] = keep + shx_f(send, 1 << s_); } }
        const int q = ((r32 & 1) << 4) | ((r32 & 2) << 2) | (r32 & 4) | ((r32 & 8) >> 2) | ((r32 & 16) >> 4);
        const int row = 32 * (q >> 4) + crow(q & 15, hi);
        ((LAS float*)(L + G3_SSQ))[row * 8 + wave] = t[0];
    }
    __syncthreads();
    if (tid < 64) { const f32x4 sa = *(const LAS f32x4*)(L + G3_SSQ + tid * 32), sb = *(const LAS f32x4*)(L + G3_SSQ + tid * 32 + 16);
        ((LAS float*)(L + G3_RSTD))[tid] = 1.0f / sqrtf(((sa.x + sa.y) + (sa.z + sa.w) + (sb.x + sb.y) + (sb.z + sb.w)) * (1.0f / 256.f) + EPS); }
    __syncthreads();
    const float g = A.in(15)[l * 256 + 32 * wave + r32];
#pragma unroll
    for (int q = 0; q < 32; ++q) { const int row = 32 * (q >> 4) + crow(q & 15, hi);
        const float rstd = ((const LAS float*)(L + G3_RSTD))[row];
        const float gg = bf2f(*(const LAS bf16_t*)(L + G3_GG + row * G3_ROWB + (32 * wave + r32) * 2));
        *(LAS bf16_t*)(L + G3_OUT + row * G3_ROWB + (32 * wave + r32) * 2) = f2bf((v[q] * rstd * g) * (gg / (1.f + __expf(-gg)))); }
    __syncthreads();
#pragma unroll
    for (int i = 0; i < 4; ++i) { const int idx = tid + 512 * i, row = idx >> 5, ch = idx & 31;
        *(u32x4*)(MIX + (size_t)(r0 + row) * DM + 1024 + h * 256 + ch * 8) = *(const LAS u32x4*)(L + G3_OUT + row * G3_ROWB + ch * 16); }
    __syncthreads();
}

#ifndef QR_REG
#define QR_REG 1
#endif
namespace att {
constexpr int NW = 8, QBLK = 32, KVBLK = 64;
constexpr float SCALE = 0.07216878364870323f;
constexpr float THR = 8.f;
constexpr int LDQ = 1536, LDKV = 2048, LDKR = 64, LDO = 2048;
constexpr int SHM_V = 16384, SHM_K = 16384, SHM_R = 8192;
constexpr int OFF_V = 0, OFF_K = 2 * SHM_V, OFF_R = OFF_K + 2 * SHM_K, OFF_WS = OFF_R + 2 * SHM_R, OFF_QR = OFF_WS + NW * 64 * 4, LDS_NEED = OFF_QR + NW * 8704;
static_assert(LDS_NEED <= LDS_CTL_OFF, "attention LDS map");
#define KSWZ(row, colB) ((row) * 256 + ((colB) ^ (((row) & 15) << 4)))
#define RSWZ(row, colB) ((row) * 128 + ((colB) ^ ((((row) >> 1) & 7) << 4)))

__device__ __forceinline__ void partialSM(f32x16& p0, f32x16& p1, float& m_reg, float& mn, float& alpha) {
  constexpr float C = SCALE * 1.4426950408889634f;
  float pmax = p0[0];
#pragma unroll
  for (int r = 1; r < 16; ++r) pmax = fmaxf(pmax, p0[r]);
#pragma unroll
  for (int r = 0; r < 16; ++r) pmax = fmaxf(pmax, p1[r]);
  { auto rr = __builtin_amdgcn_permlane32_swap(__float_as_uint(pmax), __float_as_uint(pmax), false, false);
    pmax = fmaxf(__uint_as_float(rr[0]), __uint_as_float(rr[1])); }
  if (__builtin_expect(__all(pmax - m_reg <= THR / SCALE), 1)) { mn = m_reg; alpha = 1.f; }
  else { mn = fmaxf(m_reg, pmax); alpha = __builtin_amdgcn_exp2f((m_reg - mn) * C); m_reg = mn; }
  const float mnC = -mn * C;
#pragma unroll
  for (int r = 0; r < 16; ++r) p0[r] = fmaf(p0[r], C, mnC);
#pragma unroll
  for (int r = 0; r < 16; ++r) p1[r] = fmaf(p1[r], C, mnC);
#pragma unroll
  for (int r = 0; r < 16; ++r) p0[r] = __builtin_amdgcn_exp2f(p0[r]);
}
__device__ __forceinline__ void finishSM(f32x16& p0, f32x16& p1, float alpha, float& l_reg, bf16x8& pa0, bf16x8& pa1, bf16x8& pa2, bf16x8& pa3) {
#pragma unroll
  for (int r = 0; r < 16; ++r) p1[r] = __builtin_amdgcn_exp2f(p1[r]);
  float ps = 0;
#pragma unroll
  for (int r = 0; r < 16; ++r) ps += p0[r];
#pragma unroll
  for (int r = 0; r < 16; ++r) ps += p1[r];
  { auto rr = __builtin_amdgcn_permlane32_swap(__float_as_uint(ps), __float_as_uint(ps), false, false);
    ps = __uint_as_float(rr[0]) + __uint_as_float(rr[1]); }
  l_reg = l_reg * alpha + ps;
#define PK4(P, BASE, OUT) do { unsigned a0 = cvt_pk_asm(P[BASE + 0], P[BASE + 1]), a1 = cvt_pk_asm(P[BASE + 2], P[BASE + 3]);   \
    unsigned b0 = cvt_pk_asm(P[BASE + 4], P[BASE + 5]), b1 = cvt_pk_asm(P[BASE + 6], P[BASE + 7]);                              \
    auto r0 = __builtin_amdgcn_permlane32_swap(a0, b0, false, false); auto r1 = __builtin_amdgcn_permlane32_swap(a1, b1, false, false); \
    u32x4 w = {r0[0], r1[0], r0[1], r1[1]}; OUT = __builtin_bit_cast(bf16x8, w); } while (0)
  PK4(p0, 0, pa0); PK4(p0, 8, pa1); PK4(p1, 0, pa2); PK4(p1, 8, pa3);
#undef PK4
}
__device__ __forceinline__ void qkt(f32x16& p0, f32x16& p1, const LAS unsigned char* Ks, const LAS unsigned char* Rs, const bf16x8 (&qr)[8], const bf16x8 (&qrr)[4], const LAS unsigned char* QRl, int r32, int hi) {
#pragma unroll
  for (int r = 0; r < 16; ++r) { p0[r] = 0.f; p1[r] = 0.f; }
#pragma unroll
  for (int d0 = 0; d0 < 8; ++d0) { const int cb = d0 * 32 + hi * 16;
    const bf16x8 b0 = *(const LAS bf16x8*)(Ks + KSWZ(r32, cb)), b1 = *(const LAS bf16x8*)(Ks + KSWZ(32 + r32, cb));
    p0 = __builtin_amdgcn_mfma_f32_32x32x16_bf16(b0, qr[d0], p0, 0, 0, 0);
    p1 = __builtin_amdgcn_mfma_f32_32x32x16_bf16(b1, qr[d0], p1, 0, 0, 0); }
#pragma unroll
  for (int d0 = 0; d0 < 4; ++d0) { const int cb = d0 * 32 + hi * 16;
    const bf16x8 b0 = *(const LAS bf16x8*)(Rs + RSWZ(r32, cb)), b1 = *(const LAS bf16x8*)(Rs + RSWZ(32 + r32, cb));
#if QR_REG
    const bf16x8 qq = qrr[d0];
#else
    const bf16x8 qq = *(const LAS bf16x8*)(QRl + d0 * 1024);
#endif
    p0 = __builtin_amdgcn_mfma_f32_32x32x16_bf16(b0, qq, p0, 0, 0, 0);
    p1 = __builtin_amdgcn_mfma_f32_32x32x16_bf16(b1, qq, p1, 0, 0, 0); }
}
__device__ __forceinline__ int v_st(int k, int c) { const int kk = (k & ~0xC) | ((k & 4) << 1) | ((k & 8) >> 1); return ((kk >> 3) * 4 + (c >> 5)) * 512 + ((kk & 7) * 32 + (c & 31)) * 2; }
__device__ __forceinline__ int v_rd_base(int lane) { return ((lane & 3) << 3) | (((lane >> 2) & 3) << 6) | (((lane >> 4) & 1) << 5) | (((lane >> 5) & 1) << 8); }
constexpr int v_rd_off(int d0, int ks, int half) { return d0 * 512 + ks * 4096 + half * 2048; }
template <int OFF> __device__ __forceinline__ s16x4 tr_read(int vb) {
  s16x4 r; asm volatile("ds_read_b64_tr_b16 %0, %1 offset:%2" : "=&v"(r) : "v"(vb), "i"(OFF) : "memory"); return r;
}
template <int D0> __device__ __forceinline__ void pv_one(f32x16& od, int vb, bf16x8 pa0, bf16x8 pa1, bf16x8 pa2, bf16x8 pa3) {
  const s16x4 l0 = tr_read<v_rd_off(D0, 0, 0)>(vb), h0 = tr_read<v_rd_off(D0, 0, 1)>(vb), l1 = tr_read<v_rd_off(D0, 1, 0)>(vb), h1 = tr_read<v_rd_off(D0, 1, 1)>(vb);
  const s16x4 l2 = tr_read<v_rd_off(D0, 2, 0)>(vb), h2 = tr_read<v_rd_off(D0, 2, 1)>(vb), l3 = tr_read<v_rd_off(D0, 3, 0)>(vb), h3 = tr_read<v_rd_off(D0, 3, 1)>(vb);
  asm volatile("s_waitcnt lgkmcnt(0)" ::: "memory"); SBAR();
#define PKV(L_, H_) (bf16x8){L_[0], L_[1], L_[2], L_[3], H_[0], H_[1], H_[2], H_[3]}
  od = __builtin_amdgcn_mfma_f32_32x32x16_bf16(pa0, PKV(l0, h0), od, 0, 0, 0);
  od = __builtin_amdgcn_mfma_f32_32x32x16_bf16(pa1, PKV(l1, h1), od, 0, 0, 0);
  od = __builtin_amdgcn_mfma_f32_32x32x16_bf16(pa2, PKV(l2, h2), od, 0, 0, 0);
  od = __builtin_amdgcn_mfma_f32_32x32x16_bf16(pa3, PKV(l3, h3), od, 0, 0, 0);
#undef PKV
}
__device__ __forceinline__ void pv_d0(f32x16 (&o)[4], int vb, bf16x8 pa0, bf16x8 pa1, bf16x8 pa2, bf16x8 pa3) {
  pv_one<0>(o[0], vb, pa0, pa1, pa2, pa3); pv_one<1>(o[1], vb, pa0, pa1, pa2, pa3); pv_one<2>(o[2], vb, pa0, pa1, pa2, pa3); pv_one<3>(o[3], vb, pa0, pa1, pa2, pa3);
}

__device__ __forceinline__ void attn_unit(const bf16_t* __restrict__ Qb, const bf16_t* __restrict__ Kn, const bf16_t* __restrict__ Kr, const bf16_t* __restrict__ Vh,
                                          bf16_t* __restrict__ Ob, int nkeys, LAS unsigned char* lds, int wid) {
  asm volatile("" : "+s"(wid));
  const int lane = lane_id(), tid = wid * 64 + lane, r32 = lane & 31, hi = lane >> 5;
  LAS unsigned char* V_lds = lds + OFF_V; LAS unsigned char* K_lds = lds + OFF_K; LAS unsigned char* R_lds = lds + OFF_R;
  LAS float* wsf = (LAS float*)(lds + OFF_WS) + wid * 64; LAS float* li_l = wsf; LAS float* al_l = wsf + 32;
  float m_reg = -1e30f, l_reg = 0.f; f32x16 o[4]; bf16x8 qr[8];
  LAS unsigned char* QRl = lds + OFF_QR + wid * 4096 + lane * 16;
#pragma unroll
  for (int d = 0; d < 4; ++d)
#pragma unroll
    for (int r = 0; r < 16; ++r) o[d][r] = 0.f;
  const bf16_t* Qw = Qb + (size_t)(wid * QBLK + r32) * LDQ + hi * 8;
#pragma unroll
  for (int d0 = 0; d0 < 8; ++d0) qr[d0] = *(const bf16x8*)(Qw + d0 * 16);
  bf16x8 qrr[4];
#pragma unroll
  for (int d0 = 0; d0 < 4; ++d0) { qrr[d0] = *(const bf16x8*)(Qw + (8 + d0) * 16);
#if !QR_REG
    *(LAS bf16x8*)(QRl + d0 * 1024) = qrr[d0];
#endif
  }
  const int sr = tid >> 4, sc = (tid & 15) * 8, vst0 = v_st(sr, sc), vst1 = v_st(32 + sr, sc);
  const int rr_ = tid >> 3, rc_ = (tid & 7) * 8;
  const int vb0 = (int)(unsigned)(uintptr_t)V_lds + v_rd_base(lane);
  bf16x8 vs0, vs1, ks0, ks1, rs0;
#define SLOAD(k0) do { vs0 = *(const bf16x8*)(Vh + (size_t)((k0) + sr) * LDKV + sc); vs1 = *(const bf16x8*)(Vh + (size_t)((k0) + 32 + sr) * LDKV + sc); \
    ks0 = *(const bf16x8*)(Kn + (size_t)((k0) + sr) * LDKV + sc); ks1 = *(const bf16x8*)(Kn + (size_t)((k0) + 32 + sr) * LDKV + sc); \
    rs0 = *(const bf16x8*)(Kr + (size_t)((k0) + rr_) * LDKR + rc_); } while (0)
#define SWRITE(b) do { *(LAS bf16x8*)(V_lds + (b) * SHM_V + vst0) = vs0; *(LAS bf16x8*)(V_lds + (b) * SHM_V + vst1) = vs1; const int kc = sc * 2; \
    *(LAS bf16x8*)(K_lds + (b) * SHM_K + KSWZ(sr, kc)) = ks0; *(LAS bf16x8*)(K_lds + (b) * SHM_K + KSWZ(32 + sr, kc)) = ks1; \
    *(LAS bf16x8*)(R_lds + (b) * SHM_R + RSWZ(rr_, rc_ * 2)) = rs0; } while (0)
#define SWAIT() asm volatile("s_waitcnt vmcnt(0)" ::: "memory")
#define RESC(a) do { if (__any((a) < 1.f)) { if (hi == 0) al_l[r32] = (a); asm volatile("s_waitcnt lgkmcnt(0)" ::: "memory"); \
    _Pragma("unroll") for (int d = 0; d < 4; ++d) _Pragma("unroll") for (int r = 0; r < 16; ++r) o[d][r] *= al_l[crow(r, hi)]; } } while (0)
  f32x16 pA0, pA1, pB0, pB1; float mnA, mnB, alA, alB; bf16x8 pa0, pa1, pa2, pa3; const int NT = nkeys / KVBLK;
  SLOAD(0); SWAIT(); SWRITE(0); __syncthreads();
  qkt(pA0, pA1, K_lds, R_lds, qr, qrr, QRl, r32, hi); partialSM(pA0, pA1, m_reg, mnA, alA);
  SLOAD(KVBLK);
  SWAIT(); SWRITE(1); __syncthreads();
  for (int j = 1; j + 1 < NT; j += 2) {
    SBAR(); qkt(pB0, pB1, K_lds + SHM_K, R_lds + SHM_R, qr, qrr, QRl, r32, hi);
    finishSM(pA0, pA1, alA, l_reg, pa0, pa1, pa2, pa3); SBAR();
    SLOAD((j + 1) * KVBLK); SBAR();
    pv_d0(o, vb0, pa0, pa1, pa2, pa3); partialSM(pB0, pB1, m_reg, mnB, alB);
    __syncthreads(); SWAIT(); SWRITE(0);
    RESC(alB); __syncthreads();
    SBAR(); qkt(pA0, pA1, K_lds, R_lds, qr, qrr, QRl, r32, hi);
    finishSM(pB0, pB1, alB, l_reg, pa0, pa1, pa2, pa3); SBAR();
    SLOAD((j + 2) * KVBLK); SBAR();
    pv_d0(o, vb0 + SHM_V, pa0, pa1, pa2, pa3); partialSM(pA0, pA1, m_reg, mnA, alA);
    __syncthreads(); SWAIT(); SWRITE(1);
    RESC(alA); __syncthreads();
  }
  SBAR(); qkt(pB0, pB1, K_lds + SHM_K, R_lds + SHM_R, qr, qrr, QRl, r32, hi);
  finishSM(pA0, pA1, alA, l_reg, pa0, pa1, pa2, pa3); SBAR();
  pv_d0(o, vb0, pa0, pa1, pa2, pa3); partialSM(pB0, pB1, m_reg, mnB, alB);
  __syncthreads(); RESC(alB);
  finishSM(pB0, pB1, alB, l_reg, pa0, pa1, pa2, pa3); SBAR();
  pv_d0(o, vb0 + SHM_V, pa0, pa1, pa2, pa3);
  if (hi == 0) li_l[r32] = l_reg; asm volatile("s_waitcnt lgkmcnt(0)" ::: "memory");
  float rli[16];
#pragma unroll
  for (int r = 0; r < 16; ++r) rli[r] = __builtin_amdgcn_rcpf(li_l[crow(r, hi)]);
  bf16_t* Ow = Ob + (size_t)(wid * QBLK) * LDO;
#if QR_REG
  { LAS unsigned char* slab = lds + OFF_QR + wid * 8704;
#pragma unroll
    for (int r = 0; r < 16; ++r) { const int orow = crow(r, hi);
#pragma unroll
      for (int d0 = 0; d0 < 4; ++d0) *(LAS bf16_t*)(slab + orow * 272 + (d0 * 32 + r32) * 2) = f2bf(o[d0][r] * rli[r]); }
#pragma unroll
    for (int i = 0; i < 8; ++i) { const int idx = lane + 64 * i, row = idx >> 4, ch = idx & 15;
      *(u32x4*)(Ow + (size_t)row * LDO + ch * 8) = *(const LAS u32x4*)(slab + row * 272 + ch * 16); } }
#else
#pragma unroll
  for (int r = 0; r < 16; ++r) { const int orow = crow(r, hi);
#pragma unroll
    for (int d0 = 0; d0 < 4; ++d0) Ow[(size_t)orow * LDO + d0 * 32 + r32] = f2bf(o[d0][r] * rli[r]); }
#endif
  __syncthreads();
#undef SLOAD
#undef SWRITE
#undef SWAIT
#undef RESC
}
}

constexpr int TK_S = 0, TK_SSTR = 260, TK_SBYTES = 64 * TK_SSTR * 4, TK_TV = 2 * TK_SBYTES, TK_TI = TK_TV + 64 * 2 * 16 * 4, TK_TAB = TK_TI + 64 * 2 * 16 * 4, TK_END = TK_TAB + 64 * 4;
static_assert(TK_END <= LDS_CTL_OFF, "topk LDS map");
constexpr int TK_COFF[17] = {0, 16, 24, 29, 33, 36, 38, 40, 42, 43, 44, 45, 46, 47, 48, 49, 50};
__device__ __forceinline__ unsigned f2mono(float f) { const unsigned u = __float_as_uint(f); return (u & 0x80000000u) ? ~u : (u | 0x80000000u); }
template <int N> __device__ __forceinline__ void bitonic_merge_desc(unsigned (&a)[N]) {
#pragma unroll
    for (int d = N >> 1; d > 0; d >>= 1)
#pragma unroll
        for (int i = 0; i < N; ++i) { const int p = i ^ d; if (p > i) { const unsigned lo = a[i] < a[p] ? a[i] : a[p], hi = a[i] < a[p] ? a[p] : a[i]; a[i] = hi; a[p] = lo; } }
}
template <int N> __device__ __forceinline__ void bitonic_sort_desc(unsigned (&a)[N]) {
#pragma unroll
    for (int k = 2; k <= N; k <<= 1)
#pragma unroll
        for (int d = k >> 1; d > 0; d >>= 1)
#pragma unroll
            for (int i = 0; i < N; ++i) { const int p = i ^ d; if (p > i) { const bool desc = ((i & k) == 0) || (k == N); const unsigned lo = a[i] < a[p] ? a[i] : a[p], hi = a[i] < a[p] ? a[p] : a[i]; a[i] = desc ? hi : lo; a[p] = desc ? lo : hi; } }
}
__device__ __forceinline__ void tk_scores(unsigned char* ws, LAS float* S, int l, int u, int half, int kb0, int nkb, int lane) {
    const int tile = u >> 3, h = u & 7, r0 = tile * 64, r32 = lane & 31, hi = lane >> 5;
    const bf16_t* qp = (const bf16_t*)(ws + WS_QP) + (size_t)(r0 + r32) * DM + h * 256 + half * 128 + 8 * hi;
    bf16x8 q0[8], q1[8];
#pragma unroll
    for (int ks = 0; ks < 8; ++ks) { q0[ks] = *(const bf16x8*)(qp + ks * 16); q1[ks] = *(const bf16x8*)(qp + (size_t)32 * DM + ks * 16); }
    for (int kb = kb0; kb < kb0 + nkb; ++kb) {
        const bf16_t* kp = (const bf16_t*)(ws + WS_SUBK) + ((size_t)((l * 2 + half) * 8 + h) * 128 + kb * 32 + r32) * 128 + 8 * hi;
        f32x16 a0, a1;
#pragma unroll
        for (int r = 0; r < 16; ++r) { a0[r] = 0.f; a1[r] = 0.f; }
#pragma unroll
        for (int ks = 0; ks < 8; ++ks) { const bf16x8 kk = *(const bf16x8*)(kp + ks * 16);
            a0 = __builtin_amdgcn_mfma_f32_32x32x16_bf16(q0[ks], kk, a0, 0, 0, 0); a1 = __builtin_amdgcn_mfma_f32_32x32x16_bf16(q1[ks], kk, a1, 0, 0, 0); }
#pragma unroll
        for (int r = 0; r < 16; ++r) { S[crow(r, hi) * TK_SSTR + half * 128 + kb * 32 + r32] = a0[r]; S[(32 + crow(r, hi)) * TK_SSTR + half * 128 + kb * 32 + r32] = a1[r]; }
    }
}
__device__ __forceinline__ void peer_topk_phase(const Ptrs& A, LAS unsigned char* L, int l, int wave, int bid, int G) { asm volatile("" : "+s"(wave));
    unsigned char* ws = A.ws(); LAUNDER_G(ws);
    const int NU = (NTOK / 64) * 8;
    LAS float* TV = (LAS float*)(L + TK_TV); LAS int* TI = (LAS int*)(L + TK_TI); LAS int* TAB = (LAS int*)(L + TK_TAB);
    { const int lane = lane_id(); const int tid = wave * 64 + lane;
      if (bid < NU) tk_scores(ws, (LAS float*)(L + TK_S), l, bid, wave >> 2, wave & 3, 1, lane);
      if (tid < 50) { int row = 0;
#pragma unroll
          for (int i = 1; i < 16; ++i) row = tid >= TK_COFF[i] ? i : row;
          int base = 0;
#pragma unroll
          for (int i = 1; i < 16; ++i) base = row == i ? TK_COFF[i] : base;
          TAB[tid] = row * 16 + (tid - base); } }
    __syncthreads();
    int n = 0;
    for (int u = bid; u < NU; u += G, ++n) {
        const int lane = lane_id(); const int tid = wave * 64 + lane;
        const int tile = u >> 3, h = u & 7, r0 = tile * 64;
        LAS float* S = (LAS float*)(L + TK_S + (n & 1) * TK_SBYTES);
    {
        const int item = tid >> 2, q = tid & 3, tok = item & 63, half = item >> 6;
        unsigned k0[16], k1[16];
#pragma unroll
        for (int j = 0; j < 4; ++j) { const f32x4 x = *(const LAS f32x4*)(S + tok * TK_SSTR + half * 128 + q * 32 + j * 4), y = *(const LAS f32x4*)(S + tok * TK_SSTR + half * 128 + q * 32 + 16 + j * 4);
            const int ib = 127 - (q * 32 + 4 * j);
            k0[4 * j] = (f2mono(x.x) & ~127u) | (unsigned)ib; k0[4 * j + 1] = (f2mono(x.y) & ~127u) | (unsigned)(ib - 1); k0[4 * j + 2] = (f2mono(x.z) & ~127u) | (unsigned)(ib - 2); k0[4 * j + 3] = (f2mono(x.w) & ~127u) | (unsigned)(ib - 3);
            k1[4 * j] = (f2mono(y.x) & ~127u) | (unsigned)(ib - 16); k1[4 * j + 1] = (f2mono(y.y) & ~127u) | (unsigned)(ib - 17); k1[4 * j + 2] = (f2mono(y.z) & ~127u) | (unsigned)(ib - 18); k1[4 * j + 3] = (f2mono(y.w) & ~127u) | (unsigned)(ib - 19); }
        bitonic_sort_desc<16>(k0); bitonic_sort_desc<16>(k1);
#pragma unroll
        for (int i = 0; i < 16; ++i) k0[i] = k0[i] > k1[15 - i] ? k0[i] : k1[15 - i];
        bitonic_merge_desc<16>(k0);
#pragma unroll
        for (int o = 1; o < 4; o <<= 1) {
#pragma unroll
            for (int i = 0; i < 16; ++i) k1[i] = (unsigned)shx_i((int)k0[i], o);
#pragma unroll
            for (int i = 0; i < 16; ++i) k0[i] = k0[i] > k1[15 - i] ? k0[i] : k1[15 - i];
            bitonic_merge_desc<16>(k0); }
#pragma unroll
        for (int i = 0; i < 16; ++i) if ((i >> 2) == q) { const int idx = 127 - (int)(k0[i] & 127u); TI[(tok * 2 + half) * 16 + i] = idx; TV[(tok * 2 + half) * 16 + i] = S[tok * TK_SSTR + half * 128 + idx]; }
    }
    __syncthreads();
        if (wave >= 4) { if (u + G < NU) tk_scores(ws, (LAS float*)(L + TK_S + ((n + 1) & 1) * TK_SBYTES), l, u + G, (wave - 4) >> 1, ((wave - 4) & 1) * 2, 2, lane); }
        else
    {
        const int tok = tid >> 2, q = tid & 3;
        unsigned ck[13];
#pragma unroll
        for (int sl = 0; sl < 13; ++sl) { const int n = 4 * sl + q; unsigned key = 0u;
            if (n < 50) { const int code = TAB[n]; const float sum = TV[(tok * 2) * 16 + (code >> 4)] + TV[(tok * 2 + 1) * 16 + (code & 15)]; key = (f2mono(sum) & ~63u) | (unsigned)(63 - n); }
            ck[sl] = key; }
        unsigned win[4] = {0u, 0u, 0u, 0u};
#pragma unroll
        for (int pass = 0; pass < 16; ++pass) {
            unsigned best = ck[0];
#pragma unroll
            for (int sl = 1; sl < 13; ++sl) best = ck[sl] > best ? ck[sl] : best;
#pragma unroll
            for (int o = 1; o < 4; o <<= 1) { const unsigned ob = (unsigned)shx_i((int)best, o); best = ob > best ? ob : best; }
#pragma unroll
            for (int sl = 0; sl < 13; ++sl) ck[sl] = ck[sl] == best ? 0u : ck[sl];
            if ((pass >> 2) == q) win[pass & 3] = best;
        }
        float sm[4]; int ex_idx[4];
#pragma unroll
        for (int w = 0; w < 4; ++w) { const int n = 63 - (int)(win[w] & 63u); const int code = TAB[n]; const int i = code >> 4, j = code & 15;
            sm[w] = TV[(tok * 2) * 16 + i] + TV[(tok * 2 + 1) * 16 + j]; ex_idx[w] = TI[(tok * 2) * 16 + i] * 128 + TI[(tok * 2 + 1) * 16 + j]; }
        const float mx = DPP_F(sm[0], 0x00);
        float ex[4], den = 0.f;
#pragma unroll
        for (int w = 0; w < 4; ++w) { ex[w] = __expf(sm[w] - mx); den += ex[w]; }
        den += shx_f(den, 1); den += shx_f(den, 2);
        const float inv = 1.0f / den;
        int* IDX = (int*)(ws + WS_IDX) + (size_t)(r0 + tok) * 128 + h * 16 + 4 * q; float* GATE = (float*)(ws + WS_GATE) + (size_t)(r0 + tok) * 128 + h * 16 + 4 * q;
        *(u32x4*)IDX = (u32x4){(unsigned)ex_idx[0], (unsigned)ex_idx[1], (unsigned)ex_idx[2], (unsigned)ex_idx[3]};
        *(f32x4*)GATE = (f32x4){ex[0] * inv, ex[1] * inv, ex[2] * inv, ex[3] * inv};
    }
    __syncthreads();
    }
}

__device__ __forceinline__ float gelu_tanh(float x) { const float y = 0.7978845608028654f * (x + 0.044715f * x * x * x); const float t = 1.f - 2.f * __builtin_amdgcn_rcpf(__expf(2.f * y) + 1.f); return 0.5f * x * (1.f + t); }
#ifndef PEER_NEB
#define PEER_NEB 4
#endif
#ifndef PEER_NEC
#define PEER_NEC 4
#endif
typedef int i32x4 __attribute__((ext_vector_type(4)));
typedef int i32x8 __attribute__((ext_vector_type(8)));
constexpr int PEER_H4 = 0;
static_assert(PEER_H4 + NWAVES * 4096 <= LDS_CTL_OFF, "peer LDS map");
template <int NTK>
__device__ __forceinline__ void peer_tokens(const Ptrs& A, unsigned char* ws, LAS unsigned char* HL, const int (&rows)[NTK], int l, int lane) {
    constexpr int NE = PEER_NEB / NTK, NEC = PEER_NEC / NTK;
    const unsigned char* EU = ws + WS_EU + (size_t)l * NEXP * EROW; const unsigned char* EV = ws + WS_EV + (size_t)l * NEXP * EROW;
    const float* SU = (const float*)(ws + WS_SU) + (size_t)l * NEXP; const float* SV = (const float*)(ws + WS_SV) + (size_t)l * NEXP;
    const float* MOD = (const float*)(ws + WS_MOD);
    float out[NTK][32]; unsigned k_lo[NTK], k_hi[NTK]; float g_lo[NTK], g_hi[NTK], s_lo[NTK], s_hi[NTK];
    { const int lane = lane_id();
#pragma unroll
    for (int t = 0; t < NTK; ++t) { const int r = rows[t];
        const bf16_t* hrow = (const bf16_t*)(ws + WS_H) + (size_t)r * DM;
        u32x2 hb[8]; float am = 0.f;
#pragma unroll
        for (int i = 0; i < 8; ++i) { hb[i] = *(const u32x2*)(hrow + (lane + 64 * i) * 4);
            am = fmaxf(am, fmaxf(fmaxf(fabsf(bflo(hb[i].x)), fabsf(bfhi(hb[i].x))), fmaxf(fabsf(bflo(hb[i].y)), fabsf(bfhi(hb[i].y))))); }
        am = wave_max(am);
        const float hs = am > 0.f ? am * (1.0f / 6.0f) : 1.0f, hinv = 1.0f / hs;
        LAS unsigned char* H4 = HL + t * 2048;
#pragma unroll
        for (int i = 0; i < 8; ++i) { const float y0 = bflo(hb[i].x) * hinv, y1 = bfhi(hb[i].x) * hinv, y2 = bflo(hb[i].y) * hinv, y3 = bfhi(hb[i].y) * hinv;
            unsigned c1 = 0u; c1 = __builtin_amdgcn_cvt_scalef32_pk_fp4_f32(c1, y0, y1, 1.0f, 0); c1 = __builtin_amdgcn_cvt_scalef32_pk_fp4_f32(c1, y2, y3, 1.0f, 1);
            const f32x2 d01 = __builtin_amdgcn_cvt_scalef32_pk_f32_fp4(c1, 1.0f, 0), d23 = __builtin_amdgcn_cvt_scalef32_pk_f32_fp4(c1, 1.0f, 1);
            unsigned c2 = 0u; c2 = __builtin_amdgcn_cvt_scalef32_pk_fp4_f32(c2, 4.0f * (y0 - d01.x), 4.0f * (y1 - d01.y), 1.0f, 0); c2 = __builtin_amdgcn_cvt_scalef32_pk_fp4_f32(c2, 4.0f * (y2 - d23.x), 4.0f * (y3 - d23.y), 1.0f, 1);
            *(LAS unsigned short*)(H4 + (lane + 64 * i) * 2) = (unsigned short)c1; *(LAS unsigned short*)(H4 + 1024 + (lane + 64 * i) * 2) = (unsigned short)c2; }
        const int* ip = (const int*)(ws + WS_IDX) + (size_t)r * 128; const float* gp = (const float*)(ws + WS_GATE) + (size_t)r * 128;
        const int i_lo = ip[lane], i_hi = ip[64 + lane]; g_lo[t] = gp[lane] * SV[i_lo]; g_hi[t] = gp[64 + lane] * SV[i_hi]; s_lo[t] = SU[i_lo] * hs; s_hi[t] = SU[i_hi] * hs;
        unsigned kl = ((unsigned)i_lo << 7) | (unsigned)lane, kh = ((unsigned)i_hi << 7) | (unsigned)(64 + lane);
#pragma unroll
        for (int k = 2; k <= 128; k <<= 1)
#pragma unroll
            for (int d = k >> 1; d > 0; d >>= 1) {
                if (d == 64) { const unsigned a = kl < kh ? kl : kh, c = kl < kh ? kh : kl; kl = a; kh = c; }
                else { const unsigned o0 = (unsigned)shx_i((int)kl, d), o1 = (unsigned)shx_i((int)kh, d);
                    const bool up0 = k == 128 ? true : (k == 64 ? true : ((lane & k) == 0)), up1 = k == 128 ? true : (k == 64 ? false : ((lane & k) == 0));
                    const bool lowhalf = (lane & d) == 0;
                    const unsigned mn0 = kl < o0 ? kl : o0, mx0 = kl < o0 ? o0 : kl, mn1 = kh < o1 ? kh : o1, mx1 = kh < o1 ? o1 : kh;
                    kl = (lowhalf == up0) ? mn0 : mx0; kh = (lowhalf == up1) ? mn1 : mx1; } }
        k_lo[t] = kl; k_hi[t] = kh;
#pragma unroll
        for (int jj = 0; jj < 32; ++jj) out[t][jj] = 0.f;
    }
    }
    const unsigned l16 = (unsigned)lane_id() * 16u;
    float a_lo[NTK], a_hi[NTK];
    {
        int sa_lo[NTK], sa_hi[NTK];
#pragma unroll
        for (int t = 0; t < NTK; ++t) { sa_lo[t] = 0; sa_hi[t] = 0; }
#pragma unroll 1
        for (int grp = 0; grp < 8; ++grp) {
#pragma unroll
            for (int t = 0; t < NTK; ++t) { const int ln = lane_id();
                const unsigned kreg = grp < 4 ? k_lo[t] : k_hi[t];
                const int e_m = (int)((unsigned)__builtin_amdgcn_ds_bpermute((16 * (grp & 3) + (ln & 15)) << 2, (int)kreg) >> 7);
                const unsigned char* up = EU + (size_t)e_m * EROW + (ln >> 4) * 16;
                i32x4 ua[16];
#pragma unroll
                for (int ks = 0; ks < 16; ++ks) ua[ks] = *(const i32x4*)(up + ks * 64);
                f32x4 acc = {0.f, 0.f, 0.f, 0.f};
#pragma unroll
                for (int ks = 0; ks < 16; ++ks) { if ((ks & 1) == 0) __builtin_amdgcn_sched_barrier(0);
                    const LAS unsigned char* hp = HL + t * 2048 + ks * 64 + (ln >> 4) * 16; const i32x4 b1 = *(const LAS i32x4*)hp, b2 = *(const LAS i32x4*)(hp + 1024);
                    const i32x8 Aop = {ua[ks].x, ua[ks].y, ua[ks].z, ua[ks].w, 0, 0, 0, 0}, B1 = {b1.x, b1.y, b1.z, b1.w, 0, 0, 0, 0}, B2 = {b2.x, b2.y, b2.z, b2.w, 0, 0, 0, 0};
                    acc = __builtin_amdgcn_mfma_scale_f32_16x16x128_f8f6f4(Aop, B1, acc, 4, 4, 0, 0x7F7F7F7F, 0, 0x7F7F7F7F);
                    acc = __builtin_amdgcn_mfma_scale_f32_16x16x128_f8f6f4(Aop, B2, acc, 4, 4, 0, 0x7F7F7F7F, 0, 0x7D7D7D7D); }
                __builtin_amdgcn_sched_barrier(0);
                const float af[4] = {acc[0], acc[1], acc[2], acc[3]};
#pragma unroll
                for (int m = 0; m < 16; ++m) { const int tot = __builtin_amdgcn_readlane(__builtin_bit_cast(int, af[m & 3]), 16 * (m >> 2)); const int wl = 16 * (grp & 3) + m; unsigned keep;
                    if (grp < 4) asm volatile("s_mov_b32 %1, m0\n\ts_mov_b32 m0, %3\n\tv_writelane_b32 %0, %2, m0\n\ts_mov_b32 m0, %1" : "+v"(sa_lo[t]), "=&s"(keep) : "s"(tot), "s"(wl));
                    else asm volatile("s_mov_b32 %1, m0\n\ts_mov_b32 m0, %3\n\tv_writelane_b32 %0, %2, m0\n\ts_mov_b32 m0, %1" : "+v"(sa_hi[t]), "=&s"(keep) : "s"(tot), "s"(wl)); }
            }
        }
        const int lane = lane_id();
#pragma unroll
        for (int t = 0; t < NTK; ++t) {
            const int ps_lo = (int)(k_lo[t] & 127u), ps_hi = (int)(k_hi[t] & 127u);
#define BPF(idx, v) __builtin_bit_cast(float, __builtin_amdgcn_ds_bpermute(((idx) & 63) << 2, __builtin_bit_cast(int, (v))))
            const float su_l0 = BPF(ps_lo, s_lo[t]), su_l1 = BPF(ps_lo, s_hi[t]), su_h0 = BPF(ps_hi, s_lo[t]), su_h1 = BPF(ps_hi, s_hi[t]);
            const float gt_l0 = BPF(ps_lo, g_lo[t]), gt_l1 = BPF(ps_lo, g_hi[t]), gt_h0 = BPF(ps_hi, g_lo[t]), gt_h1 = BPF(ps_hi, g_hi[t]);
#undef BPF
            const float su_l = ps_lo < 64 ? su_l0 : su_l1, su_h = ps_hi < 64 ? su_h0 : su_h1, gt_l = ps_lo < 64 ? gt_l0 : gt_l1, gt_h = ps_hi < 64 ? gt_h0 : gt_h1;
            a_lo[t] = gelu_tanh(__builtin_bit_cast(float, sa_lo[t]) * su_l) * gt_l;
            a_hi[t] = gelu_tanh(__builtin_bit_cast(float, sa_hi[t]) * su_h) * gt_h; }
        (void)lane;
    }
    {
        constexpr int NV = 8 / NTK;
        for (int k0 = 0; k0 < 128; k0 += NV) {
            u32x4 va[NTK][NV];
#pragma unroll
            for (int t = 0; t < NTK; ++t)
#pragma unroll
                for (int k = 0; k < NV; ++k) { const int kk = k0 + k;
                    const int e = (int)((unsigned)__builtin_amdgcn_readlane((int)(kk < 64 ? k_lo[t] : k_hi[t]), kk & 63) >> 7);
                    va[t][k] = *(const u32x4*)((EV + (size_t)e * EROW) + l16); }
#pragma unroll
            for (int t = 0; t < NTK; ++t)
#pragma unroll
                for (int k = 0; k < NV; ++k) { const int kk = k0 + k; if (((t * NV + k) & 1) == 0) __builtin_amdgcn_sched_barrier(0);
                    const float act = __builtin_bit_cast(float, __builtin_amdgcn_readlane(__builtin_bit_cast(int, kk < 64 ? a_lo[t] : a_hi[t]), kk & 63));
                    const u32x4 pa = va[t][k]; const unsigned pw[4] = {pa.x, pa.y, pa.z, pa.w};
#pragma unroll
                    for (int w = 0; w < 4; ++w) {
                        const f32x2 f0 = __builtin_amdgcn_cvt_scalef32_pk_f32_fp4(pw[w], 1.0f, 0), f1 = __builtin_amdgcn_cvt_scalef32_pk_f32_fp4(pw[w], 1.0f, 1), f2 = __builtin_amdgcn_cvt_scalef32_pk_f32_fp4(pw[w], 1.0f, 2), f3 = __builtin_amdgcn_cvt_scalef32_pk_f32_fp4(pw[w], 1.0f, 3);
                        out[t][8 * w + 0] = fmaf(act, f0.x, out[t][8 * w + 0]); out[t][8 * w + 1] = fmaf(act, f0.y, out[t][8 * w + 1]); out[t][8 * w + 2] = fmaf(act, f1.x, out[t][8 * w + 2]); out[t][8 * w + 3] = fmaf(act, f1.y, out[t][8 * w + 3]);
                        out[t][8 * w + 4] = fmaf(act, f2.x, out[t][8 * w + 4]); out[t][8 * w + 5] = fmaf(act, f2.y, out[t][8 * w + 5]); out[t][8 * w + 6] = fmaf(act, f3.x, out[t][8 * w + 6]); out[t][8 * w + 7] = fmaf(act, f3.y, out[t][8 * w + 7]); } }
        }
    }
    const int lane_e = lane_id();
#pragma unroll
    for (int t = 0; t < NTK; ++t) { const int r = rows[t]; const int b = r / RPB, j = r - b * RPB; const bool isctx = j < CTX;
        float* xrow = (float*)(ws + WS_XRES) + (size_t)r * DM; const int mr = isctx ? 4 : b;
        const float* gf = MOD + ((size_t)l * 5 + mr) * NMOD + 5 * DM;
        float ss = 0.f;
#pragma unroll
        for (int i = 0; i < 8; ++i) { const int col = (lane_e + 64 * i) * 4; const f32x4 g4 = *(const f32x4*)(gf + col); f32x4 x4 = *(const f32x4*)(xrow + col);
            x4.x += g4.x * out[t][4 * i]; x4.y += g4.y * out[t][4 * i + 1]; x4.z += g4.z * out[t][4 * i + 2]; x4.w += g4.w * out[t][4 * i + 3];
            out[t][4 * i] = x4.x; out[t][4 * i + 1] = x4.y; out[t][4 * i + 2] = x4.z; out[t][4 * i + 3] = x4.w;
            ss += (x4.x * x4.x + x4.y * x4.y) + (x4.z * x4.z + x4.w * x4.w); }
        ss = wave_sum(ss); const float rstd = 1.0f / sqrtf(ss * (1.0f / DM) + EPS);
        if (l < DEPTH - 1) {
            const float* mp = MOD + ((size_t)(l + 1) * 5 + mr) * NMOD; const float* gn = A.in(6) + (l + 1) * DM; bf16_t* hw = (bf16_t*)(ws + WS_H) + (size_t)r * DM;
#pragma unroll
            for (int i = 0; i < 8; ++i) { const int col = (lane_e + 64 * i) * 4;
                *(f32x4*)(xrow + col) = (f32x4){out[t][4 * i], out[t][4 * i + 1], out[t][4 * i + 2], out[t][4 * i + 3]};
                const f32x4 g4 = *(const f32x4*)(gn + col), sh = *(const f32x4*)(mp + col), sc = *(const f32x4*)(mp + DM + col);
                *(u32x2*)(hw + col) = (u32x2){cvt_pk((out[t][4 * i] * rstd * g4.x) * (1.f + sc.x) + sh.x, (out[t][4 * i + 1] * rstd * g4.y) * (1.f + sc.y) + sh.y),
                                              cvt_pk((out[t][4 * i + 2] * rstd * g4.z) * (1.f + sc.z) + sh.z, (out[t][4 * i + 3] * rstd * g4.w) * (1.f + sc.w) + sh.w)}; }
        } else {
            float* orow = A.out() + ((size_t)b * SEQ + (j - CTX)) * DM; const float* fg = A.in(21);
#pragma unroll
            for (int i = 0; i < 8; ++i) { const int col = (lane_e + 64 * i) * 4; const f32x4 g4 = *(const f32x4*)(fg + col);
                *(f32x4*)(orow + col) = (f32x4){out[t][4 * i] * rstd * g4.x, out[t][4 * i + 1] * rstd * g4.y, out[t][4 * i + 2] * rstd * g4.z, out[t][4 * i + 3] * rstd * g4.w}; }
        }
    }
}
#ifndef PEER_NTK
#define PEER_NTK 2
#endif
__device__ __forceinline__ void peer_rows(const Ptrs& A, LAS unsigned char* L, unsigned xcc, int l, int wave, int bid, int G) { asm volatile("" : "+s"(wave));
    unsigned char* ws = A.ws(); LAUNDER_G(ws); const int gw = bid + G * wave, NGW = G * NWAVES;
    for (int r = gw; r < NTOK; ) {
        const int lane = lane_id();
        int rr[3] = {-1, -1, -1}; int n = 0;
#pragma unroll
        for (int t = 0; t < PEER_NTK; ++t) { while (r < NTOK && rr[t] < 0) { if (!(l == DEPTH - 1 && (r % RPB) < CTX)) { rr[t] = r; ++n; } r += NGW; } }
        if (n == 0) break;
        LAS unsigned char* HL = L + PEER_H4 + wave * 4096;
        if (n >= 2) { const int rows[2] = {rr[0], rr[1]}; peer_tokens<2>(A, ws, HL, rows, l, lane); }
        else { const int rows[1] = {rr[0]}; peer_tokens<1>(A, ws, HL, rows, l, lane); }
    }
}

__device__ __forceinline__ void norm2_rows(const Ptrs& A, int l, int wave, int bid, int G) { asm volatile("" : "+s"(wave)); const int lane = lane_id();
    unsigned char* ws = A.ws(); LAUNDER_G(ws); const int gw = bid + G * wave, NGW = G * NWAVES; const float* MOD = (const float*)(ws + WS_MOD);
    for (int r = gw; r < NTOK; r += NGW) {
        float v[4][8]; row_load_f32((const float*)(ws + WS_XRES) + (size_t)r * DM, lane, v);
        const float rstd = row_rstd(v); const float* mp = MOD + ((size_t)l * 5 + modrow(r)) * NMOD;
        norm_mod_store(v, rstd, A.in(7) + l * DM, mp + 3 * DM, mp + 4 * DM, (bf16_t*)(ws + WS_H) + (size_t)r * DM, lane);
    }
}

constexpr int PH_P0A = 0, PH_P0B = 1, PH_L0 = 2, NPL = 9, N_PHASES = PH_L0 + DEPTH * NPL;
__global__ void __launch_bounds__(NTHR, 2) mk_fwd(Args args) {
    extern __shared__ __attribute__((aligned(16))) unsigned char lds_raw[];
    LAS unsigned char* L = (LAS unsigned char*)lds_raw;
    const int wave = __builtin_amdgcn_readfirstlane(threadIdx.x >> 6), bid = blockIdx.x, G = gridDim.x;
    if (wave == 0) { const int ln = lane_id(); if (ln < 16) ((LAS unsigned*)(L + LDS_CTL_OFF))[ln] = 0u;
        if (ln == 0) { LAS unsigned long long* pt = (LAS unsigned long long*)(L + LDS_CTL_OFF + 64);
#pragma unroll
            for (int i = 0; i < 22; ++i) pt[i] = (unsigned long long)(uintptr_t)args.in[i];
            pt[22] = (unsigned long long)(uintptr_t)args.out; pt[23] = (unsigned long long)(uintptr_t)args.ws; } }
    __syncthreads();
    const Ptrs PT{L};
    unsigned* ctl = (unsigned*)(PT.ws() + WS_CTL);
    XcdBarrier bar; bar.bar = ctl + CW_BAR; bar.x = 0; bar.st = nullptr; bar.wv = (unsigned)wave;
#if !MK_MULTI
    bar = xcd_barrier_post(ctl + CW_BAR, (volatile LAS unsigned*)(L + LDS_CTL_OFF) + 8);
    bar.wv = (unsigned)wave;
#endif
    const int lo = args.ph_lo, hi = args.ph_hi;
#ifndef PH_MASK
#define PH_MASK 0x7ff
#endif
#define PHSEL(n) (((PH_MASK) >> (n)) & 1)
#define IN(k) (lo <= (k) && (k) < hi)
#if MK_MULTI
#define SEAM(k) do { } while (0)
#else
#define SEAM(k) do { if (IN(k) && IN((k) + 1)) xcd_barrier(bar); } while (0)
#endif
    if (PHSEL(0) && IN(PH_P0A)) p0a(PT, L, wave, bid, G);
    SEAM(PH_P0A);
    if (PHSEL(1) && IN(PH_P0B)) p0b(PT, wave, bid, G);
    SEAM(PH_P0B);
    for (int l = 0; l < DEPTH; ++l) {
        const int pb = PH_L0 + l * NPL;
        if (PHSEL(2) && IN(pb + 0)) {
            unsigned char* ws = PT.ws(); LAUNDER_G(ws);
            pg8::Gemm g{(const bf16_t*)(ws + WS_H), (const bf16_t*)(ws + WS_WIN) + (size_t)l * PW * DM, NTOK, PW, DM, DM, DM};
            pg8::StaticOrder S; S.init(NTOK, PW, G, bid);
            pg8::EpiBf16<0> E{(bf16_t*)(ws + WS_P), PW, nullptr, 0, 0, 1.f};
#ifndef DBL_GIN
#define DBL_GIN 1
#endif
            for (int rep = 0; rep < DBL_GIN; ++rep)
            pg8::gemm_phase<pg8::EpiBf16<0>, pg8::StaticOrder, true, true>(L, g, S, E, wave);
#ifndef DBL_SIDE
#define DBL_SIDE 1
#endif
            for (int rep = 0; rep < DBL_SIDE; ++rep)
            side_gemm(PT, L, l, wave, bid, G);
        }
        SEAM(pb + 0);
        if (PHSEL(3) && IN(pb + 1)) {
            unsigned char* ws = PT.ws(); LAUNDER_G(ws);
#ifndef NO_THIN
            thin_rows(PT, l, wave, bid, G);
#endif
#ifndef NO_G1
#ifndef DBL_GLA
#define DBL_GLA 1
#endif
#ifndef DBL_G1
#define DBL_G1 DBL_GLA
#endif
            for (int rep = 0; rep < DBL_G1; ++rep)
            for (int u = bid; u < NGU; u += G) gla_g1(PT, L, l, u, wave);
#endif
        }
        SEAM(pb + 1);
        if (PHSEL(4) && IN(pb + 2)) {
            unsigned char* ws = PT.ws(); LAUNDER_G(ws);
#ifndef NO_UQ
            { pg8::Gemm g{(const bf16_t*)(ws + WS_P) + P_CQ, (const bf16_t*)(ws + WS_WUQ) + (size_t)l * 1536 * 512, NTOK, 1536, 512, PW, 512};
              pg8::StaticOrder S; S.init(NTOK, 1536, G, bid);
              pg8::EpiQRope E{(bf16_t*)(ws + WS_Q), (const float*)(ws + WS_ROPE), (const float*)(ws + WS_ROPE) + SEQ * 32};
              pg8::gemm_phase<pg8::EpiQRope, pg8::StaticOrder, true, true>(L, g, S, E, wave); }
#endif
#ifndef NO_UKV
            { pg8::Gemm g{(const bf16_t*)(ws + WS_P) + P_CKV, (const bf16_t*)(ws + WS_WUKV) + (size_t)l * 2048 * 256, NTOK, 2048, 256, PW, 256};
              pg8::LatentOrder S; S.init(2048, G, bid);
              pg8::EpiBf16<0> E{(bf16_t*)(ws + WS_KV), 2048, nullptr, 0, 0, 1.f};
              pg8::gemm_phase<pg8::EpiBf16<0>, pg8::LatentOrder, true, true>(L, g, S, E, wave);
              bf16_t* KVo = (bf16_t*)(ws + WS_KV);
              ctx_gemm(L, (const bf16_t*)(ws + WS_P) + P_CKV, PW, (const bf16_t*)(ws + WS_WUKV) + (size_t)l * 2048 * 256, 256, 2048, 256, wave, bid, G, [=](int row, int col, float v) { KVo[(size_t)row * 2048 + col] = f2bf_safe(v); }); }
#endif
#ifndef NO_G2
#ifndef DBL_G2
#define DBL_G2 DBL_GLA
#endif
            for (int rep = 0; rep < DBL_G2; ++rep) gla_g2(PT, wave, bid, G);
#endif
        }
        SEAM(pb + 2);
        if (PHSEL(5) && IN(pb + 3)) {
            unsigned char* ws = PT.ws(); LAUNDER_G(ws);
            const bf16_t* Q = (const bf16_t*)(ws + WS_Q); const bf16_t* KV = (const bf16_t*)(ws + WS_KV); const bf16_t* KR = (const bf16_t*)(ws + WS_KR); bf16_t* MIX = (bf16_t*)(ws + WS_MIX);
            const int nau = NB * 8 * 16 + (l < DEPTH - 1 ? NB * 8 : 0);
#ifndef DBL_ATT
#define DBL_ATT 1
#endif
#ifndef DBL_G3
#define DBL_G3 DBL_GLA
#endif
            const bool g3first = ((bid >> 3) & 1) != 0;
            for (int step = 0; step < 2; ++step) {
                if ((step == 0) == g3first) {
            for (int rep = 0; rep < DBL_G3; ++rep)
            for (int u = G - 1 - bid; u < NGU; u += G) gla_g3(PT, L, l, u, wave);
                } else {
            for (int rep = 0; rep < DBL_ATT; ++rep)
            for (int u = bid; u < nau; u += G) {
                int b, h, q0, nk;
                if (u < NB * 8 * 16) {
                    int uu = u; if ((G & 7) == 0 && G * 2 == NB * 8 * 16) { const int xcd = bid & 7, idx = (bid >> 3) + (G >> 3) * (u / G); uu = (4 * xcd + (idx >> 4)) * 16 + (idx & 15); }
                    b = uu >> 7; h = (uu >> 4) & 7; q0 = b * RPB + CTX + (uu & 15) * 256; nk = RPB; }
                else { const int v = u - NB * 8 * 16; b = v >> 3; h = v & 7; q0 = b * RPB; nk = CTX; }
                att::attn_unit(Q + (size_t)q0 * 1536 + h * 192, KV + (size_t)b * RPB * 2048 + h * 256, KR + (size_t)b * RPB * 64, KV + (size_t)b * RPB * 2048 + h * 256 + 128,
                               MIX + (size_t)q0 * DM + h * 128, nk, L, wave);
            }
                }
            }
        }
        SEAM(pb + 3);
        if (PHSEL(6) && IN(pb + 4)) {
            unsigned char* ws = PT.ws(); LAUNDER_G(ws);
            pg8::Gemm g{(const bf16_t*)(ws + WS_MIX), (const bf16_t*)(ws + WS_WOUT) + (size_t)l * DM * DM, NTOK, DM, DM, DM, DM};
            pg8::LatentOrder S; S.init(DM, G, bid);
            pg8::EpiResid E{(float*)(ws + WS_XRES), (const float*)(ws + WS_MOD) + (size_t)l * 5 * NMOD + 2 * DM};
            const bool cfirst = ((bid >> 3) & 1) != 0 && (l < DEPTH - 1);
            float* X = (float*)(ws + WS_XRES); const float* gate = (const float*)(ws + WS_MOD) + ((size_t)l * 5 + 4) * NMOD + 2 * DM;
            for (int step = 0; step < 2; ++step) {
                if ((step == 0) != cfirst) pg8::gemm_phase<pg8::EpiResid, pg8::LatentOrder, true, true>(L, g, S, E, wave);
                else if (l < DEPTH - 1) {
                ctx_gemm(L, (const bf16_t*)(ws + WS_MIX), DM, (const bf16_t*)(ws + WS_WOUT) + (size_t)l * DM * DM, DM, DM, DM, wave, bid, G, [=](int row, int col, float v) { X[(size_t)row * DM + col] += gate[col] * v; });
                }
            }
        }
        SEAM(pb + 4);
        if (PHSEL(7) && IN(pb + 5)) norm2_rows(PT, l, wave, bid, G);
        SEAM(pb + 5);
        if (PHSEL(8) && IN(pb + 6)) {
            unsigned char* ws = PT.ws(); LAUNDER_G(ws);
            pg8::Gemm g{(const bf16_t*)(ws + WS_H), (const bf16_t*)(ws + WS_WQRY) + (size_t)l * DM * DM, NTOK, DM, DM, DM, DM};
            pg8::LatentOrder S; S.init(DM, G, bid);
            pg8::EpiBf16<0> E{(bf16_t*)(ws + WS_QP), DM, nullptr, 0, 0, 1.f};
            pg8::gemm_phase<pg8::EpiBf16<0>, pg8::LatentOrder, true, true>(L, g, S, E, wave);
            if (l < DEPTH - 1) { bf16_t* QPo = (bf16_t*)(ws + WS_QP);
                ctx_gemm(L, (const bf16_t*)(ws + WS_H), DM, (const bf16_t*)(ws + WS_WQRY) + (size_t)l * DM * DM, DM, DM, DM, wave, bid, G, [=](int row, int col, float v) { QPo[(size_t)row * DM + col] = f2bf_safe(v); }); }
        }
        SEAM(pb + 6);
#ifndef DBL_TOPK
#define DBL_TOPK 1
#endif
        if (PHSEL(9) && IN(pb + 7)) { for (int rep = 0; rep < DBL_TOPK; ++rep) { peer_topk_phase(PT, L, l, wave, bid, G); __syncthreads(); } }
        SEAM(pb + 7);
        if (PHSEL(10) && IN(pb + 8)) peer_rows(PT, L, bar.x, l, wave, bid, G);
        SEAM(pb + 8);
    }
}

extern "C" void kernel_launch(void* const* d_in, const int* in_sizes, int n_in, void* d_out, int out_size, void* d_ws, size_t ws_size, hipStream_t stream) {
    static int grid = 0;
    if (grid == 0) {
        if (n_in != 22 || out_size != NB * SEQ * DM || ws_size < WS_END) { fprintf(stderr, "kernel_launch: unexpected shapes: n_in %d out %d ws %zu (need %zu)\n", n_in, out_size, ws_size, (size_t)WS_END); grid = -1; return; }
        int dev = 0, cus = 0, per_cu = 0;
        if (hipGetDevice(&dev) != hipSuccess || hipDeviceGetAttribute(&cus, hipDeviceAttributeMultiprocessorCount, dev) != hipSuccess) { grid = -1; return; }
        if (hipFuncSetAttribute((const void*)mk_fwd, hipFuncAttributeMaxDynamicSharedMemorySize, LDS_BYTES) != hipSuccess) { fprintf(stderr, "kernel_launch: hipFuncSetAttribute failed\n"); grid = -1; return; }
        if (hipOccupancyMaxActiveBlocksPerMultiprocessor(&per_cu, mk_fwd, NTHR, LDS_BYTES) != hipSuccess || per_cu < 1) { fprintf(stderr, "kernel_launch: occupancy query says %d\n", per_cu); grid = -1; return; }
        grid = cus;
    }
    if (grid < 0) return;
    (void)hipMemsetAsync((char*)d_ws + WS_CTL, 0, CTL_BYTES, stream);
    Args a{};
    for (int i = 0; i < 22; ++i) a.in[i] = (const float*)d_in[i];
    a.out = (float*)d_out; a.ws = (unsigned char*)d_ws;
#if MK_MULTI
    for (int p = 0; p < N_PHASES; ++p) { a.ph_lo = p; a.ph_hi = p + 1; hipLaunchKernelGGL(mk_fwd, dim3(grid), dim3(NTHR), LDS_BYTES, stream, a); }
#else
    a.ph_lo = 0; a.ph_hi = N_PHASES;
    hipLaunchKernelGGL(mk_fwd, dim3(grid), dim3(NTHR), LDS_BYTES, stream, a);
#endif
    const hipError_t le = hipPeekAtLastError();
    if (le != hipSuccess) fprintf(stderr, "kernel_launch: launch failed: %s\n", hipGetErrorName(le));
}
```

```cpp
#include <hip/hip_runtime.h>
#include <cstdio>
#include <cstdint>

#ifndef MK_MULTI
#define MK_MULTI 0
#endif

#define GAS __attribute__((address_space(1)))
#define LAS __attribute__((address_space(3)))
typedef unsigned short bf16_t;
typedef short bf16x8 __attribute__((ext_vector_type(8)));
typedef short s16x4 __attribute__((ext_vector_type(4)));
typedef float f32x2 __attribute__((ext_vector_type(2)));
typedef float f32x4 __attribute__((ext_vector_type(4)));
typedef float f32x16 __attribute__((ext_vector_type(16)));
typedef unsigned u32x2 __attribute__((ext_vector_type(2)));
typedef unsigned u32x4 __attribute__((ext_vector_type(4)));
typedef __bf16 bf16v2 __attribute__((ext_vector_type(2)));
typedef unsigned u32x6 __attribute__((ext_vector_type(6)));
typedef float f32x32 __attribute__((ext_vector_type(32)));
typedef __bf16 bf16x32v __attribute__((ext_vector_type(32)));
typedef unsigned u32x16 __attribute__((ext_vector_type(16)));

constexpr int DM = 2048, NB = 4, SEQ = 4096, CTX = 256, RPB = SEQ + CTX, NTOK = NB * RPB, DEPTH = 4;
constexpr int NMOD = 6 * DM;
constexpr int PW = 3840;
constexpr int P_CQ = 0, P_CKV = 512, P_GQ = 768, P_GK = 1280, P_GV = 1792, P_GG = 2816;
constexpr int SIDEW = 96;
constexpr int NCH = RPB / 64;
constexpr int NGU = NB * 4 * NCH;
constexpr int NEXP = 16384;
constexpr float EPS = 1e-6f;
constexpr int NTHR = 512, NWAVES = 8;

constexpr size_t al256(size_t x) { return (x + 255) & ~(size_t)255; }
constexpr size_t WS_CTL = 0, CTL_BYTES = 1u << 20;
constexpr size_t WS_MOD = WS_CTL + CTL_BYTES;
constexpr size_t WS_ROPE = WS_MOD + al256((size_t)DEPTH * 5 * NMOD * 4);
constexpr size_t WS_WIN = WS_ROPE + al256((size_t)2 * SEQ * 32 * 4);
constexpr size_t WS_WSIDE = WS_WIN + (size_t)DEPTH * PW * DM * 2;
constexpr size_t WS_WUQ = WS_WSIDE + (size_t)DEPTH * SIDEW * DM * 2;
constexpr size_t WS_WUKV = WS_WUQ + (size_t)DEPTH * 1536 * 512 * 2;
constexpr size_t WS_WOUT = WS_WUKV + (size_t)DEPTH * 2048 * 256 * 2;
constexpr size_t WS_WQRY = WS_WOUT + (size_t)DEPTH * DM * DM * 2;
constexpr size_t WS_SUBK = WS_WQRY + (size_t)DEPTH * DM * DM * 2;
constexpr int EROW = 1024;
constexpr size_t WS_EU = WS_SUBK + (size_t)DEPTH * 2 * 8 * 128 * 128 * 2;
constexpr size_t WS_EV = WS_EU + (size_t)DEPTH * NEXP * EROW;
constexpr size_t WS_SU = WS_EV + (size_t)DEPTH * NEXP * EROW;
constexpr size_t WS_SV = WS_SU + (size_t)DEPTH * NEXP * 4;
constexpr size_t WS_XRES = WS_SV + (size_t)DEPTH * NEXP * 4;
constexpr size_t WS_H = WS_XRES + (size_t)NTOK * DM * 4;
constexpr size_t WS_P = WS_H + (size_t)NTOK * DM * 2;
constexpr size_t WS_SIDE = WS_P + (size_t)NTOK * PW * 2;
constexpr size_t WS_Q = WS_SIDE + (size_t)NTOK * SIDEW * 4;
constexpr size_t WS_KV = WS_Q + (size_t)NTOK * 1536 * 2;
constexpr size_t WS_KR = WS_KV + (size_t)NTOK * 2048 * 2;
constexpr size_t WS_MIX = WS_KR + (size_t)NTOK * 64 * 2;
constexpr size_t WS_QDEC = WS_MIX + (size_t)NTOK * DM * 2;
constexpr size_t WS_OINTRA = WS_QDEC + (size_t)NGU * 2 * 64 * 128 * 2;
constexpr size_t WS_DS = WS_OINTRA + (size_t)NTOK * 1024 * 4;
constexpr size_t WS_DEC = WS_DS + (size_t)2 * 16 * NCH * 32768 * 2;
constexpr size_t WS_SENT = WS_DEC + al256((size_t)2 * 16 * NCH * 128 * 4);
constexpr size_t WS_QP = WS_SENT + (size_t)2 * 16 * NCH * 32768 * 2;
constexpr size_t WS_IDX = WS_QP + (size_t)NTOK * DM * 2;
constexpr size_t WS_GATE = WS_IDX + (size_t)NTOK * 128 * 4;
constexpr size_t WS_END = WS_GATE + (size_t)NTOK * 128 * 4;

constexpr int CW_DBG = 8;
constexpr int CW_BAR = 4096;
constexpr int CW_RND = 8192;

constexpr int LDS_BYTES = 163840;
constexpr int LDS_CTL_OFF = LDS_BYTES - 256;

__device__ __forceinline__ unsigned cvt_pk(float lo, float hi) { unsigned r; asm volatile("v_cvt_pk_bf16_f32 %0, %1, %2" : "=v"(r) : "v"(lo), "v"(hi)); return r; }
__device__ __forceinline__ unsigned cvt_pk_safe(float lo, float hi) { const f32x2 v = {lo, hi}; const bf16v2 b = __builtin_convertvector(v, bf16v2); return __builtin_bit_cast(unsigned, b); }
__device__ __forceinline__ unsigned cvt_pk_asm(float lo, float hi) { unsigned r; asm volatile("v_cvt_pk_bf16_f32 %0, %1, %2" : "=v"(r) : "v"(lo), "v"(hi)); return r; }
__device__ __forceinline__ float bflo(unsigned w) { return __builtin_bit_cast(float, w << 16); }
__device__ __forceinline__ float bfhi(unsigned w) { return __builtin_bit_cast(float, w & 0xffff0000u); }
__device__ __forceinline__ float bf2f(bf16_t b) { return __builtin_bit_cast(float, (unsigned)b << 16); }
__device__ __forceinline__ bf16_t f2bf_safe(float f) { return (bf16_t)(cvt_pk_safe(f, 0.f) & 0xffffu); }
__device__ __forceinline__ bf16_t f2bf(float f) { return (bf16_t)(cvt_pk(f, 0.f) & 0xffffu); }
#define DPP_I(v, ctrl) __builtin_amdgcn_update_dpp(0, (v), (ctrl), 0xF, 0xF, true)
__device__ __forceinline__ int lane_id();
__device__ __forceinline__ int shx_i(int v, int o) {
    switch (o) {
    case 1: return DPP_I(v, 0xB1);
    case 2: return DPP_I(v, 0x4E);
    case 4: return DPP_I(DPP_I(v, 0x1B), 0x141);
    case 8: return DPP_I(v, 0x128);
    default: return __builtin_amdgcn_ds_bpermute((lane_id() ^ o) << 2, v);
    }
}
__device__ __forceinline__ float shx_f(float v, int o) { return __builtin_bit_cast(float, shx_i(__builtin_bit_cast(int, v), o)); }
#define DPP_F(v, ctrl) __builtin_bit_cast(float, DPP_I(__builtin_bit_cast(int, (v)), (ctrl)))
#define RL_F(v, l) __builtin_bit_cast(float, __builtin_amdgcn_readlane(__builtin_bit_cast(int, (v)), (l)))
__device__ __forceinline__ float wave_sum(float v) {
    v += DPP_F(v, 0xB1); v += DPP_F(v, 0x4E); v += DPP_F(v, 0x141); v += DPP_F(v, 0x140);
    return (RL_F(v, 0) + RL_F(v, 16)) + (RL_F(v, 32) + RL_F(v, 48));
}
__device__ __forceinline__ float wave_max(float v) {
    v = fmaxf(v, DPP_F(v, 0xB1)); v = fmaxf(v, DPP_F(v, 0x4E)); v = fmaxf(v, DPP_F(v, 0x141)); v = fmaxf(v, DPP_F(v, 0x140));
    return fmaxf(fmaxf(RL_F(v, 0), RL_F(v, 16)), fmaxf(RL_F(v, 32), RL_F(v, 48)));
}
__device__ __forceinline__ int wave_sum_i(int v) {
    v += DPP_I(v, 0xB1); v += DPP_I(v, 0x4E); v += DPP_I(v, 0x141); v += DPP_I(v, 0x140);
    return (__builtin_amdgcn_readlane(v, 0) + __builtin_amdgcn_readlane(v, 16)) + (__builtin_amdgcn_readlane(v, 32) + __builtin_amdgcn_readlane(v, 48));
}
__device__ __forceinline__ int crow(int r, int hi) { return (r & 3) + 8 * (r >> 2) + 4 * hi; }
__device__ __forceinline__ int modrow(int r) { const int b = r / RPB; return (r - b * RPB) < CTX ? 4 : b; }
__device__ __forceinline__ int lane_id() { int l; asm volatile("v_mbcnt_lo_u32_b32 %0, -1, 0\n\tv_mbcnt_hi_u32_b32 %0, -1, %0" : "=&v"(l)); return l; }
#define LDS_WAIT() asm volatile("s_waitcnt lgkmcnt(0)" ::: "memory")
#define VM_WAIT() asm volatile("s_waitcnt vmcnt(0)" ::: "memory")
#define SBAR() __builtin_amdgcn_sched_barrier(0)
#define LAUNDER_G(p) do { GAS unsigned char* _g = (GAS unsigned char*)(p); asm volatile("" : "+s"(_g)); (p) = (unsigned char*)_g; } while (0)

namespace pg8 {
#define PG8_LAS __attribute__((address_space(3)))
typedef unsigned short bf16_t;
typedef short bf16x8 __attribute__((ext_vector_type(8)));
typedef float f32x4 __attribute__((ext_vector_type(4)));
typedef unsigned u32x4 __attribute__((ext_vector_type(4)));
constexpr int BM = 256, BK = 64, HALF = 128, HTB = HALF * BK * 2  , STAGE_BYTES = 8 * HTB, NXCD = 8, WGM = 8;

__host__ __device__ __forceinline__ int lds_byte(int r, int c) { const int st = (r >> 4) * 2 + (c >> 5), rr = r & 15, cc = c & 31, ob = rr * 64 + cc * 2; return st * 1024 + (ob ^ (((ob >> 9) & 1) << 5)); }
__host__ __device__ __forceinline__ void stage_rc(int b, int& R, int& C) { const int st = b / 1024, sb = b % 1024, swz = sb ^ (((sb >> 9) & 1) << 5); R = (st >> 1) * 16 + swz / 64; C = (st & 1) * 32 + (swz % 64) / 2; }
__host__ __device__ __forceinline__ int perm32(int rho) { const int n = rho >> 4, i = rho & 15; return 8 * (i >> 2) + 4 * n + (i & 3); }

struct Unit { int pm, pn; };
struct Gemm { const bf16_t* A; const bf16_t* Bt; int M, N, K, lda, ldb; };

struct StaticOrder {
    int nM, nN, nwg, G, c;
    __host__ __device__ void init(int M, int N, int G_, int c_) { nM = M / BM; nN = N / BM; nwg = nM * nN; G = G_; c = c_; }
    __host__ __device__ bool next(int i, Unit& u) const {
        const long L = (long)i * G + c; if (L >= nwg) return false;
        int wgid = (int)L; { const int q = nwg / NXCD, r = nwg % NXCD, xcd = wgid % NXCD, off = wgid / NXCD; wgid = (xcd < r ? xcd * (q + 1) : r * (q + 1) + (xcd - r) * q) + off; }
        const int nig = WGM * nN, gid = wgid / nig, fm = gid * WGM, gsz = (nM - fm) < WGM ? (nM - fm) : WGM;
        u.pm = fm + ((wgid % nig) % gsz); u.pn = (wgid % nig) / gsz; return true;
    }
    __device__ __forceinline__ void a_ready(const Unit&) const {}
    __device__ __forceinline__ void done(const Unit&) const {}
};
struct LatentOrder : StaticOrder {
    __host__ __device__ void init(int N, int G_, int c_) { StaticOrder::init(16384, N, G_, c_); }
    __host__ __device__ bool next(int i, Unit& u) const { if (!StaticOrder::next(i, u)) return false; u.pm = u.pm + (u.pm >> 4) + 1; return true; }
};


__device__ __forceinline__ unsigned cvt_pk_bf16(float lo, float hi) { return ::cvt_pk_asm(lo, hi); }

template <int ACT  > struct EpiBf16 {
    static constexpr bool PERM = true, AFTER_DRAIN = false; static_assert(ACT == 0, "EpiBf16: no activation here");
    bf16_t* O; int ldc; const float* bias; int split_cols; size_t split_stride; float scale0;
    __device__ __forceinline__ void operator()(const f32x4 (&acc)[2][2][4][2], const Unit& u, int wr, int wc, int fr, int fq) const {
        const int row0 = u.pm * BM + wr * 64 + fr; int colt = u.pn * BM; bf16_t* base = O;
        float sc = 1.f; if (split_cols) { const int t = colt / split_cols; base += (size_t)t * split_stride; colt -= t * split_cols; if (t == 0) sc = scale0; }
        const int col0 = colt + wc * 32 + 8 * fq, bcol0 = u.pn * BM + wc * 32 + 8 * fq;
        f32x4 bv[2][2];
#pragma unroll
        for (int bj = 0; bj < 2; ++bj)
#pragma unroll
            for (int n = 0; n < 2; ++n) bv[bj][n] = bias ? *(const f32x4*)(bias + bcol0 + bj * HALF + 4 * n) : (f32x4){0.f, 0.f, 0.f, 0.f};
#pragma unroll
        for (int ai = 0; ai < 2; ++ai)
#pragma unroll
            for (int m = 0; m < 4; ++m) { bf16_t* rowp = base + (size_t)(row0 + ai * HALF + m * 16) * ldc + col0;
#pragma unroll
                for (int bj = 0; bj < 2; ++bj) { f32x4 v0 = acc[ai][bj][m][0] + bv[bj][0], v1 = acc[ai][bj][m][1] + bv[bj][1];
                    v0 = v0 * sc; v1 = v1 * sc; u32x4 w; w.x = cvt_pk_bf16(v0[0], v0[1]); w.y = cvt_pk_bf16(v0[2], v0[3]); w.z = cvt_pk_bf16(v1[0], v1[1]); w.w = cvt_pk_bf16(v1[2], v1[3]);
                    *(u32x4*)(rowp + bj * HALF) = w; } }
    }
};


template <class Epi, class Sched, bool ALIGN_EPI = false, bool SP2 = false>
__device__ __forceinline__ void gemm_phase(PG8_LAS unsigned char* lds, const Gemm g, const Sched& S, const Epi& E, int wid) {
    asm volatile("" : "+s"(wid));
    const int lane = lane_id(), tid = wid * 64 + lane, wr = wid >> 2, wc = wid & 3, fr = lane & 15, fq = lane >> 4;
    const int K = g.K, nt = K / BK;
    unsigned voffA[2], voffB[2];
#pragma unroll
    for (int i = 0; i < 2; ++i) { int R, C; stage_rc(tid * 16 + i * 8192, R, C); const int Rb = Epi::PERM ? ((R & ~31) + perm32(R & 31)) : R;
        voffA[i] = (unsigned)(R * g.lda + C) * 2u; voffB[i] = (unsigned)(Rb * g.ldb + C) * 2u; }
    const size_t kstep = (size_t)(BK * 2);
    const size_t hstepA = (size_t)HALF * g.lda * 2, hstepB = (size_t)HALF * g.ldb * 2;
    const size_t tstepA = 2 * hstepA, tstepB = 2 * hstepB;
    const unsigned ldsw = (unsigned)wid * 1024u;
    const int aoff = lds_byte(wr * 64 + fr, fq * 8), boff = lds_byte(wc * 32 + fr, fq * 8);
#define PG8_SA(b, h) (((b) * 2 + (h)) * HTB)
#define PG8_SB(b, h) ((4 + (b) * 2 + (h)) * HTB)
#define PG8_STAGE(bufoff, gbase, voff) do { _Pragma("unroll") for (int _i = 0; _i < 2; ++_i) \
        __builtin_amdgcn_global_load_lds((const unsigned*)((const char*)(gbase) + (voff)[_i]), (PG8_LAS unsigned*)(lds + (bufoff) + ldsw + _i * 8192), 16, 0, 0); } while (0)
#define PG8_LDA(dst, b, h) do { _Pragma("unroll") for (int m = 0; m < 4; ++m) _Pragma("unroll") for (int k = 0; k < 2; ++k) dst[m][k] = *(const PG8_LAS bf16x8*)(lds + PG8_SA(b, h) + aoff + m * 2048 + k * 1024); } while (0)
#define PG8_LDB(dst, b, h) do { _Pragma("unroll") for (int n = 0; n < 2; ++n) _Pragma("unroll") for (int k = 0; k < 2; ++k) dst[n][k] = *(const PG8_LAS bf16x8*)(lds + PG8_SB(b, h) + boff + n * 2048 + k * 1024); } while (0)
#define PG8_MMA(ai, bj, At, Bt) do { __builtin_amdgcn_s_setprio(1); _Pragma("unroll") for (int m = 0; m < 4; ++m) _Pragma("unroll") for (int n = 0; n < 2; ++n) _Pragma("unroll") for (int k = 0; k < 2; ++k) \
        acc[ai][bj][m][n] = __builtin_amdgcn_mfma_f32_16x16x32_bf16(Bt[n][k], At[m][k], acc[ai][bj][m][n], 0, 0, 0); __builtin_amdgcn_s_setprio(0); } while (0)
#define PG8_WAIT_V(n) asm volatile("s_waitcnt vmcnt(" #n ")" ::: "memory")
#define PG8_WAIT_L(n) asm volatile("s_waitcnt lgkmcnt(" #n ")" ::: "memory")
#define PG8_BAR __builtin_amdgcn_s_barrier()
#define PG8_SCHED __builtin_amdgcn_sched_barrier(0)
    Unit cur, nxt; int ui = 0;
    if (!S.next(0, cur)) return;
    f32x4 acc[2][2][4][2];
#pragma unroll
    for (int a = 0; a < 2; ++a)
#pragma unroll
        for (int b = 0; b < 2; ++b)
#pragma unroll
            for (int m = 0; m < 4; ++m)
#pragma unroll
                for (int n = 0; n < 2; ++n) acc[a][b][m][n] = (f32x4){0.f, 0.f, 0.f, 0.f};
    bf16x8 At[4][2], B0[2][2], B1[2][2];
    const char* cA = (const char*)g.A + (size_t)cur.pm * tstepA; const char* cB = (const char*)g.Bt + (size_t)cur.pn * tstepB;
    S.a_ready(cur);
    if constexpr (SP2) {
        PG8_STAGE(PG8_SB(0, 0), cB, voffB); PG8_STAGE(PG8_SB(0, 1), cB + hstepB, voffB); PG8_STAGE(PG8_SA(0, 0), cA, voffA); PG8_STAGE(PG8_SA(0, 1), cA + hstepA, voffA);
        if (wr == 1) PG8_BAR;
        PG8_WAIT_V(2); PG8_BAR;
        PG8_STAGE(PG8_SB(1, 0), cB + kstep, voffB); PG8_STAGE(PG8_SA(1, 0), cA + kstep, voffA); PG8_STAGE(PG8_SB(1, 1), cB + hstepB + kstep, voffB);
        PG8_WAIT_V(6); PG8_BAR;
    } else {
        PG8_STAGE(PG8_SB(0, 0), cB, voffB); PG8_STAGE(PG8_SA(0, 0), cA, voffA); PG8_STAGE(PG8_SB(0, 1), cB + hstepB, voffB); PG8_STAGE(PG8_SA(0, 1), cA + hstepA, voffA);
        if (wr == 1) PG8_BAR;
        PG8_WAIT_V(4); PG8_BAR;
        PG8_STAGE(PG8_SB(1, 0), cB + kstep, voffB); PG8_STAGE(PG8_SA(1, 0), cA + kstep, voffA); PG8_STAGE(PG8_SB(1, 1), cB + hstepB + kstep, voffB);
        PG8_WAIT_V(6); PG8_BAR;
    }
    for (;;) {
        const bool has_next = S.next(ui + 1, nxt);
        const char* nA = has_next ? (const char*)g.A + (size_t)nxt.pm * tstepA : cA; const char* nB = has_next ? (const char*)g.Bt + (size_t)nxt.pn * tstepB : cB;
#pragma unroll 1
        for (int t = 0; t < nt; t += 2) {
            const bool last = (t == nt - 2);
            const char* a1 = cA + (size_t)(t + 1) * kstep;
            const char* a2 = last ? nA : cA + (size_t)(t + 2) * kstep; const char* b2 = last ? nB : cB + (size_t)(t + 2) * kstep;
            const char* a3 = a2 + kstep; const char* b3 = b2 + kstep;
            if (last && has_next) S.a_ready(nxt);
            if constexpr (SP2) {
            PG8_LDB(B0, 0, 0); PG8_LDB(B1, 0, 1); PG8_SCHED; PG8_LDA(At, 0, 0); PG8_STAGE(PG8_SA(1, 1), a1 + hstepA, voffA);
            PG8_WAIT_V(8); PG8_WAIT_L(0); PG8_BAR; PG8_MMA(0, 0, At, B0); PG8_MMA(0, 1, At, B1); PG8_BAR; PG8_SCHED;
            PG8_LDA(At, 0, 1); PG8_STAGE(PG8_SB(0, 0), b2, voffB); PG8_STAGE(PG8_SB(0, 1), b2 + hstepB, voffB); PG8_STAGE(PG8_SA(0, 0), a2, voffA);
            PG8_WAIT_V(8); PG8_WAIT_L(0); PG8_BAR; PG8_MMA(1, 0, At, B0); PG8_MMA(1, 1, At, B1); PG8_BAR; PG8_SCHED;
            PG8_LDB(B0, 1, 0); PG8_LDB(B1, 1, 1); PG8_SCHED; PG8_LDA(At, 1, 0); PG8_STAGE(PG8_SA(0, 1), a2 + hstepA, voffA);
            PG8_WAIT_V(8); PG8_WAIT_L(0); PG8_BAR; PG8_MMA(0, 0, At, B0); PG8_MMA(0, 1, At, B1); PG8_BAR; PG8_SCHED;
            PG8_LDA(At, 1, 1); PG8_STAGE(PG8_SB(1, 0), b3, voffB); PG8_STAGE(PG8_SB(1, 1), b3 + hstepB, voffB); PG8_STAGE(PG8_SA(1, 0), a3, voffA);
            PG8_WAIT_V(8); PG8_WAIT_L(0); PG8_BAR; PG8_MMA(1, 0, At, B0); PG8_MMA(1, 1, At, B1); PG8_BAR; PG8_SCHED;
            } else {
            PG8_LDB(B0, 0, 0); PG8_SCHED; PG8_LDA(At, 0, 0); PG8_STAGE(PG8_SA(1, 1), a1 + hstepA, voffA);
            PG8_WAIT_L(8); PG8_BAR; PG8_WAIT_L(0); PG8_MMA(0, 0, At, B0); PG8_BAR; PG8_SCHED;
            PG8_LDB(B1, 0, 1); PG8_STAGE(PG8_SB(0, 0), b2, voffB);
            PG8_BAR; PG8_WAIT_L(0); PG8_MMA(0, 1, At, B1); PG8_BAR;
            PG8_LDA(At, 0, 1); PG8_STAGE(PG8_SA(0, 0), a2, voffA);
            PG8_BAR; PG8_WAIT_L(0); PG8_MMA(1, 0, At, B0); PG8_BAR; PG8_SCHED;
            PG8_STAGE(PG8_SB(0, 1), b2 + hstepB, voffB);
            PG8_WAIT_V(6); PG8_BAR; PG8_MMA(1, 1, At, B1); PG8_BAR;
            PG8_LDB(B0, 1, 0); PG8_SCHED; PG8_LDA(At, 1, 0); PG8_STAGE(PG8_SA(0, 1), a2 + hstepA, voffA);
            PG8_WAIT_L(8); PG8_BAR; PG8_WAIT_L(0); PG8_MMA(0, 0, At, B0); PG8_BAR; PG8_SCHED;
            PG8_LDB(B1, 1, 1); PG8_STAGE(PG8_SB(1, 0), b3, voffB);
            PG8_BAR; PG8_WAIT_L(0); PG8_MMA(0, 1, At, B1); PG8_BAR;
            PG8_LDA(At, 1, 1); PG8_STAGE(PG8_SA(1, 0), a3, voffA);
            PG8_BAR; PG8_WAIT_L(0); PG8_MMA(1, 0, At, B0); PG8_BAR; PG8_SCHED;
            PG8_STAGE(PG8_SB(1, 1), b3 + hstepB, voffB);
            PG8_WAIT_V(6); PG8_BAR; PG8_MMA(1, 1, At, B1); PG8_BAR;
            }
        }
        if constexpr (ALIGN_EPI) { if (wr == 0) PG8_BAR; }
        if constexpr (!Epi::AFTER_DRAIN) { E(acc, cur, wr, wc, fr, fq); S.done(cur); }
        if (!has_next) break;
#pragma unroll
        for (int a = 0; a < 2; ++a)
#pragma unroll
            for (int b = 0; b < 2; ++b)
#pragma unroll
                for (int m = 0; m < 4; ++m)
#pragma unroll
                    for (int n = 0; n < 2; ++n) acc[a][b][m][n] = (f32x4){0.f, 0.f, 0.f, 0.f};
        cur = nxt; cA = nA; cB = nB; ++ui;
        if constexpr (ALIGN_EPI) { if (wr == 1) PG8_BAR; }
    }
    PG8_WAIT_V(0);
    if constexpr (!ALIGN_EPI) { if (wr == 0) PG8_BAR; }
    PG8_BAR;
    if constexpr (Epi::AFTER_DRAIN) { E.fused(acc, cur, wr, wc, fr, fq, lds, wid, lane); S.done(cur); }
#undef PG8_SA
#undef PG8_SB
#undef PG8_STAGE
#undef PG8_LDA
#undef PG8_LDB
#undef PG8_MMA
#undef PG8_WAIT_V
#undef PG8_WAIT_L
#undef PG8_BAR
#undef PG8_SCHED
}
}
#define XB_TMO      128
#define XB_XCNT(j)  (256  + 64 * (j))
#define XB_XSUB(j)  (1280 + 64 * (j))
#define XB_XGEN(j)  (2304 + 64 * (j))
#define XB_TOP      3328
#define XB_TOPGEN   3392
#define XCD_BAR_WORDS 3456
#define XB_SPIN_CAP (1u << 22)

__device__ __forceinline__ unsigned xb_ld(unsigned* p)              { return __hip_atomic_load(p, __ATOMIC_RELAXED, __HIP_MEMORY_SCOPE_AGENT); }
__device__ __forceinline__ unsigned xb_add(unsigned* p, unsigned v) { return __hip_atomic_fetch_add(p, v, __ATOMIC_RELAXED, __HIP_MEMORY_SCOPE_AGENT); }
__device__ __forceinline__ unsigned xb_xcc_id() { return (unsigned)__builtin_amdgcn_s_getreg((3 << 11) | 20) & 0xFu; }
#define XB_SPIN(cond, bar) do { unsigned _sp = 0; while (cond) { __builtin_amdgcn_s_sleep(1); \
    if ((++_sp & 255u) == 0u) { if (xb_ld(&(bar)[XB_TMO])) break; if (_sp > XB_SPIN_CAP) { atomicAdd(&(bar)[XB_TMO], 1u); break; } } } } while (0)

struct XcdBarrier {
    unsigned* bar; unsigned x; unsigned wv;
    volatile LAS unsigned* st;
};

__device__ __forceinline__ XcdBarrier xcd_barrier_post(unsigned* bar, volatile LAS unsigned* st) {
    XcdBarrier b; b.bar = bar; b.x = xb_xcc_id(); b.st = st; b.wv = 0u;
    if (threadIdx.x == 0) (void)xb_add(&bar[XB_XCNT(b.x)], 1u);
    return b;
}
__device__ __forceinline__ void xcd_barrier_complete(unsigned* bar, unsigned x, unsigned& nloc, unsigned& nx) {
    const unsigned G = gridDim.x * gridDim.y * gridDim.z;
    unsigned sum, cnt, mine, sp = 0u;
    for (;;) {
        sum = 0u; cnt = 0u; mine = 0u;
#pragma unroll
        for (unsigned j = 0; j < 16; ++j) { const unsigned c = xb_ld(&bar[XB_XCNT(j)]); sum += c; cnt += (c > 0u) ? 1u : 0u; mine = (j == x) ? c : mine; }
        if (sum == G) break;
        __builtin_amdgcn_s_sleep(1);
        if ((++sp & 255u) == 0u) { if (xb_ld(&bar[XB_TMO])) break; if (sp > XB_SPIN_CAP) { atomicAdd(&bar[XB_TMO], 1u); break; } }
    }
    nloc = mine > 0u ? mine : 1u; nx = cnt > 0u ? cnt : 1u;
}

__device__ __forceinline__ void xcd_barrier(const XcdBarrier& b) {
    asm volatile("s_waitcnt vmcnt(0)" ::: "memory");
    __syncthreads();
    if (b.wv == 0u && lane_id() == 0) {
        unsigned* bar = b.bar;
        __builtin_amdgcn_s_waitcnt(0);
        unsigned nloc = b.st[0], nx = b.st[1];
        if (nloc == 0u) { xcd_barrier_complete(bar, b.x, nloc, nx); b.st[0] = nloc; b.st[1] = nx; }
        const unsigned old = xb_add(&bar[XB_XSUB(b.x)], 1u);
        const unsigned gen = old / nloc;
        if (old + 1u == (gen + 1u) * nloc) {
            __builtin_amdgcn_fence(__ATOMIC_RELEASE, "agent");
            asm volatile("s_waitcnt vmcnt(0)" ::: "memory");
            const unsigned og = xb_add(&bar[XB_TOP], 1u);
            const unsigned tg = og / nx;
            if (og + 1u == (tg + 1u) * nx) xb_add(&bar[XB_TOPGEN], 1u);
            else XB_SPIN(xb_ld(&bar[XB_TOPGEN]) == tg, bar);
            __builtin_amdgcn_fence(__ATOMIC_ACQUIRE, "agent");
            xb_add(&bar[XB_XGEN(b.x)], 1u);
            asm volatile("s_waitcnt vmcnt(0)" ::: "memory");
        } else {
            XB_SPIN(xb_ld(&bar[XB_XGEN(b.x)]) == gen, bar);
            __builtin_amdgcn_fence(__ATOMIC_ACQUIRE, "agent");
            asm volatile("s_waitcnt vmcnt(0)" ::: "memory");
        }
    }
    __syncthreads();
}

namespace pg8 {
struct EpiQRope {
    static constexpr bool PERM = true, AFTER_DRAIN = false;
    bf16_t* O; const float* cosT; const float* sinT;
    __device__ __forceinline__ void operator()(const f32x4 (&acc)[2][2][4][2], const Unit& u, int wr, int wc, int fr, int fq) const {
        const int row0 = u.pm * BM + wr * 64 + fr, colb = u.pn * BM + wc * 32 + 8 * fq;
#pragma unroll
        for (int ai = 0; ai < 2; ++ai)
#pragma unroll
            for (int m = 0; m < 4; ++m) {
                const int row = row0 + ai * HALF + m * 16; const int b = row / RPB, t = row - b * RPB - CTX;
                bf16_t* rowp = O + (size_t)row * 1536;
#pragma unroll
                for (int bj = 0; bj < 2; ++bj) {
                    const int col = colb + bj * HALF; const int hh = col / 192, jj = col - hh * 192;
                    f32x4 v0 = acc[ai][bj][m][0], v1 = acc[ai][bj][m][1];
                    if (jj >= 128 && t >= 0) {
                        const int i0 = (jj - 128) >> 1;
                        const f32x4 c4 = *(const f32x4*)(cosT + (size_t)t * 32 + i0), s4 = *(const f32x4*)(sinT + (size_t)t * 32 + i0);
                        f32x4 w0, w1;
                        w0.x = v0.x * c4.x - v0.y * s4.x; w0.y = v0.x * s4.x + v0.y * c4.x;
                        w0.z = v0.z * c4.y - v0.w * s4.y; w0.w = v0.z * s4.y + v0.w * c4.y;
                        w1.x = v1.x * c4.z - v1.y * s4.z; w1.y = v1.x * s4.z + v1.y * c4.z;
                        w1.z = v1.z * c4.w - v1.w * s4.w; w1.w = v1.z * s4.w + v1.w * c4.w;
                        v0 = w0; v1 = w1;
                    }
                    u32x4 w; w.x = cvt_pk_bf16(v0[0], v0[1]); w.y = cvt_pk_bf16(v0[2], v0[3]); w.z = cvt_pk_bf16(v1[0], v1[1]); w.w = cvt_pk_bf16(v1[2], v1[3]);
                    *(u32x4*)(rowp + col) = w;
                }
            }
    }
};
struct EpiResid {
    static constexpr bool PERM = false, AFTER_DRAIN = false;
    float* X; const float* gate;
    __device__ __forceinline__ void operator()(const f32x4 (&acc)[2][2][4][2], const Unit& u, int wr, int wc, int fr, int fq) const {
        const int row0 = u.pm * BM + wr * 64 + fr, col0 = u.pn * BM + wc * 32 + 4 * fq;
#pragma unroll
        for (int ai = 0; ai < 2; ++ai)
#pragma unroll
            for (int m = 0; m < 4; ++m) {
                const int row = row0 + ai * HALF + m * 16; const float* gp = gate + (size_t)modrow(row) * NMOD + col0; float* xp = X + (size_t)row * DM + col0;
#pragma unroll
                for (int bj = 0; bj < 2; ++bj)
#pragma unroll
                    for (int n = 0; n < 2; ++n) { const int c = bj * HALF + n * 16; const f32x4 g4 = *(const f32x4*)(gp + c); f32x4 x4 = *(const f32x4*)(xp + c); x4 += g4 * acc[ai][bj][m][n]; *(f32x4*)(xp + c) = x4; }
            }
    }
};
}

struct Args { const float* in[22]; float* out; unsigned char* ws; int ph_lo, ph_hi; };
struct Ptrs {
    LAS unsigned char* L;
    __device__ __forceinline__ unsigned long long raw(int i) const { const unsigned long long v = *(volatile LAS unsigned long long*)(L + LDS_CTL_OFF + 64 + 8 * i);
        const unsigned lo = __builtin_amdgcn_readfirstlane((unsigned)v), hi = __builtin_amdgcn_readfirstlane((unsigned)(v >> 32)); return ((unsigned long long)hi << 32) | lo; }
    __device__ __forceinline__ const float* in(int i) const { return (const float*)(GAS const float*)raw(i); }
    __device__ __forceinline__ float* out() const { return (float*)(GAS float*)raw(22); }
    __device__ __forceinline__ unsigned char* ws() const { return (unsigned char*)(GAS unsigned char*)raw(23); }
};

__device__ __forceinline__ void row_load_f32(const float* src, int lane, float (&v)[4][8]) {
#pragma unroll
    for (int i = 0; i < 4; ++i) { const f32x4 a = *(const f32x4*)(src + (lane + 64 * i) * 8), b = *(const f32x4*)(src + (lane + 64 * i) * 8 + 4);
        v[i][0] = a.x; v[i][1] = a.y; v[i][2] = a.z; v[i][3] = a.w; v[i][4] = b.x; v[i][5] = b.y; v[i][6] = b.z; v[i][7] = b.w; }
}
__device__ __forceinline__ void row_store_f32(float* dst, int lane, const float (&v)[4][8]) {
#pragma unroll
    for (int i = 0; i < 4; ++i) { *(f32x4*)(dst + (lane + 64 * i) * 8) = (f32x4){v[i][0], v[i][1], v[i][2], v[i][3]}; *(f32x4*)(dst + (lane + 64 * i) * 8 + 4) = (f32x4){v[i][4], v[i][5], v[i][6], v[i][7]}; }
}
__device__ __forceinline__ float row_rstd(const float (&v)[4][8]) {
    float ss = 0.f;
#pragma unroll
    for (int i = 0; i < 4; ++i)
#pragma unroll
        for (int j = 0; j < 8; ++j) ss += v[i][j] * v[i][j];
    ss = wave_sum(ss);
    return 1.0f / sqrtf(ss * (1.0f / DM) + EPS);
}
__device__ __forceinline__ void norm_mod_store(const float (&v)[4][8], float rstd, const float* g, const float* sh, const float* sc, bf16_t* hrow, int lane) {
#pragma unroll
    for (int i = 0; i < 4; ++i) { const int col = (lane + 64 * i) * 8; float gg[8], ss[8], cc[8];
        *(f32x4*)&gg[0] = *(const f32x4*)(g + col); *(f32x4*)&gg[4] = *(const f32x4*)(g + col + 4);
        *(f32x4*)&ss[0] = *(const f32x4*)(sh + col); *(f32x4*)&ss[4] = *(const f32x4*)(sh + col + 4);
        *(f32x4*)&cc[0] = *(const f32x4*)(sc + col); *(f32x4*)&cc[4] = *(const f32x4*)(sc + col + 4);
        float y[8];
#pragma unroll
        for (int j = 0; j < 8; ++j) y[j] = (v[i][j] * rstd * gg[j]) * (1.f + cc[j]) + ss[j];
        u32x4 o; o.x = cvt_pk(y[0], y[1]); o.y = cvt_pk(y[2], y[3]); o.z = cvt_pk(y[4], y[5]); o.w = cvt_pk(y[6], y[7]);
        *(u32x4*)(hrow + col) = o; }
}

template <class RM>
__device__ __forceinline__ void transpose_item(const float* W, int K, int N, int item, LAS float* scr, int lane, const RM& rm) {
    const int nblk = N / 32, kb = item / nblk, nb = item - kb * nblk, k0 = 64 * kb, n0 = 32 * nb;
#pragma unroll 8
    for (int i = 0; i < 32; ++i) { const int kk = 2 * i + (lane >> 5); scr[kk * 33 + (lane & 31)] = W[(size_t)(k0 + kk) * N + n0 + (lane & 31)]; }
    LDS_WAIT(); asm volatile("" ::: "memory");
    const int c = lane & 7;
#pragma unroll
    for (int j = 0; j < 4; ++j) { const int n = (lane >> 3) + 8 * j; const LAS float* s = scr + (8 * c) * 33 + n;
        u32x4 o; o.x = cvt_pk(s[0], s[33]); o.y = cvt_pk(s[66], s[99]); o.z = cvt_pk(s[132], s[165]); o.w = cvt_pk(s[198], s[231]);
        *(u32x4*)(rm(n0 + n) + k0 + 8 * c) = o; }
    LDS_WAIT(); asm volatile("" ::: "memory");
}

__device__ __forceinline__ void p0a(const Ptrs& A, LAS unsigned char* L, int wave, int bid, int G) { asm volatile("" : "+s"(wave)); const int lane = lane_id(); const int tid = wave * 64 + lane; (void)tid;
    unsigned char* ws = A.ws(); LAUNDER_G(ws);
    {
        LAS float* sl = (LAS float*)L;
        LAS float* red = (LAS float*)(L + 40960);
        for (int i = tid; i < 5 * DM; i += NTHR) { const int r = i / DM, k = i - r * DM; const float c = r < 4 ? A.in(1)[r * DM + k] : A.in(3)[k]; sl[i] = c / (1.f + expf(-c)); }
        __syncthreads();
        float* MOD = (float*)(ws + WS_MOD);
        for (int u = bid; u < DEPTH * 192; u += G) {
            const int l = u / 192, nt = u - l * 192, cg = tid & 15, kg = tid >> 4;
            const float* wp = A.in(4) + ((size_t)l * DM + kg * 64) * NMOD + nt * 64 + cg * 4;
            f32x4 acc[5];
#pragma unroll
            for (int r = 0; r < 5; ++r) acc[r] = (f32x4){0.f, 0.f, 0.f, 0.f};
#pragma unroll 8
            for (int kk = 0; kk < 64; ++kk) { const f32x4 w = *(const f32x4*)(wp + (size_t)kk * NMOD); const int k = kg * 64 + kk;
#pragma unroll
                for (int r = 0; r < 5; ++r) acc[r] += w * sl[r * DM + k]; }
#pragma unroll
            for (int r = 0; r < 5; ++r) *(LAS f32x4*)(red + (kg * 5 + r) * 64 + cg * 4) = acc[r];
            __syncthreads();
            if (tid < 320) { const int r = tid >> 6, col = tid & 63; float s = 0.f;
                for (int g = 0; g < 32; ++g) s += red[(g * 5 + r) * 64 + col];
                MOD[((size_t)l * 5 + r) * NMOD + nt * 64 + col] = s + A.in(5)[l * NMOD + nt * 64 + col]; }
            __syncthreads();
        }
    }
    {
        LAS float* scr = (LAS float*)(L + wave * 16384);
        const int gw = bid * NWAVES + wave, NGW = G * NWAVES;
        constexpr int I_IN = 32 * 123, I_UQ = 8 * 48, I_UKV = 4 * 64, I_SQ = 32 * 64, I_L = I_IN + I_UQ + I_UKV + 2 * I_SQ;
        for (int it = gw; it < DEPTH * I_L; it += NGW) {
            const int l = it / I_L; int r = it - l * I_L;
            if (r < I_IN) {
                bf16_t* mainp = (bf16_t*)(ws + WS_WIN) + (size_t)l * PW * DM; bf16_t* sidep = (bf16_t*)(ws + WS_WSIDE) + (size_t)l * SIDEW * DM;
                transpose_item(A.in(8) + (size_t)l * DM * 3936, DM, 3936, r, scr, lane, [=](int n) -> bf16_t* {
                    return n < 768 ? mainp + (size_t)n * DM : n < 832 ? sidep + (size_t)(n - 768) * DM : n < 3904 ? mainp + (size_t)(n - 64) * DM : sidep + (size_t)(64 + n - 3904) * DM; });
                continue; }
            r -= I_IN;
            if (r < I_UQ) {
                bf16_t* dst = (bf16_t*)(ws + WS_WUQ) + (size_t)l * 1536 * 512;
                transpose_item(A.in(11) + (size_t)l * 512 * 1536, 512, 1536, r, scr, lane, [=](int n) -> bf16_t* {
                    const int hh = n / 192, j = n - hh * 192; const int jn = j < 128 ? j : (j < 160 ? 128 + 2 * (j - 128) : 128 + 2 * (j - 160) + 1); return dst + (size_t)(hh * 192 + jn) * 512; });
                continue; }
            r -= I_UQ;
            if (r < I_UKV) { bf16_t* dst = (bf16_t*)(ws + WS_WUKV) + (size_t)l * 2048 * 256;
                transpose_item(A.in(12) + (size_t)l * 256 * 2048, 256, 2048, r, scr, lane, [=](int n) -> bf16_t* { return dst + (size_t)n * 256; }); continue; }
            r -= I_UKV;
            if (r < I_SQ) { bf16_t* dst = (bf16_t*)(ws + WS_WOUT) + (size_t)l * DM * DM;
                transpose_item(A.in(16) + (size_t)l * DM * DM, DM, DM, r, scr, lane, [=](int n) -> bf16_t* { return dst + (size_t)n * DM; }); continue; }
            r -= I_SQ;
            { bf16_t* dst = (bf16_t*)(ws + WS_WQRY) + (size_t)l * DM * DM;
                transpose_item(A.in(17) + (size_t)l * DM * DM, DM, DM, r, scr, lane, [=](int n) -> bf16_t* { return dst + (size_t)n * DM; }); }
        }
    }
    {
        const size_t gt = (size_t)bid * NTHR + tid, NT = (size_t)G * NTHR;
        {
            const int gw = bid * NWAVES + wave, NGW = G * NWAVES;
            for (int rr = gw; rr < 2 * DEPTH * NEXP; rr += NGW) { const bool isu = rr < DEPTH * NEXP; const int row = isu ? rr : rr - DEPTH * NEXP;
                const float* src = (isu ? A.in(19) : A.in(20)) + (size_t)row * DM;
                f32x4 x[8]; float ss = 0.f;
#pragma unroll
                for (int i = 0; i < 8; ++i) { x[i] = *(const f32x4*)(src + (lane + 64 * i) * 4); ss += (x[i].x * x[i].x + x[i].y * x[i].y) + (x[i].z * x[i].z + x[i].w * x[i].w); }
                ss = wave_sum(ss); const float rms = sqrtf(ss * (1.0f / DM));
                u32x4 p; float sc;
                if (isu) { sc = rms > 0.f ? rms * 0.5f : 1.0f; const float inv = 1.0f / sc;
#define Q4C(v) fminf(fmaxf((v) * inv, -6.0f), 6.0f)
                    LAS unsigned short* xs = (LAS unsigned short*)(L + wave * 16384);
#pragma unroll
                    for (int i = 0; i < 8; ++i) { unsigned d = 0u; d = __builtin_amdgcn_cvt_scalef32_pk_fp4_f32(d, Q4C(x[i].x), Q4C(x[i].y), 1.0f, 0); d = __builtin_amdgcn_cvt_scalef32_pk_fp4_f32(d, Q4C(x[i].z), Q4C(x[i].w), 1.0f, 1);
                        xs[lane + 64 * i] = (unsigned short)d; }
#undef Q4C
                    p = *(const LAS u32x4*)(L + wave * 16384 + lane * 16);
                } else { sc = rms > 0.f ? rms * 0.5f : 1.0f; const float inv = 1.0f / sc;
#pragma unroll
                    for (int w = 0; w < 4; ++w) { const f32x4 a = x[2 * w], c = x[2 * w + 1]; unsigned d = 0u;
#define Q4C(v) fminf(fmaxf((v) * inv, -6.0f), 6.0f)
                        d = __builtin_amdgcn_cvt_scalef32_pk_fp4_f32(d, Q4C(a.x), Q4C(a.y), 1.0f, 0); d = __builtin_amdgcn_cvt_scalef32_pk_fp4_f32(d, Q4C(a.z), Q4C(a.w), 1.0f, 1);
                        d = __builtin_amdgcn_cvt_scalef32_pk_fp4_f32(d, Q4C(c.x), Q4C(c.y), 1.0f, 2); d = __builtin_amdgcn_cvt_scalef32_pk_fp4_f32(d, Q4C(c.z), Q4C(c.w), 1.0f, 3);
#undef Q4C
                        p[w] = d; } }
                unsigned char* dst = ws + (isu ? WS_EU : WS_EV) + (size_t)row * EROW;
                *(u32x4*)(dst + lane * 16) = p;
                if (lane == 0) ((float*)(ws + (isu ? WS_SU : WS_SV)))[row] = sc; } }
        const size_t s8 = (size_t)DEPTH * 2 * 8 * 128 * 128 / 8;
        for (size_t i = gt; i < s8; i += NT) { const float* src = A.in(18) + i * 8;
            const f32x4 a = *(const f32x4*)src, b = *(const f32x4*)(src + 4); u32x4 o; o.x = cvt_pk(a.x, a.y); o.y = cvt_pk(a.z, a.w); o.z = cvt_pk(b.x, b.y); o.w = cvt_pk(b.z, b.w);
            *(u32x4*)((bf16_t*)(ws + WS_SUBK) + i * 8) = o; }
        float* cosT = (float*)(ws + WS_ROPE); float* sinT = cosT + SEQ * 32;
        for (size_t i = gt; i < (size_t)SEQ * 32; i += NT) { const int t = (int)(i >> 5), a = (int)(i & 31), m = a & 15; const int pos = a < 16 ? (t >> 6) : (t & 63);
            const float inv = 1.0f / powf(10000.0f, (float)(2 * m) / 32.0f); const float ang = (float)pos * inv; cosT[i] = cosf(ang); sinT[i] = sinf(ang); }
    }
}

__device__ __forceinline__ void p0b(const Ptrs& A, int wave, int bid, int G) { asm volatile("" : "+s"(wave)); const int lane = lane_id();
    unsigned char* ws = A.ws(); LAUNDER_G(ws); const int gw = bid + G * wave, NGW = G * NWAVES;
    const float* MOD = (const float*)(ws + WS_MOD);
    for (int r = gw; r < NTOK; r += NGW) {
        const int b = r / RPB, j = r - b * RPB; const float* src = j < CTX ? A.in(2) + ((size_t)b * CTX + j) * DM : A.in(0) + ((size_t)b * SEQ + (j - CTX)) * DM;
        float v[4][8]; row_load_f32(src, lane, v); row_store_f32((float*)(ws + WS_XRES) + (size_t)r * DM, lane, v);
        const float rstd = row_rstd(v); const float* mp = MOD + (size_t)(j < CTX ? 4 : b) * NMOD;
        norm_mod_store(v, rstd, A.in(6), mp, mp + DM, (bf16_t*)(ws + WS_H) + (size_t)r * DM, lane);
    }
}

__device__ __forceinline__ void side_gemm(const Ptrs& A, LAS unsigned char* L, int l, int wave, int bid, int G) { asm volatile("" : "+s"(wave)); const int lane = lane_id(); const int tid = wave * 64 + lane;
    unsigned char* ws = A.ws(); LAUNDER_G(ws); const bf16_t* H = (const bf16_t*)(ws + WS_H); const bf16_t* W = (const bf16_t*)(ws + WS_WSIDE) + (size_t)l * SIDEW * DM; float* SIDE = (float*)(ws + WS_SIDE);
    LAS float* red = (LAS float*)L;
    for (int u = bid; u < NTOK / 32; u += G) {
        const int rbase = u * 32;
        f32x4 acc[2][6];
#pragma unroll
        for (int rb = 0; rb < 2; ++rb)
#pragma unroll
            for (int cb = 0; cb < 6; ++cb) acc[rb][cb] = (f32x4){0.f, 0.f, 0.f, 0.f};
        const bf16_t* ap = H + (size_t)(rbase + (lane & 15)) * DM + wave * 256 + 8 * (lane >> 4);
        const bf16_t* bp = W + (size_t)(lane & 15) * DM + wave * 256 + 8 * (lane >> 4);
#pragma unroll
        for (int kh = 0; kh < 2; ++kh) {
            bf16x8 a[2][4], bq[6][4];
#pragma unroll
            for (int ks = 0; ks < 4; ++ks) {
#pragma unroll
                for (int rb = 0; rb < 2; ++rb) a[rb][ks] = *(const bf16x8*)(ap + (size_t)rb * 16 * DM + (kh * 4 + ks) * 32);
#pragma unroll
                for (int cb = 0; cb < 6; ++cb) bq[cb][ks] = *(const bf16x8*)(bp + (size_t)cb * 16 * DM + (kh * 4 + ks) * 32); }
#pragma unroll
            for (int ks = 0; ks < 4; ++ks)
#pragma unroll
                for (int rb = 0; rb < 2; ++rb)
#pragma unroll
                    for (int cb = 0; cb < 6; ++cb) acc[rb][cb] = __builtin_amdgcn_mfma_f32_16x16x32_bf16(a[rb][ks], bq[cb][ks], acc[rb][cb], 0, 0, 0);
        }
#pragma unroll
        for (int rb = 0; rb < 2; ++rb)
#pragma unroll
            for (int cb = 0; cb < 6; ++cb)
#pragma unroll
                for (int rg = 0; rg < 4; ++rg) red[(wave * 32 + rb * 16 + (lane >> 4) * 4 + rg) * 96 + cb * 16 + (lane & 15)] = acc[rb][cb][rg];
        __syncthreads();
        for (int i = tid; i < 32 * 96 / 4; i += NTHR) { f32x4 s = *(const LAS f32x4*)(red + i * 4);
#pragma unroll
            for (int w = 1; w < 8; ++w) s += *(const LAS f32x4*)(red + w * 32 * 96 + i * 4);
            *(f32x4*)(SIDE + (size_t)rbase * SIDEW + i * 4) = s; }
        __syncthreads();
    }
}

constexpr int CG_A = 0, CG_B = 16384, CG_BUF = 49152;
template <class F>
__device__ __forceinline__ void ctx_gemm(LAS unsigned char* L, const bf16_t* Ab, int lda, const bf16_t* Wt, int ldb, int N, int K, int wave, int bid, int G, const F& f) { asm volatile("" : "+s"(wave)); const int lane = lane_id(); const int tid = wave * 64 + lane;
    const int r32 = lane & 31, hi = lane >> 5, wr = wave >> 2, wc = wave & 3, ncu = N / 128, nch = K / 128;
    for (int u = bid; u < 16 * ncu; u += G) {
        const int mt = u / ncu, nt = u - mt * ncu; const int m0 = mt * 64, row0 = (m0 >> 8) * RPB + (m0 & 255), col0 = nt * 128;
        const int cch = tid & 15, ra = tid >> 4;
        const bf16_t* ga = Ab + (size_t)(row0 + ra) * lda + cch * 8; const bf16_t* gb = Wt + (size_t)(col0 + ra) * ldb + cch * 8;
        u32x4 sa[2], sb[4];
#define CG_LOAD(k0) do { sa[0] = *(const u32x4*)(ga + (k0)); sa[1] = *(const u32x4*)(ga + (size_t)32 * lda + (k0)); \
        _Pragma("unroll") for (int i = 0; i < 4; ++i) sb[i] = *(const u32x4*)(gb + (size_t)(32 * i) * ldb + (k0)); } while (0)
#define CG_WRITE(buf) do { _Pragma("unroll") for (int i = 0; i < 2; ++i) { const int row = ra + 32 * i; *(LAS u32x4*)(L + (buf) * CG_BUF + CG_A + row * 256 + ((cch ^ (row & 15)) << 4)) = sa[i]; } \
        _Pragma("unroll") for (int i = 0; i < 4; ++i) { const int row = ra + 32 * i; *(LAS u32x4*)(L + (buf) * CG_BUF + CG_B + row * 256 + ((cch ^ (row & 15)) << 4)) = sb[i]; } } while (0)
        f32x16 acc;
#pragma unroll
        for (int r = 0; r < 16; ++r) acc[r] = 0.f;
        CG_LOAD(0); CG_WRITE(0);
        __syncthreads();
#pragma unroll 1
        for (int ch = 0; ch < nch; ++ch) { const int buf = ch & 1;
            if (ch + 1 < nch) CG_LOAD((ch + 1) * 128);
#pragma unroll
            for (int ks = 0; ks < 8; ++ks) { const int cc = ks * 2 + hi;
                const bf16x8 a = *(const LAS bf16x8*)(L + buf * CG_BUF + CG_A + (32 * wr + r32) * 256 + ((cc ^ (r32 & 15)) << 4)), bq = *(const LAS bf16x8*)(L + buf * CG_BUF + CG_B + (32 * wc + r32) * 256 + ((cc ^ (r32 & 15)) << 4));
                acc = __builtin_amdgcn_mfma_f32_32x32x16_bf16(a, bq, acc, 0, 0, 0); }
            if (ch + 1 < nch) CG_WRITE(buf ^ 1);
            __syncthreads(); }
#undef CG_LOAD
#undef CG_WRITE
#pragma unroll
        for (int r = 0; r < 16; ++r) f(row0 + 32 * wr + crow(r, hi), col0 + 32 * wc + r32, acc[r]);
    }
}

__device__ __forceinline__ void thin_rows(const Ptrs& A, int l, int wave, int bid, int G) { asm volatile("" : "+s"(wave)); const int lane = lane_id();
    unsigned char* ws = A.ws(); LAUNDER_G(ws); const int nx5 = (NGU % G) * 2 < G ? NGU % G : 0;
    if (bid < nx5) return;
    const int gw = (bid - nx5) + (G - nx5) * wave, NGW = (G - nx5) * NWAVES;
    bf16_t* P = (bf16_t*)(ws + WS_P); const float* SIDE = (const float*)(ws + WS_SIDE); bf16_t* KR = (bf16_t*)(ws + WS_KR);
    const float* cosT = (const float*)(ws + WS_ROPE); const float* sinT = cosT + SEQ * 32;
    const float* gq = A.in(9) + l * 512; const float* gkv = A.in(10) + l * 256;
    for (int r = gw; r < NTOK; r += NGW) {
        bf16_t* pr = P + (size_t)r * PW;
        { const u32x4 w = *(const u32x4*)(pr + P_CQ + lane * 8); float x[8] = {bflo(w.x), bfhi(w.x), bflo(w.y), bfhi(w.y), bflo(w.z), bfhi(w.z), bflo(w.w), bfhi(w.w)};
          float ss = 0.f;
#pragma unroll
          for (int j = 0; j < 8; ++j) ss += x[j] * x[j];
          ss = wave_sum(ss); const float rstd = 1.0f / sqrtf(ss * (1.0f / 512.f) + EPS);
          const f32x4 g0 = *(const f32x4*)(gq + lane * 8), g1 = *(const f32x4*)(gq + lane * 8 + 4);
          u32x4 o; o.x = cvt_pk(x[0] * rstd * g0.x, x[1] * rstd * g0.y); o.y = cvt_pk(x[2] * rstd * g0.z, x[3] * rstd * g0.w); o.z = cvt_pk(x[4] * rstd * g1.x, x[5] * rstd * g1.y); o.w = cvt_pk(x[6] * rstd * g1.z, x[7] * rstd * g1.w);
          *(u32x4*)(pr + P_CQ + lane * 8) = o; }
        { const u32x2 w = *(const u32x2*)(pr + P_CKV + lane * 4); float x[4] = {bflo(w.x), bfhi(w.x), bflo(w.y), bfhi(w.y)};
          float ss = x[0] * x[0] + x[1] * x[1] + x[2] * x[2] + x[3] * x[3];
          ss = wave_sum(ss); const float rstd = 1.0f / sqrtf(ss * (1.0f / 256.f) + EPS);
          const f32x4 g0 = *(const f32x4*)(gkv + lane * 4);
          u32x2 o; o.x = cvt_pk(x[0] * rstd * g0.x, x[1] * rstd * g0.y); o.y = cvt_pk(x[2] * rstd * g0.z, x[3] * rstd * g0.w);
          *(u32x2*)(pr + P_CKV + lane * 4) = o; }
        if (lane < 32) { const float x1 = SIDE[(size_t)r * SIDEW + lane], x2 = SIDE[(size_t)r * SIDEW + 32 + lane];
          const int b = r / RPB, t = r - b * RPB - CTX; float y1 = x1, y2 = x2;
          if (t >= 0) { const float cs = cosT[(size_t)t * 32 + lane], sn = sinT[(size_t)t * 32 + lane]; y1 = x1 * cs - x2 * sn; y2 = x1 * sn + x2 * cs; }
          *(unsigned*)(KR + (size_t)r * 64 + 2 * lane) = cvt_pk(y1, y2); }
    }
}

constexpr int G1_LR = 0, G1_WG = 8192, G1_BG = 24576, G1_GT = 25600, G1_QD = 29696, G1_KD = G1_QD + 64 * 272, G1_KET = G1_KD + 64 * 272, G1_VT = G1_KET + 128 * 144, G1_AS = G1_VT + 256 * 144, G1_END = G1_AS + 64 * 144;
constexpr int G1_RAWV = G1_QD;
constexpr int G1_RAW = G1_END;
static_assert(G1_RAWV + 32768 <= G1_VT && G1_RAW + 32768 <= LDS_CTL_OFF, "G1 LDS map");

__device__ __forceinline__ void g1_mma(LAS unsigned char* L, f32x16& Aacc, const bf16x8 (&av)[4], bf16_t* dsp, int lane, int wave) {
    const int r32 = lane & 31, hi = lane >> 5;
    if (wave < 4) { const int mb = wave >> 1, nb = wave & 1;
#pragma unroll
        for (int r = 0; r < 16; ++r) Aacc[r] = 0.f;
#pragma unroll
        for (int ks = 0; ks < 8; ++ks) { const bf16x8 a = *(const LAS bf16x8*)(L + G1_QD + (32 * mb + r32) * 272 + ks * 32 + hi * 16), bq = *(const LAS bf16x8*)(L + G1_KD + (32 * nb + r32) * 272 + ks * 32 + hi * 16);
            Aacc = __builtin_amdgcn_mfma_f32_32x32x16_bf16(a, bq, Aacc, 0, 0, 0); } }
#pragma unroll
    for (int db = 0; db < 4; ++db) { f32x16 acc;
#pragma unroll
        for (int r = 0; r < 16; ++r) acc[r] = 0.f;
#pragma unroll
        for (int ks = 0; ks < 4; ++ks) { const bf16x8 bk = *(const LAS bf16x8*)(L + G1_KET + (32 * db + r32) * 144 + ks * 32 + hi * 16); acc = __builtin_amdgcn_mfma_f32_32x32x16_bf16(av[ks], bk, acc, 0, 0, 0); }
        LAS unsigned char* slab = L + G1_RAW + wave * 4096;
#pragma unroll
        for (int r = 0; r < 16; r += 2) {
            const float x0 = acc[r], x1 = acc[r + 1];
            const float n0 = __builtin_bit_cast(float, __builtin_amdgcn_mov_dpp(__builtin_bit_cast(int, x0), 0xB1, 0xF, 0xF, true)), n1 = __builtin_bit_cast(float, __builtin_amdgcn_mov_dpp(__builtin_bit_cast(int, x1), 0xB1, 0xF, 0xF, true));
            const bool odd = r32 & 1;
            const unsigned pk = odd ? cvt_pk_safe(n1, x1) : cvt_pk_safe(x0, n0);
            *(LAS unsigned*)(slab + crow(r + (odd ? 1 : 0), hi) * 128 + (db & 1) * 64 + (r32 >> 1) * 4) = pk; }
        if (db & 1) {
#pragma unroll
            for (int i = 0; i < 4; ++i) { const int idx = lane + 64 * i, row = idx >> 3, ch = idx & 7;
                *(u32x4*)(dsp + (size_t)(32 * wave + row) * 128 + (db >> 1) * 64 + ch * 8) = *(const LAS u32x4*)(slab + row * 128 + ch * 16); } } }
}

template <int DIR>
__device__ __forceinline__ void g1_dir(const Ptrs& A, unsigned char* ws, LAS unsigned char* L, int l, int u, int bh, int c, int h, int r0, f32x16& Aacc, const bf16x8 (&av)[4], const float (&qv)[16], const float (&kv)[16], int tid, int lane, int wave) {
    LAS float* lr = (LAS float*)(L + G1_LR); LAS float* wg = (LAS float*)(L + G1_WG); LAS float* bg = (LAS float*)(L + G1_BG); LAS float* gt = (LAS float*)(L + G1_GT);
    const int d = tid & 127, pg = tid >> 7;
    float cum[16];
    {
        float wv[16];
#pragma unroll
        for (int rr = 0; rr < 16; ++rr) wv[rr] = wg[(DIR * 16 + rr) * 128 + d];
        const float bias = bg[DIR * 128 + d];
#pragma unroll
        for (int i = 0; i < 16; ++i) { const LAS float* lp = lr + (DIR * 64 + pg * 16 + i) * 16; float z = bias;
#pragma unroll
            for (int rr = 0; rr < 16; ++rr) z += lp[rr] * wv[rr];
            cum[i] = -(fmaxf(-z, 0.f) + __logf(1.0f + __expf(-fabsf(z)))) * (1.0f / 16.0f); }
    }
    if (DIR == 0) {
#pragma unroll
        for (int i = 1; i < 16; ++i) cum[i] += cum[i - 1];
        gt[(DIR * 4 + pg) * 128 + d] = cum[15];
    } else {
#pragma unroll
        for (int i = 14; i >= 0; --i) cum[i] += cum[i + 1];
        gt[(DIR * 4 + pg) * 128 + d] = cum[0];
    }
    __syncthreads();
    float off = 0.f, last = 0.f;
#pragma unroll
    for (int g = 0; g < 4; ++g) { const float t = gt[(DIR * 4 + g) * 128 + d]; last += t; if (DIR == 0 ? (g < pg) : (g > pg)) off += t; }
    bf16_t* qdec = (bf16_t*)(ws + WS_QDEC) + ((size_t)u * 2 + DIR) * 8192;
    const float elast = __expf(last);
    unsigned ke[8];
#pragma unroll
    for (int i = 0; i < 16; i += 2) {
        const int p = pg * 16 + i;
        const float q0 = qv[i], q1 = qv[i + 1], k0 = kv[i], k1 = kv[i + 1];
        const float c0 = cum[i] + off, c1 = cum[i + 1] + off;
        const float e0 = __expf(c0), e1 = __expf(c1), n0 = __expf(-c0), n1 = __expf(-c1);
        const bf16_t qa = f2bf(q0 * e0), qb = f2bf(q1 * e1);
        *(LAS bf16_t*)(L + G1_QD + p * 272 + d * 2) = qa; *(LAS bf16_t*)(L + G1_QD + (p + 1) * 272 + d * 2) = qb;
        *(LAS bf16_t*)(L + G1_KD + p * 272 + d * 2) = f2bf(k0 * n0); *(LAS bf16_t*)(L + G1_KD + (p + 1) * 272 + d * 2) = f2bf(k1 * n1);
        ke[i >> 1] = cvt_pk(k0 * n0 * elast, k1 * n1 * elast);
    }
    *(LAS u32x4*)(L + G1_KET + d * 144 + pg * 32) = (u32x4){ke[0], ke[1], ke[2], ke[3]};
    *(LAS u32x4*)(L + G1_KET + d * 144 + pg * 32 + 16) = (u32x4){ke[4], ke[5], ke[6], ke[7]};
    if (pg == 0) ((float*)(ws + WS_DEC))[((size_t)(DIR * 16 + bh) * NCH + c) * 128 + d] = elast;
    __syncthreads();
#pragma unroll
    for (int i = 0; i < 2; ++i) { const int idx = tid + 512 * i, row = idx >> 4, ch = idx & 15;
        *(u32x4*)(qdec + row * 128 + ch * 8) = *(const LAS u32x4*)(L + G1_QD + row * 272 + ch * 16); }
    g1_mma(L, Aacc, av, (bf16_t*)(ws + WS_DS) + ((size_t)(DIR * 16 + bh) * NCH + c) * 32768, lane, wave);
}

__device__ __forceinline__ void gla_g1(const Ptrs& A, LAS unsigned char* L, int l, int u, int wave) { asm volatile("" : "+s"(wave)); const int lane = lane_id(); const int tid = wave * 64 + lane; (void)tid;
    unsigned char* ws = A.ws(); LAUNDER_G(ws);
    const int bh = u / NCH, c = u - bh * NCH, b = bh >> 2, h = bh & 3, r0 = b * RPB + c * 64;
    const bf16_t* P = (const bf16_t*)(ws + WS_P); const float* SIDE = (const float*)(ws + WS_SIDE);
    LAS float* lr = (LAS float*)(L + G1_LR); LAS float* wg = (LAS float*)(L + G1_WG); LAS float* bg = (LAS float*)(L + G1_BG);
    { const int p = tid >> 3, q = tid & 7, dir = q >> 2, rr4 = (q & 3) * 4;
      *(LAS f32x4*)(lr + (dir * 64 + p) * 16 + rr4) = *(const f32x4*)(SIDE + (size_t)(r0 + p) * SIDEW + 64 + dir * 16 + rr4); }
#pragma unroll
    for (int i = 0; i < 2; ++i) { const int idx = (tid * 2 + i) * 4, dir = idx >> 11, rr = (idx >> 7) & 15, d4 = idx & 127;
      *(LAS f32x4*)(wg + idx) = *(const f32x4*)(A.in(13) + ((size_t)(l * 2 + dir) * 16 + rr) * 512 + h * 128 + d4); }
    if (tid < 256) bg[tid] = A.in(14)[(l * 2 + (tid >> 7)) * 512 + h * 128 + (tid & 127)];
#pragma unroll
    for (int i = 0; i < 2; ++i) { const int idx = tid + 512 * i, row = idx >> 4, ch = idx & 15; const bf16_t* src = P + (size_t)(r0 + row) * PW + h * 128 + ch * 8;
        *(LAS u32x4*)(L + G1_RAW + row * 256 + ch * 16) = *(const u32x4*)(src + P_GQ); *(LAS u32x4*)(L + G1_RAW + 16384 + row * 256 + ch * 16) = *(const u32x4*)(src + P_GK); }
#pragma unroll
    for (int i = 0; i < 4; ++i) { const int idx = tid + 512 * i, row = idx >> 5, ch = idx & 31;
        *(LAS u32x4*)(L + G1_RAWV + row * 512 + ch * 16) = *(const u32x4*)(P + (size_t)(r0 + row) * PW + P_GV + h * 256 + ch * 8); }
    __syncthreads();
    float qv[16], kv[16];
#pragma unroll
    for (int i = 0; i < 16; ++i) { const int off = ((tid >> 7) * 16 + i) * 256 + (tid & 127) * 2; qv[i] = bf2f(*(const LAS bf16_t*)(L + G1_RAW + off)) * 0.08838834764831845f; kv[i] = bf2f(*(const LAS bf16_t*)(L + G1_RAW + 16384 + off)); }
    { const int e = tid & 255, ph = tid >> 8;
      unsigned w[16];
#pragma unroll
      for (int i = 0; i < 16; ++i) w[i] = (unsigned)*(const LAS bf16_t*)(L + G1_RAWV + (ph * 32 + 2 * i) * 512 + e * 2) | ((unsigned)*(const LAS bf16_t*)(L + G1_RAWV + (ph * 32 + 2 * i + 1) * 512 + e * 2) << 16);
#pragma unroll
      for (int i = 0; i < 4; ++i) *(LAS u32x4*)(L + G1_VT + e * 144 + ph * 64 + i * 16) = (u32x4){w[4 * i], w[4 * i + 1], w[4 * i + 2], w[4 * i + 3]}; }
    __syncthreads();
    const int r32 = lane & 31, hi = lane >> 5;
    bf16x8 av[4];
#pragma unroll
    for (int ks = 0; ks < 4; ++ks) av[ks] = *(const LAS bf16x8*)(L + G1_VT + (32 * wave + r32) * 144 + ks * 32 + hi * 16);
    f32x16 Af, Ab;
    g1_dir<0>(A, ws, L, l, u, bh, c, h, r0, Af, av, qv, kv, tid, lane, wave);
    __syncthreads();
    g1_dir<1>(A, ws, L, l, u, bh, c, h, r0, Ab, av, qv, kv, tid, lane, wave);
    if (wave < 4) { const int mb = wave >> 1, nb = wave & 1;
#pragma unroll
        for (int r = 0; r < 16; ++r) { const int cc = 32 * mb + crow(r, hi), jj = 32 * nb + r32; const float v = (jj <= cc ? Af[r] : 0.f) + (jj >= cc ? Ab[r] : 0.f);
            *(LAS bf16_t*)(L + G1_AS + cc * 144 + jj * 2) = f2bf(v); } }
    __syncthreads();
    float* OI = (float*)(ws + WS_OINTRA);
#pragma unroll
    for (int mb = 0; mb < 2; ++mb) { f32x16 acc;
#pragma unroll
        for (int r = 0; r < 16; ++r) acc[r] = 0.f;
#pragma unroll
        for (int ks = 0; ks < 4; ++ks) { const bf16x8 a = *(const LAS bf16x8*)(L + G1_AS + (32 * mb + r32) * 144 + ks * 32 + hi * 16); acc = __builtin_amdgcn_mfma_f32_32x32x16_bf16(a, av[ks], acc, 0, 0, 0); }
        float* op = OI + (size_t)(r0 + 32 * mb) * 1024 + h * 256 + 32 * wave + r32;
#pragma unroll
        for (int r = 0; r < 16; ++r) op[(size_t)crow(r, hi) * 1024] = acc[r]; }
    __syncthreads();
}

__device__ __forceinline__ void gla_g2(const Ptrs& A, int wave, int bid, int G) { const int tid = wave * 64 + lane_id();
    unsigned char* ws = A.ws(); LAUNDER_G(ws); const bf16_t* DS = (const bf16_t*)(ws + WS_DS); const float* DEC = (const float*)(ws + WS_DEC); bf16_t* SENT = (bf16_t*)(ws + WS_SENT);
    const int NT = G * NTHR;
    for (int it = bid * NTHR + tid; it < 2 * 16 * 256 * 16; it += NT) {
        const int d8 = it & 15, e = (it >> 4) & 255, db = it >> 12;
        const int dir = db >> 4;
        const size_t base = (size_t)db * NCH * 32768 + (size_t)e * 128 + d8 * 8, dbase = (size_t)db * NCH * 128 + d8 * 8;
        f32x4 s0 = (f32x4){0.f, 0.f, 0.f, 0.f}, s1 = (f32x4){0.f, 0.f, 0.f, 0.f};
#pragma unroll 4
        for (int st = 0; st < NCH; ++st) { const int c = dir == 0 ? st : (st < 4 ? 3 - st : NCH + 3 - st);
            const u32x4 dw = *(const u32x4*)(DS + base + (size_t)c * 32768); const f32x4 dc0 = *(const f32x4*)(DEC + dbase + (size_t)c * 128), dc1 = *(const f32x4*)(DEC + dbase + (size_t)c * 128 + 4);
            const unsigned w0 = dw.x, w1 = dw.y, w2 = dw.z, w3 = dw.w;
            const f32x4 ds0 = (f32x4){bflo(w0), bfhi(w0), bflo(w1), bfhi(w1)}, ds1 = (f32x4){bflo(w2), bfhi(w2), bflo(w3), bfhi(w3)};
            u32x4 o; o.x = cvt_pk(s0.x, s0.y); o.y = cvt_pk(s0.z, s0.w); o.z = cvt_pk(s1.x, s1.y); o.w = cvt_pk(s1.z, s1.w); *(u32x4*)(SENT + base + (size_t)c * 32768) = o;
            s0 = dc0 * s0 + ds0; s1 = dc1 * s1 + ds1; }
    }
}

constexpr int G3_A = 0, G3_OUT = 32768, G3_ROWB = 528, G3_GG = G3_OUT + 64 * G3_ROWB, G3_SSQ = G3_GG + 64 * G3_ROWB, G3_RSTD = G3_SSQ + 2048, G3_END = G3_RSTD + 256;
static_assert(G3_END <= LDS_CTL_OFF, "G3 LDS map");
__device__ __forceinline__ void gla_g3(const Ptrs& A, LAS unsigned char* L, int l, int u, int wave) { asm volatile("" : "+s"(wave)); const int lane = lane_id(); const int tid = wave * 64 + lane;
    unsigned char* ws = A.ws(); LAUNDER_G(ws);
    const int bh = u / NCH, c = u - bh * NCH, b = bh >> 2, h = bh & 3, r0 = b * RPB + c * 64, r32 = lane & 31, hi = lane >> 5;
    const bf16_t* qa = (const bf16_t*)(ws + WS_QDEC) + (size_t)u * 2 * 8192; const bf16_t* SENT = (const bf16_t*)(ws + WS_SENT);
    const bf16_t* P = (const bf16_t*)(ws + WS_P); bf16_t* MIX = (bf16_t*)(ws + WS_MIX);
#pragma unroll
    for (int i = 0; i < 4; ++i) { const int idx = tid + 512 * i, dir = idx >> 10, rem = idx & 1023, row = rem >> 4, cc = rem & 15;
        *(LAS u32x4*)(L + G3_A + dir * 16384 + row * 256 + ((cc ^ (row & 15)) << 4)) = *(const u32x4*)(qa + dir * 8192 + row * 128 + cc * 8);
        const int grow = idx >> 5, gch = idx & 31;
        *(LAS u32x4*)(L + G3_GG + grow * G3_ROWB + gch * 16) = *(const u32x4*)(P + (size_t)(r0 + grow) * PW + P_GG + h * 256 + gch * 8); }
    bf16x8 bb[16];
#pragma unroll
    for (int ks = 0; ks < 16; ++ks) { const int dir = ks >> 3, kk = (ks & 7) * 16 + 8 * hi;
        bb[ks] = *(const bf16x8*)(SENT + ((size_t)(dir * 16 + bh) * NCH + c) * 32768 + (size_t)(32 * wave + r32) * 128 + kk); }
    float v[32];
    { const float* oi = (const float*)(ws + WS_OINTRA) + (size_t)r0 * 1024 + h * 256 + 32 * wave + r32;
#pragma unroll
      for (int r = 0; r < 16; ++r) { v[r] = oi[(size_t)crow(r, hi) * 1024]; v[16 + r] = oi[(size_t)(32 + crow(r, hi)) * 1024]; } }
    __syncthreads();
    f32x16 acc0, acc1;
#pragma unroll
    for (int r = 0; r < 16; ++r) { acc0[r] = 0.f; acc1[r] = 0.f; }
#pragma unroll
    for (int ks = 0; ks < 16; ++ks) { const int dir = ks >> 3, cc = (ks & 7) * 2 + hi;
        const bf16x8 a0 = *(const LAS bf16x8*)(L + G3_A + dir * 16384 + r32 * 256 + ((cc ^ (r32 & 15)) << 4)), a1 = *(const LAS bf16x8*)(L + G3_A + dir * 16384 + (32 + r32) * 256 + ((cc ^ (r32 & 15)) << 4));
        acc0 = __builtin_amdgcn_mfma_f32_32x32x16_bf16(a0, bb[ks], acc0, 0, 0, 0); acc1 = __builtin_amdgcn_mfma_f32_32x32x16_bf16(a1, bb[ks], acc1, 0, 0, 0); }
#pragma unroll
    for (int r = 0; r < 16; ++r) { v[r] += acc0[r]; v[16 + r] += acc1[r]; }
    {
        float t[32];
#pragma unroll
        for (int q = 0; q < 32; ++q) t[q] = v[q] * v[q];
#pragma unroll
        for (int s_ = 0; s_ < 5; ++s_) { const int half = 16 >> s_; const bool bit = (r32 >> s_) & 1;
#pragma unroll
            for (int i = 0; i < half; ++i) { const float send = bit ? t[i] : t[i + half], keep = bit ? t[i + half] : t[i]; t[i] = keep + shx_f(send, 1 << s_); } }
        const int q = ((r32 & 1) << 4) | ((r32 & 2) << 2) | (r32 & 4) | ((r32 & 8) >> 2) | ((r32 & 16) >> 4);
        const int row = 32 * (q >> 4) + crow(q & 15, hi);
        ((LAS float*)(L + G3_SSQ))[row * 8 + wave] = t[0];
    }
    __syncthreads();
    if (tid < 64) { const f32x4 sa = *(const LAS f32x4*)(L + G3_SSQ + tid * 32), sb = *(const LAS f32x4*)(L + G3_SSQ + tid * 32 + 16);
        ((LAS float*)(L + G3_RSTD))[tid] = 1.0f / sqrtf(((sa.x + sa.y) + (sa.z + sa.w) + (sb.x + sb.y) + (sb.z + sb.w)) * (1.0f / 256.f) + EPS); }
    __syncthreads();
    const float g = A.in(15)[l * 256 + 32 * wave + r32];
#pragma unroll
    for (int q = 0; q < 32; ++q) { const int row = 32 * (q >> 4) + crow(q & 15, hi);
        const float rstd = ((const LAS float*)(L + G3_RSTD))[row];
        const float gg = bf2f(*(const LAS bf16_t*)(L + G3_GG + row * G3_ROWB + (32 * wave + r32) * 2));
        *(LAS bf16_t*)(L + G3_OUT + row * G3_ROWB + (32 * wave + r32) * 2) = f2bf((v[q] * rstd * g) * (gg / (1.f + __expf(-gg)))); }
    __syncthreads();
#pragma unroll
    for (int i = 0; i < 4; ++i) { const int idx = tid + 512 * i, row = idx >> 5, ch = idx & 31;
        *(u32x4*)(MIX + (size_t)(r0 + row) * DM + 1024 + h * 256 + ch * 8) = *(const LAS u32x4*)(L + G3_OUT + row * G3_ROWB + ch * 16); }
    __syncthreads();
}

#ifndef QR_REG
#define QR_REG 1
#endif
namespace att {
constexpr int NW = 8, QBLK = 32, KVBLK = 64;
constexpr float SCALE = 0.07216878364870323f;
constexpr float THR = 8.f;
constexpr int LDQ = 1536, LDKV = 2048, LDKR = 64, LDO = 2048;
constexpr int SHM_V = 16384, SHM_K = 16384, SHM_R = 8192;
constexpr int OFF_V = 0, OFF_K = 2 * SHM_V, OFF_R = OFF_K + 2 * SHM_K, OFF_WS = OFF_R + 2 * SHM_R, OFF_QR = OFF_WS + NW * 64 * 4, LDS_NEED = OFF_QR + NW * 8704;
static_assert(LDS_NEED <= LDS_CTL_OFF, "attention LDS map");
#define KSWZ(row, colB) ((row) * 256 + ((colB) ^ (((row) & 15) << 4)))
#define RSWZ(row, colB) ((row) * 128 + ((colB) ^ ((((row) >> 1) & 7) << 4)))

__device__ __forceinline__ void partialSM(f32x16& p0, f32x16& p1, float& m_reg, float& mn, float& alpha) {
  constexpr float C = SCALE * 1.4426950408889634f;
  float pmax = p0[0];
#pragma unroll
  for (int r = 1; r < 16; ++r) pmax = fmaxf(pmax, p0[r]);
#pragma unroll
  for (int r = 0; r < 16; ++r) pmax = fmaxf(pmax, p1[r]);
  { auto rr = __builtin_amdgcn_permlane32_swap(__float_as_uint(pmax), __float_as_uint(pmax), false, false);
    pmax = fmaxf(__uint_as_float(rr[0]), __uint_as_float(rr[1])); }
  if (__builtin_expect(__all(pmax - m_reg <= THR / SCALE), 1)) { mn = m_reg; alpha = 1.f; }
  else { mn = fmaxf(m_reg, pmax); alpha = __builtin_amdgcn_exp2f((m_reg - mn) * C); m_reg = mn; }
  const float mnC = -mn * C;
#pragma unroll
  for (int r = 0; r < 16; ++r) p0[r] = fmaf(p0[r], C, mnC);
#pragma unroll
  for (int r = 0; r < 16; ++r) p1[r] = fmaf(p1[r], C, mnC);
#pragma unroll
  for (int r = 0; r < 16; ++r) p0[r] = __builtin_amdgcn_exp2f(p0[r]);
}
__device__ __forceinline__ void finishSM(f32x16& p0, f32x16& p1, float alpha, float& l_reg, bf16x8& pa0, bf16x8& pa1, bf16x8& pa2, bf16x8& pa3) {
#pragma unroll
  for (int r = 0; r < 16; ++r) p1[r] = __builtin_amdgcn_exp2f(p1[r]);
  float ps = 0;
#pragma unroll
  for (int r = 0; r < 16; ++r) ps += p0[r];
#pragma unroll
  for (int r = 0; r < 16; ++r) ps += p1[r];
  { auto rr = __builtin_amdgcn_permlane32_swap(__float_as_uint(ps), __float_as_uint(ps), false, false);
    ps = __uint_as_float(rr[0]) + __uint_as_float(rr[1]); }
  l_reg = l_reg * alpha + ps;
#define PK4(P, BASE, OUT) do { unsigned a0 = cvt_pk_asm(P[BASE + 0], P[BASE + 1]), a1 = cvt_pk_asm(P[BASE + 2], P[BASE + 3]);   \
    unsigned b0 = cvt_pk_asm(P[BASE + 4], P[BASE + 5]), b1 = cvt_pk_asm(P[BASE + 6], P[BASE + 7]);                              \
    auto r0 = __builtin_amdgcn_permlane32_swap(a0, b0, false, false); auto r1 = __builtin_amdgcn_permlane32_swap(a1, b1, false, false); \
    u32x4 w = {r0[0], r1[0], r0[1], r1[1]}; OUT = __builtin_bit_cast(bf16x8, w); } while (0)
  PK4(p0, 0, pa0); PK4(p0, 8, pa1); PK4(p1, 0, pa2); PK4(p1, 8, pa3);
#undef PK4
}
__device__ __forceinline__ void qkt(f32x16& p0, f32x16& p1, const LAS unsigned char* Ks, const LAS unsigned char* Rs, const bf16x8 (&qr)[8], const bf16x8 (&qrr)[4], const LAS unsigned char* QRl, int r32, int hi) {
#pragma unroll
  for (int r = 0; r < 16; ++r) { p0[r] = 0.f; p1[r] = 0.f; }
#pragma unroll
  for (int d0 = 0; d0 < 8; ++d0) { const int cb = d0 * 32 + hi * 16;
    const bf16x8 b0 = *(const LAS bf16x8*)(Ks + KSWZ(r32, cb)), b1 = *(const LAS bf16x8*)(Ks + KSWZ(32 + r32, cb));
    p0 = __builtin_amdgcn_mfma_f32_32x32x16_bf16(b0, qr[d0], p0, 0, 0, 0);
    p1 = __builtin_amdgcn_mfma_f32_32x32x16_bf16(b1, qr[d0], p1, 0, 0, 0); }
#pragma unroll
  for (int d0 = 0; d0 < 4; ++d0) { const int cb = d0 * 32 + hi * 16;
    const bf16x8 b0 = *(const LAS bf16x8*)(Rs + RSWZ(r32, cb)), b1 = *(const LAS bf16x8*)(Rs + RSWZ(32 + r32, cb));
#if QR_REG
    const bf16x8 qq = qrr[d0];
#else
    const bf16x8 qq = *(const LAS bf16x8*)(QRl + d0 * 1024);
#endif
    p0 = __builtin_amdgcn_mfma_f32_32x32x16_bf16(b0, qq, p0, 0, 0, 0);
    p1 = __builtin_amdgcn_mfma_f32_32x32x16_bf16(b1, qq, p1, 0, 0, 0); }
}
__device__ __forceinline__ int v_st(int k, int c) { const int kk = (k & ~0xC) | ((k & 4) << 1) | ((k & 8) >> 1); return ((kk >> 3) * 4 + (c >> 5)) * 512 + ((kk & 7) * 32 + (c & 31)) * 2; }
__device__ __forceinline__ int v_rd_base(int lane) { return ((lane & 3) << 3) | (((lane >> 2) & 3) << 6) | (((lane >> 4) & 1) << 5) | (((lane >> 5) & 1) << 8); }
constexpr int v_rd_off(int d0, int ks, int half) { return d0 * 512 + ks * 4096 + half * 2048; }
template <int OFF> __device__ __forceinline__ s16x4 tr_read(int vb) {
  s16x4 r; asm volatile("ds_read_b64_tr_b16 %0, %1 offset:%2" : "=&v"(r) : "v"(vb), "i"(OFF) : "memory"); return r;
}
template <int D0> __device__ __forceinline__ void pv_one(f32x16& od, int vb, bf16x8 pa0, bf16x8 pa1, bf16x8 pa2, bf16x8 pa3) {
  const s16x4 l0 = tr_read<v_rd_off(D0, 0, 0)>(vb), h0 = tr_read<v_rd_off(D0, 0, 1)>(vb), l1 = tr_read<v_rd_off(D0, 1, 0)>(vb), h1 = tr_read<v_rd_off(D0, 1, 1)>(vb);
  const s16x4 l2 = tr_read<v_rd_off(D0, 2, 0)>(vb), h2 = tr_read<v_rd_off(D0, 2, 1)>(vb), l3 = tr_read<v_rd_off(D0, 3, 0)>(vb), h3 = tr_read<v_rd_off(D0, 3, 1)>(vb);
  asm volatile("s_waitcnt lgkmcnt(0)" ::: "memory"); SBAR();
#define PKV(L_, H_) (bf16x8){L_[0], L_[1], L_[2], L_[3], H_[0], H_[1], H_[2], H_[3]}
  od = __builtin_amdgcn_mfma_f32_32x32x16_bf16(pa0, PKV(l0, h0), od, 0, 0, 0);
  od = __builtin_amdgcn_mfma_f32_32x32x16_bf16(pa1, PKV(l1, h1), od, 0, 0, 0);
  od = __builtin_amdgcn_mfma_f32_32x32x16_bf16(pa2, PKV(l2, h2), od, 0, 0, 0);
  od = __builtin_amdgcn_mfma_f32_32x32x16_bf16(pa3, PKV(l3, h3), od, 0, 0, 0);
#undef PKV
}
__device__ __forceinline__ void pv_d0(f32x16 (&o)[4], int vb, bf16x8 pa0, bf16x8 pa1, bf16x8 pa2, bf16x8 pa3) {
  pv_one<0>(o[0], vb, pa0, pa1, pa2, pa3); pv_one<1>(o[1], vb, pa0, pa1, pa2, pa3); pv_one<2>(o[2], vb, pa0, pa1, pa2, pa3); pv_one<3>(o[3], vb, pa0, pa1, pa2, pa3);
}

__device__ __forceinline__ void attn_unit(const bf16_t* __restrict__ Qb, const bf16_t* __restrict__ Kn, const bf16_t* __restrict__ Kr, const bf16_t* __restrict__ Vh,
                                          bf16_t* __restrict__ Ob, int nkeys, LAS unsigned char* lds, int wid) {
  asm volatile("" : "+s"(wid));
  const int lane = lane_id(), tid = wid * 64 + lane, r32 = lane & 31, hi = lane >> 5;
  LAS unsigned char* V_lds = lds + OFF_V; LAS unsigned char* K_lds = lds + OFF_K; LAS unsigned char* R_lds = lds + OFF_R;
  LAS float* wsf = (LAS float*)(lds + OFF_WS) + wid * 64; LAS float* li_l = wsf; LAS float* al_l = wsf + 32;
  float m_reg = -1e30f, l_reg = 0.f; f32x16 o[4]; bf16x8 qr[8];
  LAS unsigned char* QRl = lds + OFF_QR + wid * 4096 + lane * 16;
#pragma unroll
  for (int d = 0; d < 4; ++d)
#pragma unroll
    for (int r = 0; r < 16; ++r) o[d][r] = 0.f;
  const bf16_t* Qw = Qb + (size_t)(wid * QBLK + r32) * LDQ + hi * 8;
#pragma unroll
  for (int d0 = 0; d0 < 8; ++d0) qr[d0] = *(const bf16x8*)(Qw + d0 * 16);
  bf16x8 qrr[4];
#pragma unroll
  for (int d0 = 0; d0 < 4; ++d0) { qrr[d0] = *(const bf16x8*)(Qw + (8 + d0) * 16);
#if !QR_REG
    *(LAS bf16x8*)(QRl + d0 * 1024) = qrr[d0];
#endif
  }
  const int sr = tid >> 4, sc = (tid & 15) * 8, vst0 = v_st(sr, sc), vst1 = v_st(32 + sr, sc);
  const int rr_ = tid >> 3, rc_ = (tid & 7) * 8;
  const int vb0 = (int)(unsigned)(uintptr_t)V_lds + v_rd_base(lane);
  bf16x8 vs0, vs1, ks0, ks1, rs0;
#define SLOAD(k0) do { vs0 = *(const bf16x8*)(Vh + (size_t)((k0) + sr) * LDKV + sc); vs1 = *(const bf16x8*)(Vh + (size_t)((k0) + 32 + sr) * LDKV + sc); \
    ks0 = *(const bf16x8*)(Kn + (size_t)((k0) + sr) * LDKV + sc); ks1 = *(const bf16x8*)(Kn + (size_t)((k0) + 32 + sr) * LDKV + sc); \
    rs0 = *(const bf16x8*)(Kr + (size_t)((k0) + rr_) * LDKR + rc_); } while (0)
#define SWRITE(b) do { *(LAS bf16x8*)(V_lds + (b) * SHM_V + vst0) = vs0; *(LAS bf16x8*)(V_lds + (b) * SHM_V + vst1) = vs1; const int kc = sc * 2; \
    *(LAS bf16x8*)(K_lds + (b) * SHM_K + KSWZ(sr, kc)) = ks0; *(LAS bf16x8*)(K_lds + (b) * SHM_K + KSWZ(32 + sr, kc)) = ks1; \
    *(LAS bf16x8*)(R_lds + (b) * SHM_R + RSWZ(rr_, rc_ * 2)) = rs0; } while (0)
#define SWAIT() asm volatile("s_waitcnt vmcnt(0)" ::: "memory")
#define RESC(a) do { if (__any((a) < 1.f)) { if (hi == 0) al_l[r32] = (a); asm volatile("s_waitcnt lgkmcnt(0)" ::: "memory"); \
    _Pragma("unroll") for (int d = 0; d < 4; ++d) _Pragma("unroll") for (int r = 0; r < 16; ++r) o[d][r] *= al_l[crow(r, hi)]; } } while (0)
  f32x16 pA0, pA1, pB0, pB1; float mnA, mnB, alA, alB; bf16x8 pa0, pa1, pa2, pa3; const int NT = nkeys / KVBLK;
  SLOAD(0); SWAIT(); SWRITE(0); __syncthreads();
  qkt(pA0, pA1, K_lds, R_lds, qr, qrr, QRl, r32, hi); partialSM(pA0, pA1, m_reg, mnA, alA);
  SLOAD(KVBLK);
  SWAIT(); SWRITE(1); __syncthreads();
  for (int j = 1; j + 1 < NT; j += 2) {
    SBAR(); qkt(pB0, pB1, K_lds + SHM_K, R_lds + SHM_R, qr, qrr, QRl, r32, hi);
    finishSM(pA0, pA1, alA, l_reg, pa0, pa1, pa2, pa3); SBAR();
    SLOAD((j + 1) * KVBLK); SBAR();
    pv_d0(o, vb0, pa0, pa1, pa2, pa3); partialSM(pB0, pB1, m_reg, mnB, alB);
    __syncthreads(); SWAIT(); SWRITE(0);
    RESC(alB); __syncthreads();
    SBAR(); qkt(pA0, pA1, K_lds, R_lds, qr, qrr, QRl, r32, hi);
    finishSM(pB0, pB1, alB, l_reg, pa0, pa1, pa2, pa3); SBAR();
    SLOAD((j + 2) * KVBLK); SBAR();
    pv_d0(o, vb0 + SHM_V, pa0, pa1, pa2, pa3); partialSM(pA0, pA1, m_reg, mnA, alA);
    __syncthreads(); SWAIT(); SWRITE(1);
    RESC(alA); __syncthreads();
  }
  SBAR(); qkt(pB0, pB1, K_lds + SHM_K, R_lds + SHM_R, qr, qrr, QRl, r32, hi);
  finishSM(pA0, pA1, alA, l_reg, pa0, pa1, pa2, pa3); SBAR();
  pv_d0(o, vb0, pa0, pa1, pa2, pa3); partialSM(pB0, pB1, m_reg, mnB, alB);
  __syncthreads(); RESC(alB);
  finishSM(pB0, pB1, alB, l_reg, pa0, pa1, pa2, pa3); SBAR();
  pv_d0(o, vb0 + SHM_V, pa0, pa1, pa2, pa3);
  if (hi == 0) li_l[r32] = l_reg; asm volatile("s_waitcnt lgkmcnt(0)" ::: "memory");
  float rli[16];
#pragma unroll
  for (int r = 0; r < 16; ++r) rli[r] = __builtin_amdgcn_rcpf(li_l[crow(r, hi)]);
  bf16_t* Ow = Ob + (size_t)(wid * QBLK) * LDO;
#if QR_REG
  { LAS unsigned char* slab = lds + OFF_QR + wid * 8704;
#pragma unroll
    for (int r = 0; r < 16; ++r) { const int orow = crow(r, hi);
#pragma unroll
      for (int d0 = 0; d0 < 4; ++d0) *(LAS bf16_t*)(slab + orow * 272 + (d0 * 32 + r32) * 2) = f2bf(o[d0][r] * rli[r]); }
#pragma unroll
    for (int i = 0; i < 8; ++i) { const int idx = lane + 64 * i, row = idx >> 4, ch = idx & 15;
      *(u32x4*)(Ow + (size_t)row * LDO + ch * 8) = *(const LAS u32x4*)(slab + row * 272 + ch * 16); } }
#else
#pragma unroll
  for (int r = 0; r < 16; ++r) { const int orow = crow(r, hi);
#pragma unroll
    for (int d0 = 0; d0 < 4; ++d0) Ow[(size_t)orow * LDO + d0 * 32 + r32] = f2bf(o[d0][r] * rli[r]); }
#endif
  __syncthreads();
#undef SLOAD
#undef SWRITE
#undef SWAIT
#undef RESC
}
}

constexpr int TK_S = 0, TK_SSTR = 260, TK_SBYTES = 64 * TK_SSTR * 4, TK_TV = 2 * TK_SBYTES, TK_TI = TK_TV + 64 * 2 * 16 * 4, TK_TAB = TK_TI + 64 * 2 * 16 * 4, TK_END = TK_TAB + 64 * 4;
static_assert(TK_END <= LDS_CTL_OFF, "topk LDS map");
constexpr int TK_COFF[17] = {0, 16, 24, 29, 33, 36, 38, 40, 42, 43, 44, 45, 46, 47, 48, 49, 50};
__device__ __forceinline__ unsigned f2mono(float f) { const unsigned u = __float_as_uint(f); return (u & 0x80000000u) ? ~u : (u | 0x80000000u); }
template <int N> __device__ __forceinline__ void bitonic_merge_desc(unsigned (&a)[N]) {
#pragma unroll
    for (int d = N >> 1; d > 0; d >>= 1)
#pragma unroll
        for (int i = 0; i < N; ++i) { const int p = i ^ d; if (p > i) { const unsigned lo = a[i] < a[p] ? a[i] : a[p], hi = a[i] < a[p] ? a[p] : a[i]; a[i] = hi; a[p] = lo; } }
}
template <int N> __device__ __forceinline__ void bitonic_sort_desc(unsigned (&a)[N]) {
#pragma unroll
    for (int k = 2; k <= N; k <<= 1)
#pragma unroll
        for (int d = k >> 1; d > 0; d >>= 1)
#pragma unroll
            for (int i = 0; i < N; ++i) { const int p = i ^ d; if (p > i) { const bool desc = ((i & k) == 0) || (k == N); const unsigned lo = a[i] < a[p] ? a[i] : a[p], hi = a[i] < a[p] ? a[p] : a[i]; a[i] = desc ? hi : lo; a[p] = desc ? lo : hi; } }
}
__device__ __forceinline__ void tk_scores(unsigned char* ws, LAS float* S, int l, int u, int half, int kb0, int nkb, int lane) {
    const int tile = u >> 3, h = u & 7, r0 = tile * 64, r32 = lane & 31, hi = lane >> 5;
    const bf16_t* qp = (const bf16_t*)(ws + WS_QP) + (size_t)(r0 + r32) * DM + h * 256 + half * 128 + 8 * hi;
    bf16x8 q0[8], q1[8];
#pragma unroll
    for (int ks = 0; ks < 8; ++ks) { q0[ks] = *(const bf16x8*)(qp + ks * 16); q1[ks] = *(const bf16x8*)(qp + (size_t)32 * DM + ks * 16); }
    for (int kb = kb0; kb < kb0 + nkb; ++kb) {
        const bf16_t* kp = (const bf16_t*)(ws + WS_SUBK) + ((size_t)((l * 2 + half) * 8 + h) * 128 + kb * 32 + r32) * 128 + 8 * hi;
        f32x16 a0, a1;
#pragma unroll
        for (int r = 0; r < 16; ++r) { a0[r] = 0.f; a1[r] = 0.f; }
#pragma unroll
        for (int ks = 0; ks < 8; ++ks) { const bf16x8 kk = *(const bf16x8*)(kp + ks * 16);
            a0 = __builtin_amdgcn_mfma_f32_32x32x16_bf16(q0[ks], kk, a0, 0, 0, 0); a1 = __builtin_amdgcn_mfma_f32_32x32x16_bf16(q1[ks], kk, a1, 0, 0, 0); }
#pragma unroll
        for (int r = 0; r < 16; ++r) { S[crow(r, hi) * TK_SSTR + half * 128 + kb * 32 + r32] = a0[r]; S[(32 + crow(r, hi)) * TK_SSTR + half * 128 + kb * 32 + r32] = a1[r]; }
    }
}
__device__ __forceinline__ void peer_topk_phase(const Ptrs& A, LAS unsigned char* L, int l, int wave, int bid, int G) { asm volatile("" : "+s"(wave));
    unsigned char* ws = A.ws(); LAUNDER_G(ws);
    const int NU = (NTOK / 64) * 8;
    LAS float* TV = (LAS float*)(L + TK_TV); LAS int* TI = (LAS int*)(L + TK_TI); LAS int* TAB = (LAS int*)(L + TK_TAB);
    { const int lane = lane_id(); const int tid = wave * 64 + lane;
      if (bid < NU) tk_scores(ws, (LAS float*)(L + TK_S), l, bid, wave >> 2, wave & 3, 1, lane);
      if (tid < 50) { int row = 0;
#pragma unroll
          for (int i = 1; i < 16; ++i) row = tid >= TK_COFF[i] ? i : row;
          int base = 0;
#pragma unroll
          for (int i = 1; i < 16; ++i) base = row == i ? TK_COFF[i] : base;
          TAB[tid] = row * 16 + (tid - base); } }
    __syncthreads();
    int n = 0;
    for (int u = bid; u < NU; u += G, ++n) {
        const int lane = lane_id(); const int tid = wave * 64 + lane;
        const int tile = u >> 3, h = u & 7, r0 = tile * 64;
        LAS float* S = (LAS float*)(L + TK_S + (n & 1) * TK_SBYTES);
    {
        const int item = tid >> 2, q = tid & 3, tok = item & 63, half = item >> 6;
        unsigned k0[16], k1[16];
#pragma unroll
        for (int j = 0; j < 4; ++j) { const f32x4 x = *(const LAS f32x4*)(S + tok * TK_SSTR + half * 128 + q * 32 + j * 4), y = *(const LAS f32x4*)(S + tok * TK_SSTR + half * 128 + q * 32 + 16 + j * 4);
            const int ib = 127 - (q * 32 + 4 * j);
            k0[4 * j] = (f2mono(x.x) & ~127u) | (unsigned)ib; k0[4 * j + 1] = (f2mono(x.y) & ~127u) | (unsigned)(ib - 1); k0[4 * j + 2] = (f2mono(x.z) & ~127u) | (unsigned)(ib - 2); k0[4 * j + 3] = (f2mono(x.w) & ~127u) | (unsigned)(ib - 3);
            k1[4 * j] = (f2mono(y.x) & ~127u) | (unsigned)(ib - 16); k1[4 * j + 1] = (f2mono(y.y) & ~127u) | (unsigned)(ib - 17); k1[4 * j + 2] = (f2mono(y.z) & ~127u) | (unsigned)(ib - 18); k1[4 * j + 3] = (f2mono(y.w) & ~127u) | (unsigned)(ib - 19); }
        bitonic_sort_desc<16>(k0); bitonic_sort_desc<16>(k1);
#pragma unroll
        for (int i = 0; i < 16; ++i) k0[i] = k0[i] > k1[15 - i] ? k0[i] : k1[15 - i];
        bitonic_merge_desc<16>(k0);
#pragma unroll
        for (int o = 1; o < 4; o <<= 1) {
#pragma unroll
            for (int i = 0; i < 16; ++i) k1[i] = (unsigned)shx_i((int)k0[i], o);
#pragma unroll
            for (int i = 0; i < 16; ++i) k0[i] = k0[i] > k1[15 - i] ? k0[i] : k1[15 - i];
            bitonic_merge_desc<16>(k0); }
#pragma unroll
        for (int i = 0; i < 16; ++i) if ((i >> 2) == q) { const int idx = 127 - (int)(k0[i] & 127u); TI[(tok * 2 + half) * 16 + i] = idx; TV[(tok * 2 + half) * 16 + i] = S[tok * TK_SSTR + half * 128 + idx]; }
    }
    __syncthreads();
        if (wave >= 4) { if (u + G < NU) tk_scores(ws, (LAS float*)(L + TK_S + ((n + 1) & 1) * TK_SBYTES), l, u + G, (wave - 4) >> 1, ((wave - 4) & 1) * 2, 2, lane); }
        else
    {
        const int tok = tid >> 2, q = tid & 3;
        unsigned ck[13];
#pragma unroll
        for (int sl = 0; sl < 13; ++sl) { const int n = 4 * sl + q; unsigned key = 0u;
            if (n < 50) { const int code = TAB[n]; const float sum = TV[(tok * 2) * 16 + (code >> 4)] + TV[(tok * 2 + 1) * 16 + (code & 15)]; key = (f2mono(sum) & ~63u) | (unsigned)(63 - n); }
            ck[sl] = key; }
        unsigned win[4] = {0u, 0u, 0u, 0u};
#pragma unroll
        for (int pass = 0; pass < 16; ++pass) {
            unsigned best = ck[0];
#pragma unroll
            for (int sl = 1; sl < 13; ++sl) best = ck[sl] > best ? ck[sl] : best;
#pragma unroll
            for (int o = 1; o < 4; o <<= 1) { const unsigned ob = (unsigned)shx_i((int)best, o); best = ob > best ? ob : best; }
#pragma unroll
            for (int sl = 0; sl < 13; ++sl) ck[sl] = ck[sl] == best ? 0u : ck[sl];
            if ((pass >> 2) == q) win[pass & 3] = best;
        }
        float sm[4]; int ex_idx[4];
#pragma unroll
        for (int w = 0; w < 4; ++w) { const int n = 63 - (int)(win[w] & 63u); const int code = TAB[n]; const int i = code >> 4, j = code & 15;
            sm[w] = TV[(tok * 2) * 16 + i] + TV[(tok * 2 + 1) * 16 + j]; ex_idx[w] = TI[(tok * 2) * 16 + i] * 128 + TI[(tok * 2 + 1) * 16 + j]; }
        const float mx = DPP_F(sm[0], 0x00);
        float ex[4], den = 0.f;
#pragma unroll
        for (int w = 0; w < 4; ++w) { ex[w] = __expf(sm[w] - mx); den += ex[w]; }
        den += shx_f(den, 1); den += shx_f(den, 2);
        const float inv = 1.0f / den;
        int* IDX = (int*)(ws + WS_IDX) + (size_t)(r0 + tok) * 128 + h * 16 + 4 * q; float* GATE = (float*)(ws + WS_GATE) + (size_t)(r0 + tok) * 128 + h * 16 + 4 * q;
        *(u32x4*)IDX = (u32x4){(unsigned)ex_idx[0], (unsigned)ex_idx[1], (unsigned)ex_idx[2], (unsigned)ex_idx[3]};
        *(f32x4*)GATE = (f32x4){ex[0] * inv, ex[1] * inv, ex[2] * inv, ex[3] * inv};
    }
    __syncthreads();
    }
}

__device__ __forceinline__ float gelu_tanh(float x) { const float y = 0.7978845608028654f * (x + 0.044715f * x * x * x); const float t = 1.f - 2.f * __builtin_amdgcn_rcpf(__expf(2.f * y) + 1.f); return 0.5f * x * (1.f + t); }
#ifndef PEER_NEB
#define PEER_NEB 4
#endif
#ifndef PEER_NEC
#define PEER_NEC 4
#endif
typedef int i32x4 __attribute__((ext_vector_type(4)));
typedef int i32x8 __attribute__((ext_vector_type(8)));
constexpr int PEER_H4 = 0;
static_assert(PEER_H4 + NWAVES * 4096 <= LDS_CTL_OFF, "peer LDS map");
template <int NTK>
__device__ __forceinline__ void peer_tokens(const Ptrs& A, unsigned char* ws, LAS unsigned char* HL, const int (&rows)[NTK], int l, int lane) {
    constexpr int NE = PEER_NEB / NTK, NEC = PEER_NEC / NTK;
    const unsigned char* EU = ws + WS_EU + (size_t)l * NEXP * EROW; const unsigned char* EV = ws + WS_EV + (size_t)l * NEXP * EROW;
    const float* SU = (const float*)(ws + WS_SU) + (size_t)l * NEXP; const float* SV = (const float*)(ws + WS_SV) + (size_t)l * NEXP;
    const float* MOD = (const float*)(ws + WS_MOD);
    float out[NTK][32]; unsigned k_lo[NTK], k_hi[NTK]; float g_lo[NTK], g_hi[NTK], s_lo[NTK], s_hi[NTK];
    { const int lane = lane_id();
#pragma unroll
    for (int t = 0; t < NTK; ++t) { const int r = rows[t];
        const bf16_t* hrow = (const bf16_t*)(ws + WS_H) + (size_t)r * DM;
        u32x2 hb[8]; float am = 0.f;
#pragma unroll
        for (int i = 0; i < 8; ++i) { hb[i] = *(const u32x2*)(hrow + (lane + 64 * i) * 4);
            am = fmaxf(am, fmaxf(fmaxf(fabsf(bflo(hb[i].x)), fabsf(bfhi(hb[i].x))), fmaxf(fabsf(bflo(hb[i].y)), fabsf(bfhi(hb[i].y))))); }
        am = wave_max(am);
        const float hs = am > 0.f ? am * (1.0f / 6.0f) : 1.0f, hinv = 1.0f / hs;
        LAS unsigned char* H4 = HL + t * 2048;
#pragma unroll
        for (int i = 0; i < 8; ++i) { const float y0 = bflo(hb[i].x) * hinv, y1 = bfhi(hb[i].x) * hinv, y2 = bflo(hb[i].y) * hinv, y3 = bfhi(hb[i].y) * hinv;
            unsigned c1 = 0u; c1 = __builtin_amdgcn_cvt_scalef32_pk_fp4_f32(c1, y0, y1, 1.0f, 0); c1 = __builtin_amdgcn_cvt_scalef32_pk_fp4_f32(c1, y2, y3, 1.0f, 1);
            const f32x2 d01 = __builtin_amdgcn_cvt_scalef32_pk_f32_fp4(c1, 1.0f, 0), d23 = __builtin_amdgcn_cvt_scalef32_pk_f32_fp4(c1, 1.0f, 1);
            unsigned c2 = 0u; c2 = __builtin_amdgcn_cvt_scalef32_pk_fp4_f32(c2, 4.0f * (y0 - d01.x), 4.0f * (y1 - d01.y), 1.0f, 0); c2 = __builtin_amdgcn_cvt_scalef32_pk_fp4_f32(c2, 4.0f * (y2 - d23.x), 4.0f * (y3 - d23.y), 1.0f, 1);
            *(LAS unsigned short*)(H4 + (lane + 64 * i) * 2) = (unsigned short)c1; *(LAS unsigned short*)(H4 + 1024 + (lane + 64 * i) * 2) = (unsigned short)c2; }
        const int* ip = (const int*)(ws + WS_IDX) + (size_t)r * 128; const float* gp = (const float*)(ws + WS_GATE) + (size_t)r * 128;
        const int i_lo = ip[lane], i_hi = ip[64 + lane]; g_lo[t] = gp[lane] * SV[i_lo]; g_hi[t] = gp[64 + lane] * SV[i_hi]; s_lo[t] = SU[i_lo] * hs; s_hi[t] = SU[i_hi] * hs;
        unsigned kl = ((unsigned)i_lo << 7) | (unsigned)lane, kh = ((unsigned)i_hi << 7) | (unsigned)(64 + lane);
#pragma unroll
        for (int k = 2; k <= 128; k <<= 1)
#pragma unroll
            for (int d = k >> 1; d > 0; d >>= 1) {
                if (d == 64) { const unsigned a = kl < kh ? kl : kh, c = kl < kh ? kh : kl; kl = a; kh = c; }
                else { const unsigned o0 = (unsigned)shx_i((int)kl, d), o1 = (unsigned)shx_i((int)kh, d);
                    const bool up0 = k == 128 ? true : (k == 64 ? true : ((lane & k) == 0)), up1 = k == 128 ? true : (k == 64 ? false : ((lane & k) == 0));
                    const bool lowhalf = (lane & d) == 0;
                    const unsigned mn0 = kl < o0 ? kl : o0, mx0 = kl < o0 ? o0 : kl, mn1 = kh < o1 ? kh : o1, mx1 = kh < o1 ? o1 : kh;
                    kl = (lowhalf == up0) ? mn0 : mx0; kh = (lowhalf == up1) ? mn1 : mx1; } }
        k_lo[t] = kl; k_hi[t] = kh;
#pragma unroll
        for (int jj = 0; jj < 32; ++jj) out[t][jj] = 0.f;
    }
    }
    const unsigned l16 = (unsigned)lane_id() * 16u;
    float a_lo[NTK], a_hi[NTK];
    {
        int sa_lo[NTK], sa_hi[NTK];
#pragma unroll
        for (int t = 0; t < NTK; ++t) { sa_lo[t] = 0; sa_hi[t] = 0; }
#pragma unroll 1
        for (int grp = 0; grp < 8; ++grp) {
#pragma unroll
            for (int t = 0; t < NTK; ++t) { const int ln = lane_id();
                const unsigned kreg = grp < 4 ? k_lo[t] : k_hi[t];
                const int e_m = (int)((unsigned)__builtin_amdgcn_ds_bpermute((16 * (grp & 3) + (ln & 15)) << 2, (int)kreg) >> 7);
                const unsigned char* up = EU + (size_t)e_m * EROW + (ln >> 4) * 16;
                i32x4 ua[16];
#pragma unroll
                for (int ks = 0; ks < 16; ++ks) ua[ks] = *(const i32x4*)(up + ks * 64);
                f32x4 acc = {0.f, 0.f, 0.f, 0.f};
#pragma unroll
                for (int ks = 0; ks < 16; ++ks) { if ((ks & 1) == 0) __builtin_amdgcn_sched_barrier(0);
                    const LAS unsigned char* hp = HL + t * 2048 + ks * 64 + (ln >> 4) * 16; const i32x4 b1 = *(const LAS i32x4*)hp, b2 = *(const LAS i32x4*)(hp + 1024);
                    const i32x8 Aop = {ua[ks].x, ua[ks].y, ua[ks].z, ua[ks].w, 0, 0, 0, 0}, B1 = {b1.x, b1.y, b1.z, b1.w, 0, 0, 0, 0}, B2 = {b2.x, b2.y, b2.z, b2.w, 0, 0, 0, 0};
                    acc = __builtin_amdgcn_mfma_scale_f32_16x16x128_f8f6f4(Aop, B1, acc, 4, 4, 0, 0x7F7F7F7F, 0, 0x7F7F7F7F);
                    acc = __builtin_amdgcn_mfma_scale_f32_16x16x128_f8f6f4(Aop, B2, acc, 4, 4, 0, 0x7F7F7F7F, 0, 0x7D7D7D7D); }
                __builtin_amdgcn_sched_barrier(0);
                const float af[4] = {acc[0], acc[1], acc[2], acc[3]};
#pragma unroll
                for (int m = 0; m < 16; ++m) { const int tot = __builtin_amdgcn_readlane(__builtin_bit_cast(int, af[m & 3]), 16 * (m >> 2)); const int wl = 16 * (grp & 3) + m; unsigned keep;
                    if (grp < 4) asm volatile("s_mov_b32 %1, m0\n\ts_mov_b32 m0, %3\n\tv_writelane_b32 %0, %2, m0\n\ts_mov_b32 m0, %1" : "+v"(sa_lo[t]), "=&s"(keep) : "s"(tot), "s"(wl));
                    else asm volatile("s_mov_b32 %1, m0\n\ts_mov_b32 m0, %3\n\tv_writelane_b32 %0, %2, m0\n\ts_mov_b32 m0, %1" : "+v"(sa_hi[t]), "=&s"(keep) : "s"(tot), "s"(wl)); }
            }
        }
        const int lane = lane_id();
#pragma unroll
        for (int t = 0; t < NTK; ++t) {
            const int ps_lo = (int)(k_lo[t] & 127u), ps_hi = (int)(k_hi[t] & 127u);
#define BPF(idx, v) __builtin_bit_cast(float, __builtin_amdgcn_ds_bpermute(((idx) & 63) << 2, __builtin_bit_cast(int, (v))))
            const float su_l0 = BPF(ps_lo, s_lo[t]), su_l1 = BPF(ps_lo, s_hi[t]), su_h0 = BPF(ps_hi, s_lo[t]), su_h1 = BPF(ps_hi, s_hi[t]);
            const float gt_l0 = BPF(ps_lo, g_lo[t]), gt_l1 = BPF(ps_lo, g_hi[t]), gt_h0 = BPF(ps_hi, g_lo[t]), gt_h1 = BPF(ps_hi, g_hi[t]);
#undef BPF
            const float su_l = ps_lo < 64 ? su_l0 : su_l1, su_h = ps_hi < 64 ? su_h0 : su_h1, gt_l = ps_lo < 64 ? gt_l0 : gt_l1, gt_h = ps_hi < 64 ? gt_h0 : gt_h1;
            a_lo[t] = gelu_tanh(__builtin_bit_cast(float, sa_lo[t]) * su_l) * gt_l;
            a_hi[t] = gelu_tanh(__builtin_bit_cast(float, sa_hi[t]) * su_h) * gt_h; }
        (void)lane;
    }
    {
        constexpr int NV = 4 / NTK;
        u32x4 vaA[NTK][NV], vaB[NTK][NV];
        auto vload = [&](int k0, u32x4 (&va)[NTK][NV]) {
#pragma unroll
            for (int t = 0; t < NTK; ++t)
#pragma unroll
                for (int k = 0; k < NV; ++k) { const int kk = k0 + k;
                    const int e = (int)((unsigned)__builtin_amdgcn_readlane((int)(kk < 64 ? k_lo[t] : k_hi[t]), kk & 63) >> 7);
                    va[t][k] = *(const u32x4*)((EV + (size_t)e * EROW) + l16); } };
        auto vcomp = [&](int k0, const u32x4 (&va)[NTK][NV]) {
#pragma unroll
            for (int t = 0; t < NTK; ++t)
#pragma unroll
                for (int k = 0; k < NV; ++k) { const int kk = k0 + k; if (((t * NV + k) & 1) == 0) __builtin_amdgcn_sched_barrier(0);
                    const float act = __builtin_bit_cast(float, __builtin_amdgcn_readlane(__builtin_bit_cast(int, kk < 64 ? a_lo[t] : a_hi[t]), kk & 63));
                    const u32x4 pa = va[t][k]; const unsigned pw[4] = {pa.x, pa.y, pa.z, pa.w};
#pragma unroll
                    for (int w = 0; w < 4; ++w) {
                        const f32x2 f0 = __builtin_amdgcn_cvt_scalef32_pk_f32_fp4(pw[w], 1.0f, 0), f1 = __builtin_amdgcn_cvt_scalef32_pk_f32_fp4(pw[w], 1.0f, 1), f2 = __builtin_amdgcn_cvt_scalef32_pk_f32_fp4(pw[w], 1.0f, 2), f3 = __builtin_amdgcn_cvt_scalef32_pk_f32_fp4(pw[w], 1.0f, 3);
                        out[t][8 * w + 0] = fmaf(act, f0.x, out[t][8 * w + 0]); out[t][8 * w + 1] = fmaf(act, f0.y, out[t][8 * w + 1]); out[t][8 * w + 2] = fmaf(act, f1.x, out[t][8 * w + 2]); out[t][8 * w + 3] = fmaf(act, f1.y, out[t][8 * w + 3]);
                        out[t][8 * w + 4] = fmaf(act, f2.x, out[t][8 * w + 4]); out[t][8 * w + 5] = fmaf(act, f2.y, out[t][8 * w + 5]); out[t][8 * w + 6] = fmaf(act, f3.x, out[t][8 * w + 6]); out[t][8 * w + 7] = fmaf(act, f3.y, out[t][8 * w + 7]); } }
            __builtin_amdgcn_sched_barrier(0); };
        vload(0, vaA);
#pragma unroll 1
        for (int k0 = 0; k0 < 128; k0 += 2 * NV) {
            vload(k0 + NV, vaB); __builtin_amdgcn_sched_barrier(0); vcomp(k0, vaA);
            if (k0 + 2 * NV < 128) vload(k0 + 2 * NV, vaA);
            __builtin_amdgcn_sched_barrier(0); vcomp(k0 + NV, vaB);
        }
    }
    const int lane_e = lane_id();
#pragma unroll
    for (int t = 0; t < NTK; ++t) { const int r = rows[t]; const int b = r / RPB, j = r - b * RPB; const bool isctx = j < CTX;
        float* xrow = (float*)(ws + WS_XRES) + (size_t)r * DM; const int mr = isctx ? 4 : b;
        const float* gf = MOD + ((size_t)l * 5 + mr) * NMOD + 5 * DM;
        float ss = 0.f;
#pragma unroll
        for (int i = 0; i < 8; ++i) { const int col = (lane_e + 64 * i) * 4; const f32x4 g4 = *(const f32x4*)(gf + col); f32x4 x4 = *(const f32x4*)(xrow + col);
            x4.x += g4.x * out[t][4 * i]; x4.y += g4.y * out[t][4 * i + 1]; x4.z += g4.z * out[t][4 * i + 2]; x4.w += g4.w * out[t][4 * i + 3];
            out[t][4 * i] = x4.x; out[t][4 * i + 1] = x4.y; out[t][4 * i + 2] = x4.z; out[t][4 * i + 3] = x4.w;
            ss += (x4.x * x4.x + x4.y * x4.y) + (x4.z * x4.z + x4.w * x4.w); }
        ss = wave_sum(ss); const float rstd = 1.0f / sqrtf(ss * (1.0f / DM) + EPS);
        if (l < DEPTH - 1) {
            const float* mp = MOD + ((size_t)(l + 1) * 5 + mr) * NMOD; const float* gn = A.in(6) + (l + 1) * DM; bf16_t* hw = (bf16_t*)(ws + WS_H) + (size_t)r * DM;
#pragma unroll
            for (int i = 0; i < 8; ++i) { const int col = (lane_e + 64 * i) * 4;
                *(f32x4*)(xrow + col) = (f32x4){out[t][4 * i], out[t][4 * i + 1], out[t][4 * i + 2], out[t][4 * i + 3]};
                const f32x4 g4 = *(const f32x4*)(gn + col), sh = *(const f32x4*)(mp + col), sc = *(const f32x4*)(mp + DM + col);
                *(u32x2*)(hw + col) = (u32x2){cvt_pk((out[t][4 * i] * rstd * g4.x) * (1.f + sc.x) + sh.x, (out[t][4 * i + 1] * rstd * g4.y) * (1.f + sc.y) + sh.y),
                                              cvt_pk((out[t][4 * i + 2] * rstd * g4.z) * (1.f + sc.z) + sh.z, (out[t][4 * i + 3] * rstd * g4.w) * (1.f + sc.w) + sh.w)}; }
        } else {
            float* orow = A.out() + ((size_t)b * SEQ + (j - CTX)) * DM; const float* fg = A.in(21);
#pragma unroll
            for (int i = 0; i < 8; ++i) { const int col = (lane_e + 64 * i) * 4; const f32x4 g4 = *(const f32x4*)(fg + col);
                *(f32x4*)(orow + col) = (f32x4){out[t][4 * i] * rstd * g4.x, out[t][4 * i + 1] * rstd * g4.y, out[t][4 * i + 2] * rstd * g4.z, out[t][4 * i + 3] * rstd * g4.w}; }
        }
    }
}
#ifndef PEER_NTK
#define PEER_NTK 2
#endif
__device__ __forceinline__ void peer_rows(const Ptrs& A, LAS unsigned char* L, unsigned xcc, int l, int wave, int bid, int G) { asm volatile("" : "+s"(wave));
    unsigned char* ws = A.ws(); LAUNDER_G(ws); const int gw = bid + G * wave, NGW = G * NWAVES;
    for (int r = gw; r < NTOK; ) {
        const int lane = lane_id();
        int rr[3] = {-1, -1, -1}; int n = 0;
#pragma unroll
        for (int t = 0; t < PEER_NTK; ++t) { while (r < NTOK && rr[t] < 0) { if (!(l == DEPTH - 1 && (r % RPB) < CTX)) { rr[t] = r; ++n; } r += NGW; } }
        if (n == 0) break;
        LAS unsigned char* HL = L + PEER_H4 + wave * 4096;
        if (n >= 2) { const int rows[2] = {rr[0], rr[1]}; peer_tokens<2>(A, ws, HL, rows, l, lane); }
        else { const int rows[1] = {rr[0]}; peer_tokens<1>(A, ws, HL, rows, l, lane); }
    }
}

__device__ __forceinline__ void norm2_rows(const Ptrs& A, int l, int wave, int bid, int G) { asm volatile("" : "+s"(wave)); const int lane = lane_id();
    unsigned char* ws = A.ws(); LAUNDER_G(ws); const int gw = bid + G * wave, NGW = G * NWAVES; const float* MOD = (const float*)(ws + WS_MOD);
    for (int r = gw; r < NTOK; r += NGW) {
        float v[4][8]; row_load_f32((const float*)(ws + WS_XRES) + (size_t)r * DM, lane, v);
        const float rstd = row_rstd(v); const float* mp = MOD + ((size_t)l * 5 + modrow(r)) * NMOD;
        norm_mod_store(v, rstd, A.in(7) + l * DM, mp + 3 * DM, mp + 4 * DM, (bf16_t*)(ws + WS_H) + (size_t)r * DM, lane);
    }
}

constexpr int PH_P0A = 0, PH_P0B = 1, PH_L0 = 2, NPL = 9, N_PHASES = PH_L0 + DEPTH * NPL;
__global__ void __launch_bounds__(NTHR, 2) mk_fwd(Args args) {
    extern __shared__ __attribute__((aligned(16))) unsigned char lds_raw[];
    LAS unsigned char* L = (LAS unsigned char*)lds_raw;
    const int wave = __builtin_amdgcn_readfirstlane(threadIdx.x >> 6), bid = blockIdx.x, G = gridDim.x;
    if (wave == 0) { const int ln = lane_id(); if (ln < 16) ((LAS unsigned*)(L + LDS_CTL_OFF))[ln] = 0u;
        if (ln == 0) { LAS unsigned long long* pt = (LAS unsigned long long*)(L + LDS_CTL_OFF + 64);
#pragma unroll
            for (int i = 0; i < 22; ++i) pt[i] = (unsigned long long)(uintptr_t)args.in[i];
            pt[22] = (unsigned long long)(uintptr_t)args.out; pt[23] = (unsigned long long)(uintptr_t)args.ws; } }
    __syncthreads();
    const Ptrs PT{L};
    unsigned* ctl = (unsigned*)(PT.ws() + WS_CTL);
    XcdBarrier bar; bar.bar = ctl + CW_BAR; bar.x = 0; bar.st = nullptr; bar.wv = (unsigned)wave;
#if !MK_MULTI
    bar = xcd_barrier_post(ctl + CW_BAR, (volatile LAS unsigned*)(L + LDS_CTL_OFF) + 8);
    bar.wv = (unsigned)wave;
#endif
    const int lo = args.ph_lo, hi = args.ph_hi;
#ifndef PH_MASK
#define PH_MASK 0x7ff
#endif
#define PHSEL(n) (((PH_MASK) >> (n)) & 1)
#define IN(k) (lo <= (k) && (k) < hi)
#if MK_MULTI
#define SEAM(k) do { } while (0)
#else
#define SEAM(k) do { if (IN(k) && IN((k) + 1)) xcd_barrier(bar); } while (0)
#endif
    if (PHSEL(0) && IN(PH_P0A)) p0a(PT, L, wave, bid, G);
    SEAM(PH_P0A);
    if (PHSEL(1) && IN(PH_P0B)) p0b(PT, wave, bid, G);
    SEAM(PH_P0B);
    for (int l = 0; l < DEPTH; ++l) {
        const int pb = PH_L0 + l * NPL;
        if (PHSEL(2) && IN(pb + 0)) {
            unsigned char* ws = PT.ws(); LAUNDER_G(ws);
            pg8::Gemm g{(const bf16_t*)(ws + WS_H), (const bf16_t*)(ws + WS_WIN) + (size_t)l * PW * DM, NTOK, PW, DM, DM, DM};
            pg8::StaticOrder S; S.init(NTOK, PW, G, bid);
            pg8::EpiBf16<0> E{(bf16_t*)(ws + WS_P), PW, nullptr, 0, 0, 1.f};
#ifndef DBL_GIN
#define DBL_GIN 1
#endif
            for (int rep = 0; rep < DBL_GIN; ++rep)
            pg8::gemm_phase<pg8::EpiBf16<0>, pg8::StaticOrder, true, true>(L, g, S, E, wave);
#ifndef DBL_SIDE
#define DBL_SIDE 1
#endif
            for (int rep = 0; rep < DBL_SIDE; ++rep)
            side_gemm(PT, L, l, wave, bid, G);
        }
        SEAM(pb + 0);
        if (PHSEL(3) && IN(pb + 1)) {
            unsigned char* ws = PT.ws(); LAUNDER_G(ws);
#ifndef NO_THIN
            thin_rows(PT, l, wave, bid, G);
#endif
#ifndef NO_G1
#ifndef DBL_GLA
#define DBL_GLA 1
#endif
#ifndef DBL_G1
#define DBL_G1 DBL_GLA
#endif
            for (int rep = 0; rep < DBL_G1; ++rep)
            for (int u = bid; u < NGU; u += G) gla_g1(PT, L, l, u, wave);
#endif
        }
        SEAM(pb + 1);
        if (PHSEL(4) && IN(pb + 2)) {
            unsigned char* ws = PT.ws(); LAUNDER_G(ws);
#ifndef NO_UQ
            { pg8::Gemm g{(const bf16_t*)(ws + WS_P) + P_CQ, (const bf16_t*)(ws + WS_WUQ) + (size_t)l * 1536 * 512, NTOK, 1536, 512, PW, 512};
              pg8::StaticOrder S; S.init(NTOK, 1536, G, bid);
              pg8::EpiQRope E{(bf16_t*)(ws + WS_Q), (const float*)(ws + WS_ROPE), (const float*)(ws + WS_ROPE) + SEQ * 32};
              pg8::gemm_phase<pg8::EpiQRope, pg8::StaticOrder, true, true>(L, g, S, E, wave); }
#endif
#ifndef NO_UKV
            { pg8::Gemm g{(const bf16_t*)(ws + WS_P) + P_CKV, (const bf16_t*)(ws + WS_WUKV) + (size_t)l * 2048 * 256, NTOK, 2048, 256, PW, 256};
              pg8::LatentOrder S; S.init(2048, G, bid);
              pg8::EpiBf16<0> E{(bf16_t*)(ws + WS_KV), 2048, nullptr, 0, 0, 1.f};
              pg8::gemm_phase<pg8::EpiBf16<0>, pg8::LatentOrder, true, true>(L, g, S, E, wave);
              bf16_t* KVo = (bf16_t*)(ws + WS_KV);
              ctx_gemm(L, (const bf16_t*)(ws + WS_P) + P_CKV, PW, (const bf16_t*)(ws + WS_WUKV) + (size_t)l * 2048 * 256, 256, 2048, 256, wave, bid, G, [=](int row, int col, float v) { KVo[(size_t)row * 2048 + col] = f2bf_safe(v); }); }
#endif
#ifndef NO_G2
#ifndef DBL_G2
#define DBL_G2 DBL_GLA
#endif
            for (int rep = 0; rep < DBL_G2; ++rep) gla_g2(PT, wave, bid, G);
#endif
        }
        SEAM(pb + 2);
        if (PHSEL(5) && IN(pb + 3)) {
            unsigned char* ws = PT.ws(); LAUNDER_G(ws);
            const bf16_t* Q = (const bf16_t*)(ws + WS_Q); const bf16_t* KV = (const bf16_t*)(ws + WS_KV); const bf16_t* KR = (const bf16_t*)(ws + WS_KR); bf16_t* MIX = (bf16_t*)(ws + WS_MIX);
            const int nau = NB * 8 * 16 + (l < DEPTH - 1 ? NB * 8 : 0);
#ifndef DBL_ATT
#define DBL_ATT 1
#endif
#ifndef DBL_G3
#define DBL_G3 DBL_GLA
#endif
            const bool g3first = ((bid >> 3) & 1) != 0;
            for (int step = 0; step < 2; ++step) {
                if ((step == 0) == g3first) {
            for (int rep = 0; rep < DBL_G3; ++rep)
            for (int u = G - 1 - bid; u < NGU; u += G) gla_g3(PT, L, l, u, wave);
                } else {
            for (int rep = 0; rep < DBL_ATT; ++rep)
            for (int u = bid; u < nau; u += G) {
                int b, h, q0, nk;
                if (u < NB * 8 * 16) {
                    int uu = u; if ((G & 7) == 0 && G * 2 == NB * 8 * 16) { const int xcd = bid & 7, idx = (bid >> 3) + (G >> 3) * (u / G); uu = (4 * xcd + (idx >> 4)) * 16 + (idx & 15); }
                    b = uu >> 7; h = (uu >> 4) & 7; q0 = b * RPB + CTX + (uu & 15) * 256; nk = RPB; }
                else { const int v = u - NB * 8 * 16; b = v >> 3; h = v & 7; q0 = b * RPB; nk = CTX; }
                att::attn_unit(Q + (size_t)q0 * 1536 + h * 192, KV + (size_t)b * RPB * 2048 + h * 256, KR + (size_t)b * RPB * 64, KV + (size_t)b * RPB * 2048 + h * 256 + 128,
                               MIX + (size_t)q0 * DM + h * 128, nk, L, wave);
            }
                }
            }
        }
        SEAM(pb + 3);
        if (PHSEL(6) && IN(pb + 4)) {
            unsigned char* ws = PT.ws(); LAUNDER_G(ws);
            pg8::Gemm g{(const bf16_t*)(ws + WS_MIX), (const bf16_t*)(ws + WS_WOUT) + (size_t)l * DM * DM, NTOK, DM, DM, DM, DM};
            pg8::LatentOrder S; S.init(DM, G, bid);
            pg8::EpiResid E{(float*)(ws + WS_XRES), (const float*)(ws + WS_MOD) + (size_t)l * 5 * NMOD + 2 * DM};
            const bool cfirst = ((bid >> 3) & 1) != 0 && (l < DEPTH - 1);
            float* X = (float*)(ws + WS_XRES); const float* gate = (const float*)(ws + WS_MOD) + ((size_t)l * 5 + 4) * NMOD + 2 * DM;
            for (int step = 0; step < 2; ++step) {
                if ((step == 0) != cfirst) pg8::gemm_phase<pg8::EpiResid, pg8::LatentOrder, true, true>(L, g, S, E, wave);
                else if (l < DEPTH - 1) {
                ctx_gemm(L, (const bf16_t*)(ws + WS_MIX), DM, (const bf16_t*)(ws + WS_WOUT) + (size_t)l * DM * DM, DM, DM, DM, wave, bid, G, [=](int row, int col, float v) { X[(size_t)row * DM + col] += gate[col] * v; });
                }
            }
        }
        SEAM(pb + 4);
        if (PHSEL(7) && IN(pb + 5)) norm2_rows(PT, l, wave, bid, G);
        SEAM(pb + 5);
        if (PHSEL(8) && IN(pb + 6)) {
            unsigned char* ws = PT.ws(); LAUNDER_G(ws);
            pg8::Gemm g{(const bf16_t*)(ws + WS_H), (const bf16_t*)(ws + WS_WQRY) + (size_t)l * DM * DM, NTOK, DM, DM, DM, DM};
            pg8::LatentOrder S; S.init(DM, G, bid);
            pg8::EpiBf16<0> E{(bf16_t*)(ws + WS_QP), DM, nullptr, 0, 0, 1.f};
            pg8::gemm_phase<pg8::EpiBf16<0>, pg8::LatentOrder, true, true>(L, g, S, E, wave);
            if (l < DEPTH - 1) { bf16_t* QPo = (bf16_t*)(ws + WS_QP);
                ctx_gemm(L, (const bf16_t*)(ws + WS_H), DM, (const bf16_t*)(ws + WS_WQRY) + (size_t)l * DM * DM, DM, DM, DM, wave, bid, G, [=](int row, int col, float v) { QPo[(size_t)row * DM + col] = f2bf_safe(v); }); }
        }
        SEAM(pb + 6);
#ifndef DBL_TOPK
#define DBL_TOPK 1
#endif
        if (PHSEL(9) && IN(pb + 7)) { for (int rep = 0; rep < DBL_TOPK; ++rep) { peer_topk_phase(PT, L, l, wave, bid, G); __syncthreads(); } }
        SEAM(pb + 7);
        if (PHSEL(10) && IN(pb + 8)) peer_rows(PT, L, bar.x, l, wave, bid, G);
        SEAM(pb + 8);
    }
}

extern "C" void kernel_launch(void* const* d_in, const int* in_sizes, int n_in, void* d_out, int out_size, void* d_ws, size_t ws_size, hipStream_t stream) {
    static int grid = 0;
    if (grid == 0) {
        if (n_in != 22 || out_size != NB * SEQ * DM || ws_size < WS_END) { fprintf(stderr, "kernel_launch: unexpected shapes: n_in %d out %d ws %zu (need %zu)\n", n_in, out_size, ws_size, (size_t)WS_END); grid = -1; return; }
        int dev = 0, cus = 0, per_cu = 0;
        if (hipGetDevice(&dev) != hipSuccess || hipDeviceGetAttribute(&cus, hipDeviceAttributeMultiprocessorCount, dev) != hipSuccess) { grid = -1; return; }
        if (hipFuncSetAttribute((const void*)mk_fwd, hipFuncAttributeMaxDynamicSharedMemorySize, LDS_BYTES) != hipSuccess) { fprintf(stderr, "kernel_launch: hipFuncSetAttribute failed\n"); grid = -1; return; }
        if (hipOccupancyMaxActiveBlocksPerMultiprocessor(&per_cu, mk_fwd, NTHR, LDS_BYTES) != hipSuccess || per_cu < 1) { fprintf(stderr, "kernel_launch: occupancy query says %d\n", per_cu); grid = -1; return; }
        grid = cus;
    }
    if (grid < 0) return;
    (void)hipMemsetAsync((char*)d_ws + WS_CTL, 0, CTL_BYTES, stream);
    Args a{};
    for (int i = 0; i < 22; ++i) a.in[i] = (const float*)d_in[i];
    a.out = (float*)d_out; a.ws = (unsigned char*)d_ws;
#if MK_MULTI
    for (int p = 0; p < N_PHASES; ++p) { a.ph_lo = p; a.ph_hi = p + 1; hipLaunchKernelGGL(mk_fwd, dim3(grid), dim3(NTHR), LDS_BYTES, stream, a); }
#else
    a.ph_lo = 0; a.ph_hi = N_PHASES;
    hipLaunchKernelGGL(mk_fwd, dim3(grid), dim3(NTHR), LDS_BYTES, stream, a);
#endif
    const hipError_t le = hipPeekAtLastError();
    if (le != hipSuccess) fprintf(stderr, "kernel_launch: launch failed: %s\n", hipGetErrorName(le));
}
```

```cpp
#include <hip/hip_runtime.h>
#include <cstdio>
#include <cstdint>

#ifndef MK_MULTI
#define MK_MULTI 0
#endif

#define GAS __attribute__((address_space(1)))
#define LAS __attribute__((address_space(3)))
typedef unsigned short bf16_t;
typedef short bf16x8 __attribute__((ext_vector_type(8)));
typedef short s16x4 __attribute__((ext_vector_type(4)));
typedef float f32x2 __attribute__((ext_vector_type(2)));
typedef float f32x4 __attribute__((ext_vector_type(4)));
typedef float f32x16 __attribute__((ext_vector_type(16)));
typedef unsigned u32x2 __attribute__((ext_vector_type(2)));
typedef unsigned u32x4 __attribute__((ext_vector_type(4)));
typedef __bf16 bf16v2 __attribute__((ext_vector_type(2)));
typedef unsigned u32x6 __attribute__((ext_vector_type(6)));
typedef float f32x32 __attribute__((ext_vector_type(32)));
typedef __bf16 bf16x32v __attribute__((ext_vector_type(32)));
typedef unsigned u32x16 __attribute__((ext_vector_type(16)));

constexpr int DM = 2048, NB = 4, SEQ = 4096, CTX = 256, RPB = SEQ + CTX, NTOK = NB * RPB, DEPTH = 4;
constexpr int NMOD = 6 * DM;
constexpr int PW = 3840;
constexpr int P_CQ = 0, P_CKV = 512, P_GQ = 768, P_GK = 1280, P_GV = 1792, P_GG = 2816;
constexpr int SIDEW = 96;
constexpr int NCH = RPB / 64;
constexpr int NGU = NB * 4 * NCH;
constexpr int NEXP = 16384;
constexpr float EPS = 1e-6f;
constexpr int NTHR = 512, NWAVES = 8;

constexpr size_t al256(size_t x) { return (x + 255) & ~(size_t)255; }
constexpr size_t WS_CTL = 0, CTL_BYTES = 1u << 20;
constexpr size_t WS_MOD = WS_CTL + CTL_BYTES;
constexpr size_t WS_ROPE = WS_MOD + al256((size_t)DEPTH * 5 * NMOD * 4);
constexpr size_t WS_WIN = WS_ROPE + al256((size_t)2 * SEQ * 32 * 4);
constexpr size_t WS_WSIDE = WS_WIN + (size_t)DEPTH * PW * DM * 2;
constexpr size_t WS_WUQ = WS_WSIDE + (size_t)DEPTH * SIDEW * DM * 2;
constexpr size_t WS_WUKV = WS_WUQ + (size_t)DEPTH * 1536 * 512 * 2;
constexpr size_t WS_WOUT = WS_WUKV + (size_t)DEPTH * 2048 * 256 * 2;
constexpr size_t WS_WQRY = WS_WOUT + (size_t)DEPTH * DM * DM * 2;
constexpr size_t WS_SUBK = WS_WQRY + (size_t)DEPTH * DM * DM * 2;
constexpr int EROW = 1024;
constexpr size_t WS_EU = WS_SUBK + (size_t)DEPTH * 2 * 8 * 128 * 128 * 2;
constexpr size_t WS_EV = WS_EU + (size_t)DEPTH * NEXP * EROW;
constexpr size_t WS_SU = WS_EV + (size_t)DEPTH * NEXP * EROW;
constexpr size_t WS_SV = WS_SU + (size_t)DEPTH * NEXP * 4;
constexpr size_t WS_XRES = WS_SV + (size_t)DEPTH * NEXP * 4;
constexpr size_t WS_H = WS_XRES + (size_t)NTOK * DM * 4;
constexpr size_t WS_P = WS_H + (size_t)NTOK * DM * 2;
constexpr size_t WS_SIDE = WS_P + (size_t)NTOK * PW * 2;
constexpr size_t WS_Q = WS_SIDE + (size_t)NTOK * SIDEW * 4;
constexpr size_t WS_KV = WS_Q + (size_t)NTOK * 1536 * 2;
constexpr size_t WS_KR = WS_KV + (size_t)NTOK * 2048 * 2;
constexpr size_t WS_MIX = WS_KR + (size_t)NTOK * 64 * 2;
constexpr size_t WS_QDEC = WS_MIX + (size_t)NTOK * DM * 2;
constexpr size_t WS_OINTRA = WS_QDEC + (size_t)NGU * 2 * 64 * 128 * 2;
constexpr size_t WS_DS = WS_OINTRA + (size_t)NTOK * 1024 * 4;
constexpr size_t WS_DEC = WS_DS + (size_t)2 * 16 * NCH * 32768 * 2;
constexpr size_t WS_SENT = WS_DEC + al256((size_t)2 * 16 * NCH * 128 * 4);
constexpr size_t WS_QP = WS_SENT + (size_t)2 * 16 * NCH * 32768 * 2;
constexpr size_t WS_IDX = WS_QP + (size_t)NTOK * DM * 2;
constexpr size_t WS_GATE = WS_IDX + (size_t)NTOK * 128 * 4;
constexpr size_t WS_END = WS_GATE + (size_t)NTOK * 128 * 4;

constexpr int CW_DBG = 8;
constexpr int CW_BAR = 4096;
constexpr int CW_RND = 8192;

constexpr int LDS_BYTES = 163840;
constexpr int LDS_CTL_OFF = LDS_BYTES - 256;

__device__ __forceinline__ unsigned cvt_pk(float lo, float hi) { unsigned r; asm volatile("v_cvt_pk_bf16_f32 %0, %1, %2" : "=v"(r) : "v"(lo), "v"(hi)); return r; }
__device__ __forceinline__ unsigned cvt_pk_safe(float lo, float hi) { const f32x2 v = {lo, hi}; const bf16v2 b = __builtin_convertvector(v, bf16v2); return __builtin_bit_cast(unsigned, b); }
__device__ __forceinline__ unsigned cvt_pk_asm(float lo, float hi) { unsigned r; asm volatile("v_cvt_pk_bf16_f32 %0, %1, %2" : "=v"(r) : "v"(lo), "v"(hi)); return r; }
__device__ __forceinline__ float bflo(unsigned w) { return __builtin_bit_cast(float, w << 16); }
__device__ __forceinline__ float bfhi(unsigned w) { return __builtin_bit_cast(float, w & 0xffff0000u); }
__device__ __forceinline__ float bf2f(bf16_t b) { return __builtin_bit_cast(float, (unsigned)b << 16); }
__device__ __forceinline__ bf16_t f2bf_safe(float f) { return (bf16_t)(cvt_pk_safe(f, 0.f) & 0xffffu); }
__device__ __forceinline__ bf16_t f2bf(float f) { return (bf16_t)(cvt_pk(f, 0.f) & 0xffffu); }
#define DPP_I(v, ctrl) __builtin_amdgcn_update_dpp(0, (v), (ctrl), 0xF, 0xF, true)
__device__ __forceinline__ int lane_id();
__device__ __forceinline__ int shx_i(int v, int o) {
    switch (o) {
    case 1: return DPP_I(v, 0xB1);
    case 2: return DPP_I(v, 0x4E);
    case 4: return DPP_I(DPP_I(v, 0x1B), 0x141);
    case 8: return DPP_I(v, 0x128);
    default: return __builtin_amdgcn_ds_bpermute((lane_id() ^ o) << 2, v);
    }
}
__device__ __forceinline__ float shx_f(float v, int o) { return __builtin_bit_cast(float, shx_i(__builtin_bit_cast(int, v), o)); }
#define DPP_F(v, ctrl) __builtin_bit_cast(float, DPP_I(__builtin_bit_cast(int, (v)), (ctrl)))
#define RL_F(v, l) __builtin_bit_cast(float, __builtin_amdgcn_readlane(__builtin_bit_cast(int, (v)), (l)))
__device__ __forceinline__ float wave_sum(float v) {
    v += DPP_F(v, 0xB1); v += DPP_F(v, 0x4E); v += DPP_F(v, 0x141); v += DPP_F(v, 0x140);
    return (RL_F(v, 0) + RL_F(v, 16)) + (RL_F(v, 32) + RL_F(v, 48));
}
__device__ __forceinline__ float wave_max(float v) {
    v = fmaxf(v, DPP_F(v, 0xB1)); v = fmaxf(v, DPP_F(v, 0x4E)); v = fmaxf(v, DPP_F(v, 0x141)); v = fmaxf(v, DPP_F(v, 0x140));
    return fmaxf(fmaxf(RL_F(v, 0), RL_F(v, 16)), fmaxf(RL_F(v, 32), RL_F(v, 48)));
}
__device__ __forceinline__ int wave_sum_i(int v) {
    v += DPP_I(v, 0xB1); v += DPP_I(v, 0x4E); v += DPP_I(v, 0x141); v += DPP_I(v, 0x140);
    return (__builtin_amdgcn_readlane(v, 0) + __builtin_amdgcn_readlane(v, 16)) + (__builtin_amdgcn_readlane(v, 32) + __builtin_amdgcn_readlane(v, 48));
}
__device__ __forceinline__ int crow(int r, int hi) { return (r & 3) + 8 * (r >> 2) + 4 * hi; }
__device__ __forceinline__ int modrow(int r) { const int b = r / RPB; return (r - b * RPB) < CTX ? 4 : b; }
__device__ __forceinline__ int lane_id() { int l; asm volatile("v_mbcnt_lo_u32_b32 %0, -1, 0\n\tv_mbcnt_hi_u32_b32 %0, -1, %0" : "=&v"(l)); return l; }
#define LDS_WAIT() asm volatile("s_waitcnt lgkmcnt(0)" ::: "memory")
#define VM_WAIT() asm volatile("s_waitcnt vmcnt(0)" ::: "memory")
#define SBAR() __builtin_amdgcn_sched_barrier(0)
#define LAUNDER_G(p) do { GAS unsigned char* _g = (GAS unsigned char*)(p); asm volatile("" : "+s"(_g)); (p) = (unsigned char*)_g; } while (0)

namespace pg8 {
#define PG8_LAS __attribute__((address_space(3)))
typedef unsigned short bf16_t;
typedef short bf16x8 __attribute__((ext_vector_type(8)));
typedef float f32x4 __attribute__((ext_vector_type(4)));
typedef unsigned u32x4 __attribute__((ext_vector_type(4)));
constexpr int BM = 256, BK = 64, HALF = 128, HTB = HALF * BK * 2  , STAGE_BYTES = 8 * HTB, NXCD = 8, WGM = 8;

__host__ __device__ __forceinline__ int lds_byte(int r, int c) { const int st = (r >> 4) * 2 + (c >> 5), rr = r & 15, cc = c & 31, ob = rr * 64 + cc * 2; return st * 1024 + (ob ^ (((ob >> 9) & 1) << 5)); }
__host__ __device__ __forceinline__ void stage_rc(int b, int& R, int& C) { const int st = b / 1024, sb = b % 1024, swz = sb ^ (((sb >> 9) & 1) << 5); R = (st >> 1) * 16 + swz / 64; C = (st & 1) * 32 + (swz % 64) / 2; }
__host__ __device__ __forceinline__ int perm32(int rho) { const int n = rho >> 4, i = rho & 15; return 8 * (i >> 2) + 4 * n + (i & 3); }

struct Unit { int pm, pn; };
struct Gemm { const bf16_t* A; const bf16_t* Bt; int M, N, K, lda, ldb; };

struct StaticOrder {
    int nM, nN, nwg, G, c;
    __host__ __device__ void init(int M, int N, int G_, int c_) { nM = M / BM; nN = N / BM; nwg = nM * nN; G = G_; c = c_; }
    __host__ __device__ bool next(int i, Unit& u) const {
        const long L = (long)i * G + c; if (L >= nwg) return false;
        int wgid = (int)L; { const int q = nwg / NXCD, r = nwg % NXCD, xcd = wgid % NXCD, off = wgid / NXCD; wgid = (xcd < r ? xcd * (q + 1) : r * (q + 1) + (xcd - r) * q) + off; }
        const int nig = WGM * nN, gid = wgid / nig, fm = gid * WGM, gsz = (nM - fm) < WGM ? (nM - fm) : WGM;
        u.pm = fm + ((wgid % nig) % gsz); u.pn = (wgid % nig) / gsz; return true;
    }
    __device__ __forceinline__ void a_ready(const Unit&) const {}
    __device__ __forceinline__ void done(const Unit&) const {}
};
struct LatentOrder : StaticOrder {
    __host__ __device__ void init(int N, int G_, int c_) { StaticOrder::init(16384, N, G_, c_); }
    __host__ __device__ bool next(int i, Unit& u) const { if (!StaticOrder::next(i, u)) return false; u.pm = u.pm + (u.pm >> 4) + 1; return true; }
};


__device__ __forceinline__ unsigned cvt_pk_bf16(float lo, float hi) { return ::cvt_pk_asm(lo, hi); }

template <int ACT  > struct EpiBf16 {
    static constexpr bool PERM = true, AFTER_DRAIN = false; static_assert(ACT == 0, "EpiBf16: no activation here");
    bf16_t* O; int ldc; const float* bias; int split_cols; size_t split_stride; float scale0;
    __device__ __forceinline__ void operator()(const f32x4 (&acc)[2][2][4][2], const Unit& u, int wr, int wc, int fr, int fq) const {
        const int row0 = u.pm * BM + wr * 64 + fr; int colt = u.pn * BM; bf16_t* base = O;
        float sc = 1.f; if (split_cols) { const int t = colt / split_cols; base += (size_t)t * split_stride; colt -= t * split_cols; if (t == 0) sc = scale0; }
        const int col0 = colt + wc * 32 + 8 * fq, bcol0 = u.pn * BM + wc * 32 + 8 * fq;
        f32x4 bv[2][2];
#pragma unroll
        for (int bj = 0; bj < 2; ++bj)
#pragma unroll
            for (int n = 0; n < 2; ++n) bv[bj][n] = bias ? *(const f32x4*)(bias + bcol0 + bj * HALF + 4 * n) : (f32x4){0.f, 0.f, 0.f, 0.f};
#pragma unroll
        for (int ai = 0; ai < 2; ++ai)
#pragma unroll
            for (int m = 0; m < 4; ++m) { bf16_t* rowp = base + (size_t)(row0 + ai * HALF + m * 16) * ldc + col0;
#pragma unroll
                for (int bj = 0; bj < 2; ++bj) { f32x4 v0 = acc[ai][bj][m][0] + bv[bj][0], v1 = acc[ai][bj][m][1] + bv[bj][1];
                    v0 = v0 * sc; v1 = v1 * sc; u32x4 w; w.x = cvt_pk_bf16(v0[0], v0[1]); w.y = cvt_pk_bf16(v0[2], v0[3]); w.z = cvt_pk_bf16(v1[0], v1[1]); w.w = cvt_pk_bf16(v1[2], v1[3]);
                    *(u32x4*)(rowp + bj * HALF) = w; } }
    }
};


template <class Epi, class Sched, bool ALIGN_EPI = false, bool SP2 = false>
__device__ __forceinline__ void gemm_phase(PG8_LAS unsigned char* lds, const Gemm g, const Sched& S, const Epi& E, int wid) {
    asm volatile("" : "+s"(wid));
    const int lane = lane_id(), tid = wid * 64 + lane, wr = wid >> 2, wc = wid & 3, fr = lane & 15, fq = lane >> 4;
    const int K = g.K, nt = K / BK;
    unsigned voffA[2], voffB[2];
#pragma unroll
    for (int i = 0; i < 2; ++i) { int R, C; stage_rc(tid * 16 + i * 8192, R, C); const int Rb = Epi::PERM ? ((R & ~31) + perm32(R & 31)) : R;
        voffA[i] = (unsigned)(R * g.lda + C) * 2u; voffB[i] = (unsigned)(Rb * g.ldb + C) * 2u; }
    const size_t kstep = (size_t)(BK * 2);
    const size_t hstepA = (size_t)HALF * g.lda * 2, hstepB = (size_t)HALF * g.ldb * 2;
    const size_t tstepA = 2 * hstepA, tstepB = 2 * hstepB;
    const unsigned ldsw = (unsigned)wid * 1024u;
    const int aoff = lds_byte(wr * 64 + fr, fq * 8), boff = lds_byte(wc * 32 + fr, fq * 8);
#define PG8_SA(b, h) (((b) * 2 + (h)) * HTB)
#define PG8_SB(b, h) ((4 + (b) * 2 + (h)) * HTB)
#define PG8_STAGE(bufoff, gbase, voff) do { _Pragma("unroll") for (int _i = 0; _i < 2; ++_i) \
        __builtin_amdgcn_global_load_lds((const unsigned*)((const char*)(gbase) + (voff)[_i]), (PG8_LAS unsigned*)(lds + (bufoff) + ldsw + _i * 8192), 16, 0, 0); } while (0)
#define PG8_LDA(dst, b, h) do { _Pragma("unroll") for (int m = 0; m < 4; ++m) _Pragma("unroll") for (int k = 0; k < 2; ++k) dst[m][k] = *(const PG8_LAS bf16x8*)(lds + PG8_SA(b, h) + aoff + m * 2048 + k * 1024); } while (0)
#define PG8_LDB(dst, b, h) do { _Pragma("unroll") for (int n = 0; n < 2; ++n) _Pragma("unroll") for (int k = 0; k < 2; ++k) dst[n][k] = *(const PG8_LAS bf16x8*)(lds + PG8_SB(b, h) + boff + n * 2048 + k * 1024); } while (0)
#define PG8_MMA(ai, bj, At, Bt) do { __builtin_amdgcn_s_setprio(1); _Pragma("unroll") for (int m = 0; m < 4; ++m) _Pragma("unroll") for (int n = 0; n < 2; ++n) _Pragma("unroll") for (int k = 0; k < 2; ++k) \
        acc[ai][bj][m][n] = __builtin_amdgcn_mfma_f32_16x16x32_bf16(Bt[n][k], At[m][k], acc[ai][bj][m][n], 0, 0, 0); __builtin_amdgcn_s_setprio(0); } while (0)
#define PG8_WAIT_V(n) asm volatile("s_waitcnt vmcnt(" #n ")" ::: "memory")
#define PG8_WAIT_L(n) asm volatile("s_waitcnt lgkmcnt(" #n ")" ::: "memory")
#define PG8_BAR __builtin_amdgcn_s_barrier()
#define PG8_SCHED __builtin_amdgcn_sched_barrier(0)
    Unit cur, nxt; int ui = 0;
    if (!S.next(0, cur)) return;
    f32x4 acc[2][2][4][2];
#pragma unroll
    for (int a = 0; a < 2; ++a)
#pragma unroll
        for (int b = 0; b < 2; ++b)
#pragma unroll
            for (int m = 0; m < 4; ++m)
#pragma unroll
                for (int n = 0; n < 2; ++n) acc[a][b][m][n] = (f32x4){0.f, 0.f, 0.f, 0.f};
    bf16x8 At[4][2], B0[2][2], B1[2][2];
    const char* cA = (const char*)g.A + (size_t)cur.pm * tstepA; const char* cB = (const char*)g.Bt + (size_t)cur.pn * tstepB;
    S.a_ready(cur);
    if constexpr (SP2) {
        PG8_STAGE(PG8_SB(0, 0), cB, voffB); PG8_STAGE(PG8_SB(0, 1), cB + hstepB, voffB); PG8_STAGE(PG8_SA(0, 0), cA, voffA); PG8_STAGE(PG8_SA(0, 1), cA + hstepA, voffA);
        if (wr == 1) PG8_BAR;
        PG8_WAIT_V(2); PG8_BAR;
        PG8_STAGE(PG8_SB(1, 0), cB + kstep, voffB); PG8_STAGE(PG8_SA(1, 0), cA + kstep, voffA); PG8_STAGE(PG8_SB(1, 1), cB + hstepB + kstep, voffB);
        PG8_WAIT_V(6); PG8_BAR;
    } else {
        PG8_STAGE(PG8_SB(0, 0), cB, voffB); PG8_STAGE(PG8_SA(0, 0), cA, voffA); PG8_STAGE(PG8_SB(0, 1), cB + hstepB, voffB); PG8_STAGE(PG8_SA(0, 1), cA + hstepA, voffA);
        if (wr == 1) PG8_BAR;
        PG8_WAIT_V(4); PG8_BAR;
        PG8_STAGE(PG8_SB(1, 0), cB + kstep, voffB); PG8_STAGE(PG8_SA(1, 0), cA + kstep, voffA); PG8_STAGE(PG8_SB(1, 1), cB + hstepB + kstep, voffB);
        PG8_WAIT_V(6); PG8_BAR;
    }
    for (;;) {
        const bool has_next = S.next(ui + 1, nxt);
        const char* nA = has_next ? (const char*)g.A + (size_t)nxt.pm * tstepA : cA; const char* nB = has_next ? (const char*)g.Bt + (size_t)nxt.pn * tstepB : cB;
#pragma unroll 1
        for (int t = 0; t < nt; t += 2) {
            const bool last = (t == nt - 2);
            const char* a1 = cA + (size_t)(t + 1) * kstep;
            const char* a2 = last ? nA : cA + (size_t)(t + 2) * kstep; const char* b2 = last ? nB : cB + (size_t)(t + 2) * kstep;
            const char* a3 = a2 + kstep; const char* b3 = b2 + kstep;
            if (last && has_next) S.a_ready(nxt);
            if constexpr (SP2) {
            PG8_LDB(B0, 0, 0); PG8_LDB(B1, 0, 1); PG8_SCHED; PG8_LDA(At, 0, 0); PG8_STAGE(PG8_SA(1, 1), a1 + hstepA, voffA);
            PG8_WAIT_V(8); PG8_WAIT_L(0); PG8_BAR; PG8_MMA(0, 0, At, B0); PG8_MMA(0, 1, At, B1); PG8_BAR; PG8_SCHED;
            PG8_LDA(At, 0, 1); PG8_STAGE(PG8_SB(0, 0), b2, voffB); PG8_STAGE(PG8_SB(0, 1), b2 + hstepB, voffB); PG8_STAGE(PG8_SA(0, 0), a2, voffA);
            PG8_WAIT_V(8); PG8_WAIT_L(0); PG8_BAR; PG8_MMA(1, 0, At, B0); PG8_MMA(1, 1, At, B1); PG8_BAR; PG8_SCHED;
            PG8_LDB(B0, 1, 0); PG8_LDB(B1, 1, 1); PG8_SCHED; PG8_LDA(At, 1, 0); PG8_STAGE(PG8_SA(0, 1), a2 + hstepA, voffA);
            PG8_WAIT_V(8); PG8_WAIT_L(0); PG8_BAR; PG8_MMA(0, 0, At, B0); PG8_MMA(0, 1, At, B1); PG8_BAR; PG8_SCHED;
            PG8_LDA(At, 1, 1); PG8_STAGE(PG8_SB(1, 0), b3, voffB); PG8_STAGE(PG8_SB(1, 1), b3 + hstepB, voffB); PG8_STAGE(PG8_SA(1, 0), a3, voffA);
            PG8_WAIT_V(8); PG8_WAIT_L(0); PG8_BAR; PG8_MMA(1, 0, At, B0); PG8_MMA(1, 1, At, B1); PG8_BAR; PG8_SCHED;
            } else {
            PG8_LDB(B0, 0, 0); PG8_SCHED; PG8_LDA(At, 0, 0); PG8_STAGE(PG8_SA(1, 1), a1 + hstepA, voffA);
            PG8_WAIT_L(8); PG8_BAR; PG8_WAIT_L(0); PG8_MMA(0, 0, At, B0); PG8_BAR; PG8_SCHED;
            PG8_LDB(B1, 0, 1); PG8_STAGE(PG8_SB(0, 0), b2, voffB);
            PG8_BAR; PG8_WAIT_L(0); PG8_MMA(0, 1, At, B1); PG8_BAR;
            PG8_LDA(At, 0, 1); PG8_STAGE(PG8_SA(0, 0), a2, voffA);
            PG8_BAR; PG8_WAIT_L(0); PG8_MMA(1, 0, At, B0); PG8_BAR; PG8_SCHED;
            PG8_STAGE(PG8_SB(0, 1), b2 + hstepB, voffB);
            PG8_WAIT_V(6); PG8_BAR; PG8_MMA(1, 1, At, B1); PG8_BAR;
            PG8_LDB(B0, 1, 0); PG8_SCHED; PG8_LDA(At, 1, 0); PG8_STAGE(PG8_SA(0, 1), a2 + hstepA, voffA);
            PG8_WAIT_L(8); PG8_BAR; PG8_WAIT_L(0); PG8_MMA(0, 0, At, B0); PG8_BAR; PG8_SCHED;
            PG8_LDB(B1, 1, 1); PG8_STAGE(PG8_SB(1, 0), b3, voffB);
            PG8_BAR; PG8_WAIT_L(0); PG8_MMA(0, 1, At, B1); PG8_BAR;
            PG8_LDA(At, 1, 1); PG8_STAGE(PG8_SA(1, 0), a3, voffA);
            PG8_BAR; PG8_WAIT_L(0); PG8_MMA(1, 0, At, B0); PG8_BAR; PG8_SCHED;
            PG8_STAGE(PG8_SB(1, 1), b3 + hstepB, voffB);
            PG8_WAIT_V(6); PG8_BAR; PG8_MMA(1, 1, At, B1); PG8_BAR;
            }
        }
        if constexpr (ALIGN_EPI) { if (wr == 0) PG8_BAR; }
        if constexpr (!Epi::AFTER_DRAIN) { E(acc, cur, wr, wc, fr, fq); S.done(cur); }
        if (!has_next) break;
#pragma unroll
        for (int a = 0; a < 2; ++a)
#pragma unroll
            for (int b = 0; b < 2; ++b)
#pragma unroll
                for (int m = 0; m < 4; ++m)
#pragma unroll
                    for (int n = 0; n < 2; ++n) acc[a][b][m][n] = (f32x4){0.f, 0.f, 0.f, 0.f};
        cur = nxt; cA = nA; cB = nB; ++ui;
        if constexpr (ALIGN_EPI) { if (wr == 1) PG8_BAR; }
    }
    PG8_WAIT_V(0);
    if constexpr (!ALIGN_EPI) { if (wr == 0) PG8_BAR; }
    PG8_BAR;
    if constexpr (Epi::AFTER_DRAIN) { E.fused(acc, cur, wr, wc, fr, fq, lds, wid, lane); S.done(cur); }
#undef PG8_SA
#undef PG8_SB
#undef PG8_STAGE
#undef PG8_LDA
#undef PG8_LDB
#undef PG8_MMA
#undef PG8_WAIT_V
#undef PG8_WAIT_L
#undef PG8_BAR
#undef PG8_SCHED
}
}
#define XB_TMO      128
#define XB_XCNT(j)  (256  + 64 * (j))
#define XB_XSUB(j)  (1280 + 64 * (j))
#define XB_XGEN(j)  (2304 + 64 * (j))
#define XB_TOP      3328
#define XB_TOPGEN   3392
#define XCD_BAR_WORDS 3456
#define XB_SPIN_CAP (1u << 22)

__device__ __forceinline__ unsigned xb_ld(unsigned* p)              { return __hip_atomic_load(p, __ATOMIC_RELAXED, __HIP_MEMORY_SCOPE_AGENT); }
__device__ __forceinline__ unsigned xb_add(unsigned* p, unsigned v) { return __hip_atomic_fetch_add(p, v, __ATOMIC_RELAXED, __HIP_MEMORY_SCOPE_AGENT); }
__device__ __forceinline__ unsigned xb_xcc_id() { return (unsigned)__builtin_amdgcn_s_getreg((3 << 11) | 20) & 0xFu; }
#define XB_SPIN(cond, bar) do { unsigned _sp = 0; while (cond) { __builtin_amdgcn_s_sleep(1); \
    if ((++_sp & 255u) == 0u) { if (xb_ld(&(bar)[XB_TMO])) break; if (_sp > XB_SPIN_CAP) { atomicAdd(&(bar)[XB_TMO], 1u); break; } } } } while (0)

struct XcdBarrier {
    unsigned* bar; unsigned x; unsigned wv;
    volatile LAS unsigned* st;
};

__device__ __forceinline__ XcdBarrier xcd_barrier_post(unsigned* bar, volatile LAS unsigned* st) {
    XcdBarrier b; b.bar = bar; b.x = xb_xcc_id(); b.st = st; b.wv = 0u;
    if (threadIdx.x == 0) (void)xb_add(&bar[XB_XCNT(b.x)], 1u);
    return b;
}
__device__ __forceinline__ void xcd_barrier_complete(unsigned* bar, unsigned x, unsigned& nloc, unsigned& nx) {
    const unsigned G = gridDim.x * gridDim.y * gridDim.z;
    unsigned sum, cnt, mine, sp = 0u;
    for (;;) {
        sum = 0u; cnt = 0u; mine = 0u;
#pragma unroll
        for (unsigned j = 0; j < 16; ++j) { const unsigned c = xb_ld(&bar[XB_XCNT(j)]); sum += c; cnt += (c > 0u) ? 1u : 0u; mine = (j == x) ? c : mine; }
        if (sum == G) break;
        __builtin_amdgcn_s_sleep(1);
        if ((++sp & 255u) == 0u) { if (xb_ld(&bar[XB_TMO])) break; if (sp > XB_SPIN_CAP) { atomicAdd(&bar[XB_TMO], 1u); break; } }
    }
    nloc = mine > 0u ? mine : 1u; nx = cnt > 0u ? cnt : 1u;
}

__device__ __forceinline__ void xcd_barrier(const XcdBarrier& b) {
    asm volatile("s_waitcnt vmcnt(0)" ::: "memory");
    __syncthreads();
    if (b.wv == 0u && lane_id() == 0) {
        unsigned* bar = b.bar;
        __builtin_amdgcn_s_waitcnt(0);
        unsigned nloc = b.st[0], nx = b.st[1];
        if (nloc == 0u) { xcd_barrier_complete(bar, b.x, nloc, nx); b.st[0] = nloc; b.st[1] = nx; }
        const unsigned old = xb_add(&bar[XB_XSUB(b.x)], 1u);
        const unsigned gen = old / nloc;
        if (old + 1u == (gen + 1u) * nloc) {
            __builtin_amdgcn_fence(__ATOMIC_RELEASE, "agent");
            asm volatile("s_waitcnt vmcnt(0)" ::: "memory");
            const unsigned og = xb_add(&bar[XB_TOP], 1u);
            const unsigned tg = og / nx;
            if (og + 1u == (tg + 1u) * nx) xb_add(&bar[XB_TOPGEN], 1u);
            else XB_SPIN(xb_ld(&bar[XB_TOPGEN]) == tg, bar);
            __builtin_amdgcn_fence(__ATOMIC_ACQUIRE, "agent");
            xb_add(&bar[XB_XGEN(b.x)], 1u);
            asm volatile("s_waitcnt vmcnt(0)" ::: "memory");
        } else {
            XB_SPIN(xb_ld(&bar[XB_XGEN(b.x)]) == gen, bar);
            __builtin_amdgcn_fence(__ATOMIC_ACQUIRE, "agent");
            asm volatile("s_waitcnt vmcnt(0)" ::: "memory");
        }
    }
    __syncthreads();
}

namespace pg8 {
struct EpiQRope {
    static constexpr bool PERM = true, AFTER_DRAIN = false;
    bf16_t* O; const float* cosT; const float* sinT;
    __device__ __forceinline__ void operator()(const f32x4 (&acc)[2][2][4][2], const Unit& u, int wr, int wc, int fr, int fq) const {
        const int row0 = u.pm * BM + wr * 64 + fr, colb = u.pn * BM + wc * 32 + 8 * fq;
#pragma unroll
        for (int ai = 0; ai < 2; ++ai)
#pragma unroll
            for (int m = 0; m < 4; ++m) {
                const int row = row0 + ai * HALF + m * 16; const int b = row / RPB, t = row - b * RPB - CTX;
                bf16_t* rowp = O + (size_t)row * 1536;
#pragma unroll
                for (int bj = 0; bj < 2; ++bj) {
                    const int col = colb + bj * HALF; const int hh = col / 192, jj = col - hh * 192;
                    f32x4 v0 = acc[ai][bj][m][0], v1 = acc[ai][bj][m][1];
                    if (jj >= 128 && t >= 0) {
                        const int i0 = (jj - 128) >> 1;
                        const f32x4 c4 = *(const f32x4*)(cosT + (size_t)t * 32 + i0), s4 = *(const f32x4*)(sinT + (size_t)t * 32 + i0);
                        f32x4 w0, w1;
                        w0.x = v0.x * c4.x - v0.y * s4.x; w0.y = v0.x * s4.x + v0.y * c4.x;
                        w0.z = v0.z * c4.y - v0.w * s4.y; w0.w = v0.z * s4.y + v0.w * c4.y;
                        w1.x = v1.x * c4.z - v1.y * s4.z; w1.y = v1.x * s4.z + v1.y * c4.z;
                        w1.z = v1.z * c4.w - v1.w * s4.w; w1.w = v1.z * s4.w + v1.w * c4.w;
                        v0 = w0; v1 = w1;
                    }
                    u32x4 w; w.x = cvt_pk_bf16(v0[0], v0[1]); w.y = cvt_pk_bf16(v0[2], v0[3]); w.z = cvt_pk_bf16(v1[0], v1[1]); w.w = cvt_pk_bf16(v1[2], v1[3]);
                    *(u32x4*)(rowp + col) = w;
                }
            }
    }
};
struct EpiResid {
    static constexpr bool PERM = false, AFTER_DRAIN = false;
    float* X; const float* gate;
    __device__ __forceinline__ void operator()(const f32x4 (&acc)[2][2][4][2], const Unit& u, int wr, int wc, int fr, int fq) const {
        const int row0 = u.pm * BM + wr * 64 + fr, col0 = u.pn * BM + wc * 32 + 4 * fq;
#pragma unroll
        for (int ai = 0; ai < 2; ++ai)
#pragma unroll
            for (int m = 0; m < 4; ++m) {
                const int row = row0 + ai * HALF + m * 16; const float* gp = gate + (size_t)modrow(row) * NMOD + col0; float* xp = X + (size_t)row * DM + col0;
#pragma unroll
                for (int bj = 0; bj < 2; ++bj)
#pragma unroll
                    for (int n = 0; n < 2; ++n) { const int c = bj * HALF + n * 16; const f32x4 g4 = *(const f32x4*)(gp + c); f32x4 x4 = *(const f32x4*)(xp + c); x4 += g4 * acc[ai][bj][m][n]; *(f32x4*)(xp + c) = x4; }
            }
    }
};
}

struct Args { const float* in[22]; float* out; unsigned char* ws; int ph_lo, ph_hi; };
struct Ptrs {
    LAS unsigned char* L;
    __device__ __forceinline__ unsigned long long raw(int i) const { const unsigned long long v = *(volatile LAS unsigned long long*)(L + LDS_CTL_OFF + 64 + 8 * i);
        const unsigned lo = __builtin_amdgcn_readfirstlane((unsigned)v), hi = __builtin_amdgcn_readfirstlane((unsigned)(v >> 32)); return ((unsigned long long)hi << 32) | lo; }
    __device__ __forceinline__ const float* in(int i) const { return (const float*)(GAS const float*)raw(i); }
    __device__ __forceinline__ float* out() const { return (float*)(GAS float*)raw(22); }
    __device__ __forceinline__ unsigned char* ws() const { return (unsigned char*)(GAS unsigned char*)raw(23); }
};

__device__ __forceinline__ void row_load_f32(const float* src, int lane, float (&v)[4][8]) {
#pragma unroll
    for (int i = 0; i < 4; ++i) { const f32x4 a = *(const f32x4*)(src + (lane + 64 * i) * 8), b = *(const f32x4*)(src + (lane + 64 * i) * 8 + 4);
        v[i][0] = a.x; v[i][1] = a.y; v[i][2] = a.z; v[i][3] = a.w; v[i][4] = b.x; v[i][5] = b.y; v[i][6] = b.z; v[i][7] = b.w; }
}
__device__ __forceinline__ void row_store_f32(float* dst, int lane, const float (&v)[4][8]) {
#pragma unroll
    for (int i = 0; i < 4; ++i) { *(f32x4*)(dst + (lane + 64 * i) * 8) = (f32x4){v[i][0], v[i][1], v[i][2], v[i][3]}; *(f32x4*)(dst + (lane + 64 * i) * 8 + 4) = (f32x4){v[i][4], v[i][5], v[i][6], v[i][7]}; }
}
__device__ __forceinline__ float row_rstd(const float (&v)[4][8]) {
    float ss = 0.f;
#pragma unroll
    for (int i = 0; i < 4; ++i)
#pragma unroll
        for (int j = 0; j < 8; ++j) ss += v[i][j] * v[i][j];
    ss = wave_sum(ss);
    return 1.0f / sqrtf(ss * (1.0f / DM) + EPS);
}
__device__ __forceinline__ void norm_mod_store(const float (&v)[4][8], float rstd, const float* g, const float* sh, const float* sc, bf16_t* hrow, int lane) {
#pragma unroll
    for (int i = 0; i < 4; ++i) { const int col = (lane + 64 * i) * 8; float gg[8], ss[8], cc[8];
        *(f32x4*)&gg[0] = *(const f32x4*)(g + col); *(f32x4*)&gg[4] = *(const f32x4*)(g + col + 4);
        *(f32x4*)&ss[0] = *(const f32x4*)(sh + col); *(f32x4*)&ss[4] = *(const f32x4*)(sh + col + 4);
        *(f32x4*)&cc[0] = *(const f32x4*)(sc + col); *(f32x4*)&cc[4] = *(const f32x4*)(sc + col + 4);
        float y[8];
#pragma unroll
        for (int j = 0; j < 8; ++j) y[j] = (v[i][j] * rstd * gg[j]) * (1.f + cc[j]) + ss[j];
        u32x4 o; o.x = cvt_pk(y[0], y[1]); o.y = cvt_pk(y[2], y[3]); o.z = cvt_pk(y[4], y[5]); o.w = cvt_pk(y[6], y[7]);
        *(u32x4*)(hrow + col) = o; }
}

template <class RM>
__device__ __forceinline__ void transpose_item(const float* W, int K, int N, int item, LAS float* scr, int lane, const RM& rm) {
    const int nblk = N / 32, kb = item / nblk, nb = item - kb * nblk, k0 = 64 * kb, n0 = 32 * nb;
#pragma unroll 8
    for (int i = 0; i < 32; ++i) { const int kk = 2 * i + (lane >> 5); scr[kk * 33 + (lane & 31)] = W[(size_t)(k0 + kk) * N + n0 + (lane & 31)]; }
    LDS_WAIT(); asm volatile("" ::: "memory");
    const int c = lane & 7;
#pragma unroll
    for (int j = 0; j < 4; ++j) { const int n = (lane >> 3) + 8 * j; const LAS float* s = scr + (8 * c) * 33 + n;
        u32x4 o; o.x = cvt_pk(s[0], s[33]); o.y = cvt_pk(s[66], s[99]); o.z = cvt_pk(s[132], s[165]); o.w = cvt_pk(s[198], s[231]);
        *(u32x4*)(rm(n0 + n) + k0 + 8 * c) = o; }
    LDS_WAIT(); asm volatile("" ::: "memory");
}

__device__ __forceinline__ void p0a(const Ptrs& A, LAS unsigned char* L, int wave, int bid, int G) { asm volatile("" : "+s"(wave)); const int lane = lane_id(); const int tid = wave * 64 + lane; (void)tid;
    unsigned char* ws = A.ws(); LAUNDER_G(ws);
    {
        LAS float* sl = (LAS float*)L;
        LAS float* red = (LAS float*)(L + 40960);
        for (int i = tid; i < 5 * DM; i += NTHR) { const int r = i / DM, k = i - r * DM; const float c = r < 4 ? A.in(1)[r * DM + k] : A.in(3)[k]; sl[i] = c / (1.f + expf(-c)); }
        __syncthreads();
        float* MOD = (float*)(ws + WS_MOD);
        for (int u = bid; u < DEPTH * 192; u += G) {
            const int l = u / 192, nt = u - l * 192, cg = tid & 15, kg = tid >> 4;
            const float* wp = A.in(4) + ((size_t)l * DM + kg * 64) * NMOD + nt * 64 + cg * 4;
            f32x4 acc[5];
#pragma unroll
            for (int r = 0; r < 5; ++r) acc[r] = (f32x4){0.f, 0.f, 0.f, 0.f};
#pragma unroll 8
            for (int kk = 0; kk < 64; ++kk) { const f32x4 w = *(const f32x4*)(wp + (size_t)kk * NMOD); const int k = kg * 64 + kk;
#pragma unroll
                for (int r = 0; r < 5; ++r) acc[r] += w * sl[r * DM + k]; }
#pragma unroll
            for (int r = 0; r < 5; ++r) *(LAS f32x4*)(red + (kg * 5 + r) * 64 + cg * 4) = acc[r];
            __syncthreads();
            if (tid < 320) { const int r = tid >> 6, col = tid & 63; float s = 0.f;
                for (int g = 0; g < 32; ++g) s += red[(g * 5 + r) * 64 + col];
                MOD[((size_t)l * 5 + r) * NMOD + nt * 64 + col] = s + A.in(5)[l * NMOD + nt * 64 + col]; }
            __syncthreads();
        }
    }
    {
        LAS float* scr = (LAS float*)(L + wave * 16384);
        const int gw = bid * NWAVES + wave, NGW = G * NWAVES;
        constexpr int I_IN = 32 * 123, I_UQ = 8 * 48, I_UKV = 4 * 64, I_SQ = 32 * 64, I_L = I_IN + I_UQ + I_UKV + 2 * I_SQ;
        for (int it = gw; it < DEPTH * I_L; it += NGW) {
            const int l = it / I_L; int r = it - l * I_L;
            if (r < I_IN) {
                bf16_t* mainp = (bf16_t*)(ws + WS_WIN) + (size_t)l * PW * DM; bf16_t* sidep = (bf16_t*)(ws + WS_WSIDE) + (size_t)l * SIDEW * DM;
                transpose_item(A.in(8) + (size_t)l * DM * 3936, DM, 3936, r, scr, lane, [=](int n) -> bf16_t* {
                    return n < 768 ? mainp + (size_t)n * DM : n < 832 ? sidep + (size_t)(n - 768) * DM : n < 3904 ? mainp + (size_t)(n - 64) * DM : sidep + (size_t)(64 + n - 3904) * DM; });
                continue; }
            r -= I_IN;
            if (r < I_UQ) {
                bf16_t* dst = (bf16_t*)(ws + WS_WUQ) + (size_t)l * 1536 * 512;
                transpose_item(A.in(11) + (size_t)l * 512 * 1536, 512, 1536, r, scr, lane, [=](int n) -> bf16_t* {
                    const int hh = n / 192, j = n - hh * 192; const int jn = j < 128 ? j : (j < 160 ? 128 + 2 * (j - 128) : 128 + 2 * (j - 160) + 1); return dst + (size_t)(hh * 192 + jn) * 512; });
                continue; }
            r -= I_UQ;
            if (r < I_UKV) { bf16_t* dst = (bf16_t*)(ws + WS_WUKV) + (size_t)l * 2048 * 256;
                transpose_item(A.in(12) + (size_t)l * 256 * 2048, 256, 2048, r, scr, lane, [=](int n) -> bf16_t* { return dst + (size_t)n * 256; }); continue; }
            r -= I_UKV;
            if (r < I_SQ) { bf16_t* dst = (bf16_t*)(ws + WS_WOUT) + (size_t)l * DM * DM;
                transpose_item(A.in(16) + (size_t)l * DM * DM, DM, DM, r, scr, lane, [=](int n) -> bf16_t* { return dst + (size_t)n * DM; }); continue; }
            r -= I_SQ;
            { bf16_t* dst = (bf16_t*)(ws + WS_WQRY) + (size_t)l * DM * DM;
                transpose_item(A.in(17) + (size_t)l * DM * DM, DM, DM, r, scr, lane, [=](int n) -> bf16_t* { return dst + (size_t)n * DM; }); }
        }
    }
    {
        const size_t gt = (size_t)bid * NTHR + tid, NT = (size_t)G * NTHR;
        {
            const int gw = bid * NWAVES + wave, NGW = G * NWAVES;
            for (int rr = gw; rr < 2 * DEPTH * NEXP; rr += NGW) { const bool isu = rr < DEPTH * NEXP; const int row = isu ? rr : rr - DEPTH * NEXP;
                const float* src = (isu ? A.in(19) : A.in(20)) + (size_t)row * DM;
                f32x4 x[8]; float ss = 0.f;
#pragma unroll
                for (int i = 0; i < 8; ++i) { x[i] = *(const f32x4*)(src + (lane + 64 * i) * 4); ss += (x[i].x * x[i].x + x[i].y * x[i].y) + (x[i].z * x[i].z + x[i].w * x[i].w); }
                ss = wave_sum(ss); const float rms = sqrtf(ss * (1.0f / DM));
                u32x4 p; float sc;
                if (isu) { sc = rms > 0.f ? rms * 0.5f : 1.0f; const float inv = 1.0f / sc;
#define Q4C(v) fminf(fmaxf((v) * inv, -6.0f), 6.0f)
                    LAS unsigned short* xs = (LAS unsigned short*)(L + wave * 16384);
#pragma unroll
                    for (int i = 0; i < 8; ++i) { unsigned d = 0u; d = __builtin_amdgcn_cvt_scalef32_pk_fp4_f32(d, Q4C(x[i].x), Q4C(x[i].y), 1.0f, 0); d = __builtin_amdgcn_cvt_scalef32_pk_fp4_f32(d, Q4C(x[i].z), Q4C(x[i].w), 1.0f, 1);
                        xs[lane + 64 * i] = (unsigned short)d; }
#undef Q4C
                    p = *(const LAS u32x4*)(L + wave * 16384 + lane * 16);
                } else { sc = rms > 0.f ? rms * 0.5f : 1.0f; const float inv = 1.0f / sc;
#pragma unroll
                    for (int w = 0; w < 4; ++w) { const f32x4 a = x[2 * w], c = x[2 * w + 1]; unsigned d = 0u;
#define Q4C(v) fminf(fmaxf((v) * inv, -6.0f), 6.0f)
                        d = __builtin_amdgcn_cvt_scalef32_pk_fp4_f32(d, Q4C(a.x), Q4C(a.y), 1.0f, 0); d = __builtin_amdgcn_cvt_scalef32_pk_fp4_f32(d, Q4C(a.z), Q4C(a.w), 1.0f, 1);
                        d = __builtin_amdgcn_cvt_scalef32_pk_fp4_f32(d, Q4C(c.x), Q4C(c.y), 1.0f, 2); d = __builtin_amdgcn_cvt_scalef32_pk_fp4_f32(d, Q4C(c.z), Q4C(c.w), 1.0f, 3);
#undef Q4C
                        p[w] = d; } }
                unsigned char* dst = ws + (isu ? WS_EU : WS_EV) + (size_t)row * EROW;
                *(u32x4*)(dst + lane * 16) = p;
                if (lane == 0) ((float*)(ws + (isu ? WS_SU : WS_SV)))[row] = sc; } }
        const size_t s8 = (size_t)DEPTH * 2 * 8 * 128 * 128 / 8;
        for (size_t i = gt; i < s8; i += NT) { const float* src = A.in(18) + i * 8;
            const f32x4 a = *(const f32x4*)src, b = *(const f32x4*)(src + 4); u32x4 o; o.x = cvt_pk(a.x, a.y); o.y = cvt_pk(a.z, a.w); o.z = cvt_pk(b.x, b.y); o.w = cvt_pk(b.z, b.w);
            *(u32x4*)((bf16_t*)(ws + WS_SUBK) + i * 8) = o; }
        float* cosT = (float*)(ws + WS_ROPE); float* sinT = cosT + SEQ * 32;
        for (size_t i = gt; i < (size_t)SEQ * 32; i += NT) { const int t = (int)(i >> 5), a = (int)(i & 31), m = a & 15; const int pos = a < 16 ? (t >> 6) : (t & 63);
            const float inv = 1.0f / powf(10000.0f, (float)(2 * m) / 32.0f); const float ang = (float)pos * inv; cosT[i] = cosf(ang); sinT[i] = sinf(ang); }
    }
}

__device__ __forceinline__ void p0b(const Ptrs& A, int wave, int bid, int G) { asm volatile("" : "+s"(wave)); const int lane = lane_id();
    unsigned char* ws = A.ws(); LAUNDER_G(ws); const int gw = bid + G * wave, NGW = G * NWAVES;
    const float* MOD = (const float*)(ws + WS_MOD);
    for (int r = gw; r < NTOK; r += NGW) {
        const int b = r / RPB, j = r - b * RPB; const float* src = j < CTX ? A.in(2) + ((size_t)b * CTX + j) * DM : A.in(0) + ((size_t)b * SEQ + (j - CTX)) * DM;
        float v[4][8]; row_load_f32(src, lane, v); row_store_f32((float*)(ws + WS_XRES) + (size_t)r * DM, lane, v);
        const float rstd = row_rstd(v); const float* mp = MOD + (size_t)(j < CTX ? 4 : b) * NMOD;
        norm_mod_store(v, rstd, A.in(6), mp, mp + DM, (bf16_t*)(ws + WS_H) + (size_t)r * DM, lane);
    }
}

__device__ __forceinline__ void side_gemm(const Ptrs& A, LAS unsigned char* L, int l, int wave, int bid, int G) { asm volatile("" : "+s"(wave)); const int lane = lane_id(); const int tid = wave * 64 + lane;
    unsigned char* ws = A.ws(); LAUNDER_G(ws); const bf16_t* H = (const bf16_t*)(ws + WS_H); const bf16_t* W = (const bf16_t*)(ws + WS_WSIDE) + (size_t)l * SIDEW * DM; float* SIDE = (float*)(ws + WS_SIDE);
    LAS float* red = (LAS float*)L;
    for (int u = bid; u < NTOK / 32; u += G) {
        const int rbase = u * 32;
        f32x4 acc[2][6];
#pragma unroll
        for (int rb = 0; rb < 2; ++rb)
#pragma unroll
            for (int cb = 0; cb < 6; ++cb) acc[rb][cb] = (f32x4){0.f, 0.f, 0.f, 0.f};
        const bf16_t* ap = H + (size_t)(rbase + (lane & 15)) * DM + wave * 256 + 8 * (lane >> 4);
        const bf16_t* bp = W + (size_t)(lane & 15) * DM + wave * 256 + 8 * (lane >> 4);
#pragma unroll
        for (int kh = 0; kh < 2; ++kh) {
            bf16x8 a[2][4], bq[6][4];
#pragma unroll
            for (int ks = 0; ks < 4; ++ks) {
#pragma unroll
                for (int rb = 0; rb < 2; ++rb) a[rb][ks] = *(const bf16x8*)(ap + (size_t)rb * 16 * DM + (kh * 4 + ks) * 32);
#pragma unroll
                for (int cb = 0; cb < 6; ++cb) bq[cb][ks] = *(const bf16x8*)(bp + (size_t)cb * 16 * DM + (kh * 4 + ks) * 32); }
#pragma unroll
            for (int ks = 0; ks < 4; ++ks)
#pragma unroll
                for (int rb = 0; rb < 2; ++rb)
#pragma unroll
                    for (int cb = 0; cb < 6; ++cb) acc[rb][cb] = __builtin_amdgcn_mfma_f32_16x16x32_bf16(a[rb][ks], bq[cb][ks], acc[rb][cb], 0, 0, 0);
        }
#pragma unroll
        for (int rb = 0; rb < 2; ++rb)
#pragma unroll
            for (int cb = 0; cb < 6; ++cb)
#pragma unroll
                for (int rg = 0; rg < 4; ++rg) red[(wave * 32 + rb * 16 + (lane >> 4) * 4 + rg) * 96 + cb * 16 + (lane & 15)] = acc[rb][cb][rg];
        __syncthreads();
        for (int i = tid; i < 32 * 96 / 4; i += NTHR) { f32x4 s = *(const LAS f32x4*)(red + i * 4);
#pragma unroll
            for (int w = 1; w < 8; ++w) s += *(const LAS f32x4*)(red + w * 32 * 96 + i * 4);
            *(f32x4*)(SIDE + (size_t)rbase * SIDEW + i * 4) = s; }
        __syncthreads();
    }
}

constexpr int CG_A = 0, CG_B = 16384, CG_BUF = 49152;
template <class F>
__device__ __forceinline__ void ctx_gemm(LAS unsigned char* L, const bf16_t* Ab, int lda, const bf16_t* Wt, int ldb, int N, int K, int wave, int bid, int G, const F& f) { asm volatile("" : "+s"(wave)); const int lane = lane_id(); const int tid = wave * 64 + lane;
    const int r32 = lane & 31, hi = lane >> 5, wr = wave >> 2, wc = wave & 3, ncu = N / 128, nch = K / 128;
    for (int u = bid; u < 16 * ncu; u += G) {
        const int mt = u / ncu, nt = u - mt * ncu; const int m0 = mt * 64, row0 = (m0 >> 8) * RPB + (m0 & 255), col0 = nt * 128;
        const int cch = tid & 15, ra = tid >> 4;
        const bf16_t* ga = Ab + (size_t)(row0 + ra) * lda + cch * 8; const bf16_t* gb = Wt + (size_t)(col0 + ra) * ldb + cch * 8;
        u32x4 sa[2], sb[4];
#define CG_LOAD(k0) do { sa[0] = *(const u32x4*)(ga + (k0)); sa[1] = *(const u32x4*)(ga + (size_t)32 * lda + (k0)); \
        _Pragma("unroll") for (int i = 0; i < 4; ++i) sb[i] = *(const u32x4*)(gb + (size_t)(32 * i) * ldb + (k0)); } while (0)
#define CG_WRITE(buf) do { _Pragma("unroll") for (int i = 0; i < 2; ++i) { const int row = ra + 32 * i; *(LAS u32x4*)(L + (buf) * CG_BUF + CG_A + row * 256 + ((cch ^ (row & 15)) << 4)) = sa[i]; } \
        _Pragma("unroll") for (int i = 0; i < 4; ++i) { const int row = ra + 32 * i; *(LAS u32x4*)(L + (buf) * CG_BUF + CG_B + row * 256 + ((cch ^ (row & 15)) << 4)) = sb[i]; } } while (0)
        f32x16 acc;
#pragma unroll
        for (int r = 0; r < 16; ++r) acc[r] = 0.f;
        CG_LOAD(0); CG_WRITE(0);
        __syncthreads();
#pragma unroll 1
        for (int ch = 0; ch < nch; ++ch) { const int buf = ch & 1;
            if (ch + 1 < nch) CG_LOAD((ch + 1) * 128);
#pragma unroll
            for (int ks = 0; ks < 8; ++ks) { const int cc = ks * 2 + hi;
                const bf16x8 a = *(const LAS bf16x8*)(L + buf * CG_BUF + CG_A + (32 * wr + r32) * 256 + ((cc ^ (r32 & 15)) << 4)), bq = *(const LAS bf16x8*)(L + buf * CG_BUF + CG_B + (32 * wc + r32) * 256 + ((cc ^ (r32 & 15)) << 4));
                acc = __builtin_amdgcn_mfma_f32_32x32x16_bf16(a, bq, acc, 0, 0, 0); }
            if (ch + 1 < nch) CG_WRITE(buf ^ 1);
            __syncthreads(); }
#undef CG_LOAD
#undef CG_WRITE
#pragma unroll
        for (int r = 0; r < 16; ++r) f(row0 + 32 * wr + crow(r, hi), col0 + 32 * wc + r32, acc[r]);
    }
}

__device__ __forceinline__ void thin_rows(const Ptrs& A, int l, int wave, int bid, int G) { asm volatile("" : "+s"(wave)); const int lane = lane_id();
    unsigned char* ws = A.ws(); LAUNDER_G(ws); const int nx5 = (NGU % G) * 2 < G ? NGU % G : 0;
    if (bid < nx5) return;
    const int gw = (bid - nx5) + (G - nx5) * wave, NGW = (G - nx5) * NWAVES;
    bf16_t* P = (bf16_t*)(ws + WS_P); const float* SIDE = (const float*)(ws + WS_SIDE); bf16_t* KR = (bf16_t*)(ws + WS_KR);
    const float* cosT = (const float*)(ws + WS_ROPE); const float* sinT = cosT + SEQ * 32;
    const float* gq = A.in(9) + l * 512; const float* gkv = A.in(10) + l * 256;
    for (int r = gw; r < NTOK; r += NGW) {
        bf16_t* pr = P + (size_t)r * PW;
        { const u32x4 w = *(const u32x4*)(pr + P_CQ + lane * 8); float x[8] = {bflo(w.x), bfhi(w.x), bflo(w.y), bfhi(w.y), bflo(w.z), bfhi(w.z), bflo(w.w), bfhi(w.w)};
          float ss = 0.f;
#pragma unroll
          for (int j = 0; j < 8; ++j) ss += x[j] * x[j];
          ss = wave_sum(ss); const float rstd = 1.0f / sqrtf(ss * (1.0f / 512.f) + EPS);
          const f32x4 g0 = *(const f32x4*)(gq + lane * 8), g1 = *(const f32x4*)(gq + lane * 8 + 4);
          u32x4 o; o.x = cvt_pk(x[0] * rstd * g0.x, x[1] * rstd * g0.y); o.y = cvt_pk(x[2] * rstd * g0.z, x[3] * rstd * g0.w); o.z = cvt_pk(x[4] * rstd * g1.x, x[5] * rstd * g1.y); o.w = cvt_pk(x[6] * rstd * g1.z, x[7] * rstd * g1.w);
          *(u32x4*)(pr + P_CQ + lane * 8) = o; }
        { const u32x2 w = *(const u32x2*)(pr + P_CKV + lane * 4); float x[4] = {bflo(w.x), bfhi(w.x), bflo(w.y), bfhi(w.y)};
          float ss = x[0] * x[0] + x[1] * x[1] + x[2] * x[2] + x[3] * x[3];
          ss = wave_sum(ss); const float rstd = 1.0f / sqrtf(ss * (1.0f / 256.f) + EPS);
          const f32x4 g0 = *(const f32x4*)(gkv + lane * 4);
          u32x2 o; o.x = cvt_pk(x[0] * rstd * g0.x, x[1] * rstd * g0.y); o.y = cvt_pk(x[2] * rstd * g0.z, x[3] * rstd * g0.w);
          *(u32x2*)(pr + P_CKV + lane * 4) = o; }
        if (lane < 32) { const float x1 = SIDE[(size_t)r * SIDEW + lane], x2 = SIDE[(size_t)r * SIDEW + 32 + lane];
          const int b = r / RPB, t = r - b * RPB - CTX; float y1 = x1, y2 = x2;
          if (t >= 0) { const float cs = cosT[(size_t)t * 32 + lane], sn = sinT[(size_t)t * 32 + lane]; y1 = x1 * cs - x2 * sn; y2 = x1 * sn + x2 * cs; }
          *(unsigned*)(KR + (size_t)r * 64 + 2 * lane) = cvt_pk(y1, y2); }
    }
}

constexpr int G1_LR = 0, G1_WG = 8192, G1_BG = 24576, G1_GT = 25600, G1_QD = 29696, G1_KD = G1_QD + 64 * 272, G1_KET = G1_KD + 64 * 272, G1_VT = G1_KET + 128 * 144, G1_AS = G1_VT + 256 * 144, G1_END = G1_AS + 64 * 144;
constexpr int G1_RAWV = G1_QD;
constexpr int G1_RAW = G1_END;
static_assert(G1_RAWV + 32768 <= G1_VT && G1_RAW + 32768 <= LDS_CTL_OFF, "G1 LDS map");

__device__ __forceinline__ void g1_mma(LAS unsigned char* L, f32x16& Aacc, const bf16x8 (&av)[4], bf16_t* dsp, int lane, int wave) {
    const int r32 = lane & 31, hi = lane >> 5;
    if (wave < 4) { const int mb = wave >> 1, nb = wave & 1;
#pragma unroll
        for (int r = 0; r < 16; ++r) Aacc[r] = 0.f;
#pragma unroll
        for (int ks = 0; ks < 8; ++ks) { const bf16x8 a = *(const LAS bf16x8*)(L + G1_QD + (32 * mb + r32) * 272 + ks * 32 + hi * 16), bq = *(const LAS bf16x8*)(L + G1_KD + (32 * nb + r32) * 272 + ks * 32 + hi * 16);
            Aacc = __builtin_amdgcn_mfma_f32_32x32x16_bf16(a, bq, Aacc, 0, 0, 0); } }
#pragma unroll
    for (int db = 0; db < 4; ++db) { f32x16 acc;
#pragma unroll
        for (int r = 0; r < 16; ++r) acc[r] = 0.f;
#pragma unroll
        for (int ks = 0; ks < 4; ++ks) { const bf16x8 bk = *(const LAS bf16x8*)(L + G1_KET + (32 * db + r32) * 144 + ks * 32 + hi * 16); acc = __builtin_amdgcn_mfma_f32_32x32x16_bf16(av[ks], bk, acc, 0, 0, 0); }
        LAS unsigned char* slab = L + G1_RAW + wave * 4096;
#pragma unroll
        for (int r = 0; r < 16; r += 2) {
            const float x0 = acc[r], x1 = acc[r + 1];
            const float n0 = __builtin_bit_cast(float, __builtin_amdgcn_mov_dpp(__builtin_bit_cast(int, x0), 0xB1, 0xF, 0xF, true)), n1 = __builtin_bit_cast(float, __builtin_amdgcn_mov_dpp(__builtin_bit_cast(int, x1), 0xB1, 0xF, 0xF, true));
            const bool odd = r32 & 1;
            const unsigned pk = odd ? cvt_pk_safe(n1, x1) : cvt_pk_safe(x0, n0);
            *(LAS unsigned*)(slab + crow(r + (odd ? 1 : 0), hi) * 128 + (db & 1) * 64 + (r32 >> 1) * 4) = pk; }
        if (db & 1) {
#pragma unroll
            for (int i = 0; i < 4; ++i) { const int idx = lane + 64 * i, row = idx >> 3, ch = idx & 7;
                *(u32x4*)(dsp + (size_t)(32 * wave + row) * 128 + (db >> 1) * 64 + ch * 8) = *(const LAS u32x4*)(slab + row * 128 + ch * 16); } } }
}

template <int DIR>
__device__ __forceinline__ void g1_dir(const Ptrs& A, unsigned char* ws, LAS unsigned char* L, int l, int u, int bh, int c, int h, int r0, f32x16& Aacc, const bf16x8 (&av)[4], const float (&qv)[16], const float (&kv)[16], int tid, int lane, int wave) {
    LAS float* lr = (LAS float*)(L + G1_LR); LAS float* wg = (LAS float*)(L + G1_WG); LAS float* bg = (LAS float*)(L + G1_BG); LAS float* gt = (LAS float*)(L + G1_GT);
    const int d = tid & 127, pg = tid >> 7;
    float cum[16];
    {
        float wv[16];
#pragma unroll
        for (int rr = 0; rr < 16; ++rr) wv[rr] = wg[(DIR * 16 + rr) * 128 + d];
        const float bias = bg[DIR * 128 + d];
#pragma unroll
        for (int i = 0; i < 16; ++i) { const LAS float* lp = lr + (DIR * 64 + pg * 16 + i) * 16; float z = bias;
#pragma unroll
            for (int rr = 0; rr < 16; ++rr) z += lp[rr] * wv[rr];
            cum[i] = -(fmaxf(-z, 0.f) + __logf(1.0f + __expf(-fabsf(z)))) * (1.0f / 16.0f); }
    }
    if (DIR == 0) {
#pragma unroll
        for (int i = 1; i < 16; ++i) cum[i] += cum[i - 1];
        gt[(DIR * 4 + pg) * 128 + d] = cum[15];
    } else {
#pragma unroll
        for (int i = 14; i >= 0; --i) cum[i] += cum[i + 1];
        gt[(DIR * 4 + pg) * 128 + d] = cum[0];
    }
    __syncthreads();
    float off = 0.f, last = 0.f;
#pragma unroll
    for (int g = 0; g < 4; ++g) { const float t = gt[(DIR * 4 + g) * 128 + d]; last += t; if (DIR == 0 ? (g < pg) : (g > pg)) off += t; }
    bf16_t* qdec = (bf16_t*)(ws + WS_QDEC) + ((size_t)u * 2 + DIR) * 8192;
    const float elast = __expf(last);
    unsigned ke[8];
#pragma unroll
    for (int i = 0; i < 16; i += 2) {
        const int p = pg * 16 + i;
        const float q0 = qv[i], q1 = qv[i + 1], k0 = kv[i], k1 = kv[i + 1];
        const float c0 = cum[i] + off, c1 = cum[i + 1] + off;
        const float e0 = __expf(c0), e1 = __expf(c1), n0 = __expf(-c0), n1 = __expf(-c1);
        const bf16_t qa = f2bf(q0 * e0), qb = f2bf(q1 * e1);
        *(LAS bf16_t*)(L + G1_QD + p * 272 + d * 2) = qa; *(LAS bf16_t*)(L + G1_QD + (p + 1) * 272 + d * 2) = qb;
        *(LAS bf16_t*)(L + G1_KD + p * 272 + d * 2) = f2bf(k0 * n0); *(LAS bf16_t*)(L + G1_KD + (p + 1) * 272 + d * 2) = f2bf(k1 * n1);
        ke[i >> 1] = cvt_pk(k0 * n0 * elast, k1 * n1 * elast);
    }
    *(LAS u32x4*)(L + G1_KET + d * 144 + pg * 32) = (u32x4){ke[0], ke[1], ke[2], ke[3]};
    *(LAS u32x4*)(L + G1_KET + d * 144 + pg * 32 + 16) = (u32x4){ke[4], ke[5], ke[6], ke[7]};
    if (pg == 0) ((float*)(ws + WS_DEC))[((size_t)(DIR * 16 + bh) * NCH + c) * 128 + d] = elast;
    __syncthreads();
#pragma unroll
    for (int i = 0; i < 2; ++i) { const int idx = tid + 512 * i, row = idx >> 4, ch = idx & 15;
        *(u32x4*)(qdec + row * 128 + ch * 8) = *(const LAS u32x4*)(L + G1_QD + row * 272 + ch * 16); }
    g1_mma(L, Aacc, av, (bf16_t*)(ws + WS_DS) + ((size_t)(DIR * 16 + bh) * NCH + c) * 32768, lane, wave);
}

__device__ __forceinline__ void gla_g1(const Ptrs& A, LAS unsigned char* L, int l, int u, int wave) { asm volatile("" : "+s"(wave)); const int lane = lane_id(); const int tid = wave * 64 + lane; (void)tid;
    unsigned char* ws = A.ws(); LAUNDER_G(ws);
    const int bh = u / NCH, c = u - bh * NCH, b = bh >> 2, h = bh & 3, r0 = b * RPB + c * 64;
    const bf16_t* P = (const bf16_t*)(ws + WS_P); const float* SIDE = (const float*)(ws + WS_SIDE);
    LAS float* lr = (LAS float*)(L + G1_LR); LAS float* wg = (LAS float*)(L + G1_WG); LAS float* bg = (LAS float*)(L + G1_BG);
    { const int p = tid >> 3, q = tid & 7, dir = q >> 2, rr4 = (q & 3) * 4;
      *(LAS f32x4*)(lr + (dir * 64 + p) * 16 + rr4) = *(const f32x4*)(SIDE + (size_t)(r0 + p) * SIDEW + 64 + dir * 16 + rr4); }
#pragma unroll
    for (int i = 0; i < 2; ++i) { const int idx = (tid * 2 + i) * 4, dir = idx >> 11, rr = (idx >> 7) & 15, d4 = idx & 127;
      *(LAS f32x4*)(wg + idx) = *(const f32x4*)(A.in(13) + ((size_t)(l * 2 + dir) * 16 + rr) * 512 + h * 128 + d4); }
    if (tid < 256) bg[tid] = A.in(14)[(l * 2 + (tid >> 7)) * 512 + h * 128 + (tid & 127)];
#pragma unroll
    for (int i = 0; i < 2; ++i) { const int idx = tid + 512 * i, row = idx >> 4, ch = idx & 15; const bf16_t* src = P + (size_t)(r0 + row) * PW + h * 128 + ch * 8;
        *(LAS u32x4*)(L + G1_RAW + row * 256 + ch * 16) = *(const u32x4*)(src + P_GQ); *(LAS u32x4*)(L + G1_RAW + 16384 + row * 256 + ch * 16) = *(const u32x4*)(src + P_GK); }
#pragma unroll
    for (int i = 0; i < 4; ++i) { const int idx = tid + 512 * i, row = idx >> 5, ch = idx & 31;
        *(LAS u32x4*)(L + G1_RAWV + row * 512 + ch * 16) = *(const u32x4*)(P + (size_t)(r0 + row) * PW + P_GV + h * 256 + ch * 8); }
    __syncthreads();
    float qv[16], kv[16];
#pragma unroll
    for (int i = 0; i < 16; ++i) { const int off = ((tid >> 7) * 16 + i) * 256 + (tid & 127) * 2; qv[i] = bf2f(*(const LAS bf16_t*)(L + G1_RAW + off)) * 0.08838834764831845f; kv[i] = bf2f(*(const LAS bf16_t*)(L + G1_RAW + 16384 + off)); }
    { const int e = tid & 255, ph = tid >> 8;
      unsigned w[16];
#pragma unroll
      for (int i = 0; i < 16; ++i) w[i] = (unsigned)*(const LAS bf16_t*)(L + G1_RAWV + (ph * 32 + 2 * i) * 512 + e * 2) | ((unsigned)*(const LAS bf16_t*)(L + G1_RAWV + (ph * 32 + 2 * i + 1) * 512 + e * 2) << 16);
#pragma unroll
      for (int i = 0; i < 4; ++i) *(LAS u32x4*)(L + G1_VT + e * 144 + ph * 64 + i * 16) = (u32x4){w[4 * i], w[4 * i + 1], w[4 * i + 2], w[4 * i + 3]}; }
    __syncthreads();
    const int r32 = lane & 31, hi = lane >> 5;
    bf16x8 av[4];
#pragma unroll
    for (int ks = 0; ks < 4; ++ks) av[ks] = *(const LAS bf16x8*)(L + G1_VT + (32 * wave + r32) * 144 + ks * 32 + hi * 16);
    f32x16 Af, Ab;
    g1_dir<0>(A, ws, L, l, u, bh, c, h, r0, Af, av, qv, kv, tid, lane, wave);
    __syncthreads();
    g1_dir<1>(A, ws, L, l, u, bh, c, h, r0, Ab, av, qv, kv, tid, lane, wave);
    if (wave < 4) { const int mb = wave >> 1, nb = wave & 1;
#pragma unroll
        for (int r = 0; r < 16; ++r) { const int cc = 32 * mb + crow(r, hi), jj = 32 * nb + r32; const float v = (jj <= cc ? Af[r] : 0.f) + (jj >= cc ? Ab[r] : 0.f);
            *(LAS bf16_t*)(L + G1_AS + cc * 144 + jj * 2) = f2bf(v); } }
    __syncthreads();
    float* OI = (float*)(ws + WS_OINTRA);
#pragma unroll
    for (int mb = 0; mb < 2; ++mb) { f32x16 acc;
#pragma unroll
        for (int r = 0; r < 16; ++r) acc[r] = 0.f;
#pragma unroll
        for (int ks = 0; ks < 4; ++ks) { const bf16x8 a = *(const LAS bf16x8*)(L + G1_AS + (32 * mb + r32) * 144 + ks * 32 + hi * 16); acc = __builtin_amdgcn_mfma_f32_32x32x16_bf16(a, av[ks], acc, 0, 0, 0); }
        float* op = OI + (size_t)(r0 + 32 * mb) * 1024 + h * 256 + 32 * wave + r32;
#pragma unroll
        for (int r = 0; r < 16; ++r) op[(size_t)crow(r, hi) * 1024] = acc[r]; }
    __syncthreads();
}

__device__ __forceinline__ void gla_g2(const Ptrs& A, int wave, int bid, int G) { const int tid = wave * 64 + lane_id();
    unsigned char* ws = A.ws(); LAUNDER_G(ws); const bf16_t* DS = (const bf16_t*)(ws + WS_DS); const float* DEC = (const float*)(ws + WS_DEC); bf16_t* SENT = (bf16_t*)(ws + WS_SENT);
    const int NT = G * NTHR;
    for (int it = bid * NTHR + tid; it < 2 * 16 * 256 * 16; it += NT) {
        const int d8 = it & 15, e = (it >> 4) & 255, db = it >> 12;
        const int dir = db >> 4;
        const size_t base = (size_t)db * NCH * 32768 + (size_t)e * 128 + d8 * 8, dbase = (size_t)db * NCH * 128 + d8 * 8;
        f32x4 s0 = (f32x4){0.f, 0.f, 0.f, 0.f}, s1 = (f32x4){0.f, 0.f, 0.f, 0.f};
#pragma unroll 4
        for (int st = 0; st < NCH; ++st) { const int c = dir == 0 ? st : (st < 4 ? 3 - st : NCH + 3 - st);
            const u32x4 dw = *(const u32x4*)(DS + base + (size_t)c * 32768); const f32x4 dc0 = *(const f32x4*)(DEC + dbase + (size_t)c * 128), dc1 = *(const f32x4*)(DEC + dbase + (size_t)c * 128 + 4);
            const unsigned w0 = dw.x, w1 = dw.y, w2 = dw.z, w3 = dw.w;
            const f32x4 ds0 = (f32x4){bflo(w0), bfhi(w0), bflo(w1), bfhi(w1)}, ds1 = (f32x4){bflo(w2), bfhi(w2), bflo(w3), bfhi(w3)};
            u32x4 o; o.x = cvt_pk(s0.x, s0.y); o.y = cvt_pk(s0.z, s0.w); o.z = cvt_pk(s1.x, s1.y); o.w = cvt_pk(s1.z, s1.w); *(u32x4*)(SENT + base + (size_t)c * 32768) = o;
            s0 = dc0 * s0 + ds0; s1 = dc1 * s1 + ds1; }
    }
}

constexpr int G3_A = 0, G3_OUT = 32768, G3_ROWB = 528, G3_GG = G3_OUT + 64 * G3_ROWB, G3_SSQ = G3_GG + 64 * G3_ROWB, G3_RSTD = G3_SSQ + 2048, G3_END = G3_RSTD + 256;
static_assert(G3_END <= LDS_CTL_OFF, "G3 LDS map");
__device__ __forceinline__ void gla_g3(const Ptrs& A, LAS unsigned char* L, int l, int u, int wave) { asm volatile("" : "+s"(wave)); const int lane = lane_id(); const int tid = wave * 64 + lane;
    unsigned char* ws = A.ws(); LAUNDER_G(ws);
    const int bh = u / NCH, c = u - bh * NCH, b = bh >> 2, h = bh & 3, r0 = b * RPB + c * 64, r32 = lane & 31, hi = lane >> 5;
    const bf16_t* qa = (const bf16_t*)(ws + WS_QDEC) + (size_t)u * 2 * 8192; const bf16_t* SENT = (const bf16_t*)(ws + WS_SENT);
    const bf16_t* P = (const bf16_t*)(ws + WS_P); bf16_t* MIX = (bf16_t*)(ws + WS_MIX);
#pragma unroll
    for (int i = 0; i < 4; ++i) { const int idx = tid + 512 * i, dir = idx >> 10, rem = idx & 1023, row = rem >> 4, cc = rem & 15;
        *(LAS u32x4*)(L + G3_A + dir * 16384 + row * 256 + ((cc ^ (row & 15)) << 4)) = *(const u32x4*)(qa + dir * 8192 + row * 128 + cc * 8);
        const int grow = idx >> 5, gch = idx & 31;
        *(LAS u32x4*)(L + G3_GG + grow * G3_ROWB + gch * 16) = *(const u32x4*)(P + (size_t)(r0 + grow) * PW + P_GG + h * 256 + gch * 8); }
    bf16x8 bb[16];
#pragma unroll
    for (int ks = 0; ks < 16; ++ks) { const int dir = ks >> 3, kk = (ks & 7) * 16 + 8 * hi;
        bb[ks] = *(const bf16x8*)(SENT + ((size_t)(dir * 16 + bh) * NCH + c) * 32768 + (size_t)(32 * wave + r32) * 128 + kk); }
    float v[32];
    { const float* oi = (const float*)(ws + WS_OINTRA) + (size_t)r0 * 1024 + h * 256 + 32 * wave + r32;
#pragma unroll
      for (int r = 0; r < 16; ++r) { v[r] = oi[(size_t)crow(r, hi) * 1024]; v[16 + r] = oi[(size_t)(32 + crow(r, hi)) * 1024]; } }
    __syncthreads();
    f32x16 acc0, acc1;
#pragma unroll
    for (int r = 0; r < 16; ++r) { acc0[r] = 0.f; acc1[r] = 0.f; }
#pragma unroll
    for (int ks = 0; ks < 16; ++ks) { const int dir = ks >> 3, cc = (ks & 7) * 2 + hi;
        const bf16x8 a0 = *(const LAS bf16x8*)(L + G3_A + dir * 16384 + r32 * 256 + ((cc ^ (r32 & 15)) << 4)), a1 = *(const LAS bf16x8*)(L + G3_A + dir * 16384 + (32 + r32) * 256 + ((cc ^ (r32 & 15)) << 4));
        acc0 = __builtin_amdgcn_mfma_f32_32x32x16_bf16(a0, bb[ks], acc0, 0, 0, 0); acc1 = __builtin_amdgcn_mfma_f32_32x32x16_bf16(a1, bb[ks], acc1, 0, 0, 0); }
#pragma unroll
    for (int r = 0; r < 16; ++r) { v[r] += acc0[r]; v[16 + r] += acc1[r]; }
    {
        float t[32];
#pragma unroll
        for (int q = 0; q < 32; ++q) t[q] = v[q] * v[q];
#pragma unroll
        for (int s_ = 0; s_ < 5; ++s_) { const int half = 16 >> s_; const bool bit = (r32 >> s_) & 1;
#pragma unroll
            for (int i = 0; i < half; ++i) { const float send = bit ? t[i] : t[i + half], keep = bit ? t[i + half] : t[i]; t[i] = keep + shx_f(send, 1 << s_); } }
        const int q = ((r32 & 1) << 4) | ((r32 & 2) << 2) | (r32 & 4) | ((r32 & 8) >> 2) | ((r32 & 16) >> 4);
        const int row = 32 * (q >> 4) + crow(q & 15, hi);
        ((LAS float*)(L + G3_SSQ))[row * 8 + wave] = t[0];
    }
    __syncthreads();
    if (tid < 64) { const f32x4 sa = *(const LAS f32x4*)(L + G3_SSQ + tid * 32), sb = *(const LAS f32x4*)(L + G3_SSQ + tid * 32 + 16);
        ((LAS float*)(L + G3_RSTD))[tid] = 1.0f / sqrtf(((sa.x + sa.y) + (sa.z + sa.w) + (sb.x + sb.y) + (sb.z + sb.w)) * (1.0f / 256.f) + EPS); }
    __syncthreads();
    const float g = A.in(15)[l * 256 + 32 * wave + r32];
#pragma unroll
    for (int q = 0; q < 32; ++q) { const int row = 32 * (q >> 4) + crow(q & 15, hi);
        const float rstd = ((const LAS float*)(L + G3_RSTD))[row];
        const float gg = bf2f(*(const LAS bf16_t*)(L + G3_GG + row * G3_ROWB + (32 * wave + r32) * 2));
        *(LAS bf16_t*)(L + G3_OUT + row * G3_ROWB + (32 * wave + r32) * 2) = f2bf((v[q] * rstd * g) * (gg / (1.f + __expf(-gg)))); }
    __syncthreads();
#pragma unroll
    for (int i = 0; i < 4; ++i) { const int idx = tid + 512 * i, row = idx >> 5, ch = idx & 31;
        *(u32x4*)(MIX + (size_t)(r0 + row) * DM + 1024 + h * 256 + ch * 8) = *(const LAS u32x4*)(L + G3_OUT + row * G3_ROWB + ch * 16); }
    __syncthreads();
}

#ifndef QR_REG
#define QR_REG 1
#endif
namespace att {
constexpr int NW = 8, QBLK = 32, KVBLK = 64;
constexpr float SCALE = 0.07216878364870323f;
constexpr float THR = 8.f;
constexpr int LDQ = 1536, LDKV = 2048, LDKR = 64, LDO = 2048;
constexpr int SHM_V = 16384, SHM_K = 16384, SHM_R = 8192;
constexpr int OFF_V = 0, OFF_K = 2 * SHM_V, OFF_R = OFF_K + 2 * SHM_K, OFF_WS = OFF_R + 2 * SHM_R, OFF_QR = OFF_WS + NW * 64 * 4, LDS_NEED = OFF_QR + NW * 8704;
static_assert(LDS_NEED <= LDS_CTL_OFF, "attention LDS map");
#define KSWZ(row, colB) ((row) * 256 + ((colB) ^ (((row) & 15) << 4)))
#define RSWZ(row, colB) ((row) * 128 + ((colB) ^ ((((row) >> 1) & 7) << 4)))

__device__ __forceinline__ void partialSM(f32x16& p0, f32x16& p1, float& m_reg, float& mn, float& alpha) {
  constexpr float C = SCALE * 1.4426950408889634f;
  float pmax = p0[0];
#pragma unroll
  for (int r = 1; r < 16; ++r) pmax = fmaxf(pmax, p0[r]);
#pragma unroll
  for (int r = 0; r < 16; ++r) pmax = fmaxf(pmax, p1[r]);
  { auto rr = __builtin_amdgcn_permlane32_swap(__float_as_uint(pmax), __float_as_uint(pmax), false, false);
    pmax = fmaxf(__uint_as_float(rr[0]), __uint_as_float(rr[1])); }
  if (__builtin_expect(__all(pmax - m_reg <= THR / SCALE), 1)) { mn = m_reg; alpha = 1.f; }
  else { mn = fmaxf(m_reg, pmax); alpha = __builtin_amdgcn_exp2f((m_reg - mn) * C); m_reg = mn; }
  const float mnC = -mn * C;
#pragma unroll
  for (int r = 0; r < 16; ++r) p0[r] = fmaf(p0[r], C, mnC);
#pragma unroll
  for (int r = 0; r < 16; ++r) p1[r] = fmaf(p1[r], C, mnC);
#pragma unroll
  for (int r = 0; r < 16; ++r) p0[r] = __builtin_amdgcn_exp2f(p0[r]);
}
__device__ __forceinline__ void finishSM(f32x16& p0, f32x16& p1, float alpha, float& l_reg, bf16x8& pa0, bf16x8& pa1, bf16x8& pa2, bf16x8& pa3) {
#pragma unroll
  for (int r = 0; r < 16; ++r) p1[r] = __builtin_amdgcn_exp2f(p1[r]);
  float ps = 0;
#pragma unroll
  for (int r = 0; r < 16; ++r) ps += p0[r];
#pragma unroll
  for (int r = 0; r < 16; ++r) ps += p1[r];
  { auto rr = __builtin_amdgcn_permlane32_swap(__float_as_uint(ps), __float_as_uint(ps), false, false);
    ps = __uint_as_float(rr[0]) + __uint_as_float(rr[1]); }
  l_reg = l_reg * alpha + ps;
#define PK4(P, BASE, OUT) do { unsigned a0 = cvt_pk_asm(P[BASE + 0], P[BASE + 1]), a1 = cvt_pk_asm(P[BASE + 2], P[BASE + 3]);   \
    unsigned b0 = cvt_pk_asm(P[BASE + 4], P[BASE + 5]), b1 = cvt_pk_asm(P[BASE + 6], P[BASE + 7]);                              \
    auto r0 = __builtin_amdgcn_permlane32_swap(a0, b0, false, false); auto r1 = __builtin_amdgcn_permlane32_swap(a1, b1, false, false); \
    u32x4 w = {r0[0], r1[0], r0[1], r1[1]}; OUT = __builtin_bit_cast(bf16x8, w); } while (0)
  PK4(p0, 0, pa0); PK4(p0, 8, pa1); PK4(p1, 0, pa2); PK4(p1, 8, pa3);
#undef PK4
}
__device__ __forceinline__ void qkt(f32x16& p0, f32x16& p1, const LAS unsigned char* Ks, const LAS unsigned char* Rs, const bf16x8 (&qr)[8], const bf16x8 (&qrr)[4], const LAS unsigned char* QRl, int r32, int hi) {
#pragma unroll
  for (int r = 0; r < 16; ++r) { p0[r] = 0.f; p1[r] = 0.f; }
#pragma unroll
  for (int d0 = 0; d0 < 8; ++d0) { const int cb = d0 * 32 + hi * 16;
    const bf16x8 b0 = *(const LAS bf16x8*)(Ks + KSWZ(r32, cb)), b1 = *(const LAS bf16x8*)(Ks + KSWZ(32 + r32, cb));
    p0 = __builtin_amdgcn_mfma_f32_32x32x16_bf16(b0, qr[d0], p0, 0, 0, 0);
    p1 = __builtin_amdgcn_mfma_f32_32x32x16_bf16(b1, qr[d0], p1, 0, 0, 0); }
#pragma unroll
  for (int d0 = 0; d0 < 4; ++d0) { const int cb = d0 * 32 + hi * 16;
    const bf16x8 b0 = *(const LAS bf16x8*)(Rs + RSWZ(r32, cb)), b1 = *(const LAS bf16x8*)(Rs + RSWZ(32 + r32, cb));
#if QR_REG
    const bf16x8 qq = qrr[d0];
#else
    const bf16x8 qq = *(const LAS bf16x8*)(QRl + d0 * 1024);
#endif
    p0 = __builtin_amdgcn_mfma_f32_32x32x16_bf16(b0, qq, p0, 0, 0, 0);
    p1 = __builtin_amdgcn_mfma_f32_32x32x16_bf16(b1, qq, p1, 0, 0, 0); }
}
__device__ __forceinline__ int v_st(int k, int c) { const int kk = (k & ~0xC) | ((k & 4) << 1) | ((k & 8) >> 1); return ((kk >> 3) * 4 + (c >> 5)) * 512 + ((kk & 7) * 32 + (c & 31)) * 2; }
__device__ __forceinline__ int v_rd_base(int lane) { return ((lane & 3) << 3) | (((lane >> 2) & 3) << 6) | (((lane >> 4) & 1) << 5) | (((lane >> 5) & 1) << 8); }
constexpr int v_rd_off(int d0, int ks, int half) { return d0 * 512 + ks * 4096 + half * 2048; }
template <int OFF> __device__ __forceinline__ s16x4 tr_read(int vb) {
  s16x4 r; asm volatile("ds_read_b64_tr_b16 %0, %1 offset:%2" : "=&v"(r) : "v"(vb), "i"(OFF) : "memory"); return r;
}
template <int D0> __device__ __forceinline__ void pv_one(f32x16& od, int vb, bf16x8 pa0, bf16x8 pa1, bf16x8 pa2, bf16x8 pa3) {
  const s16x4 l0 = tr_read<v_rd_off(D0, 0, 0)>(vb), h0 = tr_read<v_rd_off(D0, 0, 1)>(vb), l1 = tr_read<v_rd_off(D0, 1, 0)>(vb), h1 = tr_read<v_rd_off(D0, 1, 1)>(vb);
  const s16x4 l2 = tr_read<v_rd_off(D0, 2, 0)>(vb), h2 = tr_read<v_rd_off(D0, 2, 1)>(vb), l3 = tr_read<v_rd_off(D0, 3, 0)>(vb), h3 = tr_read<v_rd_off(D0, 3, 1)>(vb);
  asm volatile("s_waitcnt lgkmcnt(0)" ::: "memory"); SBAR();
#define PKV(L_, H_) (bf16x8){L_[0], L_[1], L_[2], L_[3], H_[0], H_[1], H_[2], H_[3]}
  od = __builtin_amdgcn_mfma_f32_32x32x16_bf16(pa0, PKV(l0, h0), od, 0, 0, 0);
  od = __builtin_amdgcn_mfma_f32_32x32x16_bf16(pa1, PKV(l1, h1), od, 0, 0, 0);
  od = __builtin_amdgcn_mfma_f32_32x32x16_bf16(pa2, PKV(l2, h2), od, 0, 0, 0);
  od = __builtin_amdgcn_mfma_f32_32x32x16_bf16(pa3, PKV(l3, h3), od, 0, 0, 0);
#undef PKV
}
__device__ __forceinline__ void pv_d0(f32x16 (&o)[4], int vb, bf16x8 pa0, bf16x8 pa1, bf16x8 pa2, bf16x8 pa3) {
  pv_one<0>(o[0], vb, pa0, pa1, pa2, pa3); pv_one<1>(o[1], vb, pa0, pa1, pa2, pa3); pv_one<2>(o[2], vb, pa0, pa1, pa2, pa3); pv_one<3>(o[3], vb, pa0, pa1, pa2, pa3);
}

__device__ __forceinline__ void attn_unit(const bf16_t* __restrict__ Qb, const bf16_t* __restrict__ Kn, const bf16_t* __restrict__ Kr, const bf16_t* __restrict__ Vh,
                                          bf16_t* __restrict__ Ob, int nkeys, LAS unsigned char* lds, int wid) {
  asm volatile("" : "+s"(wid));
  const int lane = lane_id(), tid = wid * 64 + lane, r32 = lane & 31, hi = lane >> 5;
  LAS unsigned char* V_lds = lds + OFF_V; LAS unsigned char* K_lds = lds + OFF_K; LAS unsigned char* R_lds = lds + OFF_R;
  LAS float* wsf = (LAS float*)(lds + OFF_WS) + wid * 64; LAS float* li_l = wsf; LAS float* al_l = wsf + 32;
  float m_reg = -1e30f, l_reg = 0.f; f32x16 o[4]; bf16x8 qr[8];
  LAS unsigned char* QRl = lds + OFF_QR + wid * 4096 + lane * 16;
#pragma unroll
  for (int d = 0; d < 4; ++d)
#pragma unroll
    for (int r = 0; r < 16; ++r) o[d][r] = 0.f;
  const bf16_t* Qw = Qb + (size_t)(wid * QBLK + r32) * LDQ + hi * 8;
#pragma unroll
  for (int d0 = 0; d0 < 8; ++d0) qr[d0] = *(const bf16x8*)(Qw + d0 * 16);
  bf16x8 qrr[4];
#pragma unroll
  for (int d0 = 0; d0 < 4; ++d0) { qrr[d0] = *(const bf16x8*)(Qw + (8 + d0) * 16);
#if !QR_REG
    *(LAS bf16x8*)(QRl + d0 * 1024) = qrr[d0];
#endif
  }
  const int sr = tid >> 4, sc = (tid & 15) * 8, vst0 = v_st(sr, sc), vst1 = v_st(32 + sr, sc);
  const int rr_ = tid >> 3, rc_ = (tid & 7) * 8;
  const int vb0 = (int)(unsigned)(uintptr_t)V_lds + v_rd_base(lane);
  bf16x8 vs0, vs1, ks0, ks1, rs0;
#define SLOAD(k0) do { vs0 = *(const bf16x8*)(Vh + (size_t)((k0) + sr) * LDKV + sc); vs1 = *(const bf16x8*)(Vh + (size_t)((k0) + 32 + sr) * LDKV + sc); \
    ks0 = *(const bf16x8*)(Kn + (size_t)((k0) + sr) * LDKV + sc); ks1 = *(const bf16x8*)(Kn + (size_t)((k0) + 32 + sr) * LDKV + sc); \
    rs0 = *(const bf16x8*)(Kr + (size_t)((k0) + rr_) * LDKR + rc_); } while (0)
#define SWRITE(b) do { *(LAS bf16x8*)(V_lds + (b) * SHM_V + vst0) = vs0; *(LAS bf16x8*)(V_lds + (b) * SHM_V + vst1) = vs1; const int kc = sc * 2; \
    *(LAS bf16x8*)(K_lds + (b) * SHM_K + KSWZ(sr, kc)) = ks0; *(LAS bf16x8*)(K_lds + (b) * SHM_K + KSWZ(32 + sr, kc)) = ks1; \
    *(LAS bf16x8*)(R_lds + (b) * SHM_R + RSWZ(rr_, rc_ * 2)) = rs0; } while (0)
#define SWAIT() asm volatile("s_waitcnt vmcnt(0)" ::: "memory")
#define RESC(a) do { if (__any((a) < 1.f)) { if (hi == 0) al_l[r32] = (a); asm volatile("s_waitcnt lgkmcnt(0)" ::: "memory"); \
    _Pragma("unroll") for (int d = 0; d < 4; ++d) _Pragma("unroll") for (int r = 0; r < 16; ++r) o[d][r] *= al_l[crow(r, hi)]; } } while (0)
  f32x16 pA0, pA1, pB0, pB1; float mnA, mnB, alA, alB; bf16x8 pa0, pa1, pa2, pa3; const int NT = nkeys / KVBLK;
  SLOAD(0); SWAIT(); SWRITE(0); __syncthreads();
  qkt(pA0, pA1, K_lds, R_lds, qr, qrr, QRl, r32, hi); partialSM(pA0, pA1, m_reg, mnA, alA);
  SLOAD(KVBLK);
  SWAIT(); SWRITE(1); __syncthreads();
  for (int j = 1; j + 1 < NT; j += 2) {
    SBAR(); qkt(pB0, pB1, K_lds + SHM_K, R_lds + SHM_R, qr, qrr, QRl, r32, hi);
    finishSM(pA0, pA1, alA, l_reg, pa0, pa1, pa2, pa3); SBAR();
    SLOAD((j + 1) * KVBLK); SBAR();
    pv_d0(o, vb0, pa0, pa1, pa2, pa3); partialSM(pB0, pB1, m_reg, mnB, alB);
    __syncthreads(); SWAIT(); SWRITE(0);
    RESC(alB); __syncthreads();
    SBAR(); qkt(pA0, pA1, K_lds, R_lds, qr, qrr, QRl, r32, hi);
    finishSM(pB0, pB1, alB, l_reg, pa0, pa1, pa2, pa3); SBAR();
    SLOAD((j + 2) * KVBLK); SBAR();
    pv_d0(o, vb0 + SHM_V, pa0, pa1, pa2, pa3); partialSM(pA0, pA1, m_reg, mnA, alA);
    __syncthreads(); SWAIT(); SWRITE(1);
    RESC(alA); __syncthreads();
  }
  SBAR(); qkt(pB0, pB1, K_lds + SHM_K, R_lds + SHM_R, qr, qrr, QRl, r32, hi);
  finishSM(pA0, pA1, alA, l_reg, pa0, pa1, pa2, pa3); SBAR();
  pv_d0(o, vb0, pa0, pa1, pa2, pa3); partialSM(pB0, pB1, m_reg, mnB, alB);
  __syncthreads(); RESC(alB);
  finishSM(pB0, pB1, alB, l_reg, pa0, pa1, pa2, pa3); SBAR();
  pv_d0(o, vb0 + SHM_V, pa0, pa1, pa2, pa3);
  if (hi == 0) li_l[r32] = l_reg; asm volatile("s_waitcnt lgkmcnt(0)" ::: "memory");
  float rli[16];
#pragma unroll
  for (int r = 0; r < 16; ++r) rli[r] = __builtin_amdgcn_rcpf(li_l[crow(r, hi)]);
  bf16_t* Ow = Ob + (size_t)(wid * QBLK) * LDO;
#if QR_REG
  { LAS unsigned char* slab = lds + OFF_QR + wid * 8704;
#pragma unroll
    for (int r = 0; r < 16; ++r) { const int orow = crow(r, hi);
#pragma unroll
      for (int d0 = 0; d0 < 4; ++d0) *(LAS bf16_t*)(slab + orow * 272 + (d0 * 32 + r32) * 2) = f2bf(o[d0][r] * rli[r]); }
#pragma unroll
    for (int i = 0; i < 8; ++i) { const int idx = lane + 64 * i, row = idx >> 4, ch = idx & 15;
      *(u32x4*)(Ow + (size_t)row * LDO + ch * 8) = *(const LAS u32x4*)(slab + row * 272 + ch * 16); } }
#else
#pragma unroll
  for (int r = 0; r < 16; ++r) { const int orow = crow(r, hi);
#pragma unroll
    for (int d0 = 0; d0 < 4; ++d0) Ow[(size_t)orow * LDO + d0 * 32 + r32] = f2bf(o[d0][r] * rli[r]); }
#endif
  __syncthreads();
#undef SLOAD
#undef SWRITE
#undef SWAIT
#undef RESC
}
}

constexpr int TK_S = 0, TK_SSTR = 260, TK_SBYTES = 64 * TK_SSTR * 4, TK_TV = 2 * TK_SBYTES, TK_TI = TK_TV + 64 * 2 * 16 * 4, TK_TAB = TK_TI + 64 * 2 * 16 * 4, TK_END = TK_TAB + 64 * 4;
static_assert(TK_END <= LDS_CTL_OFF, "topk LDS map");
constexpr int TK_COFF[17] = {0, 16, 24, 29, 33, 36, 38, 40, 42, 43, 44, 45, 46, 47, 48, 49, 50};
__device__ __forceinline__ unsigned f2mono(float f) { const unsigned u = __float_as_uint(f); return (u & 0x80000000u) ? ~u : (u | 0x80000000u); }
template <int N> __device__ __forceinline__ void bitonic_merge_desc(unsigned (&a)[N]) {
#pragma unroll
    for (int d = N >> 1; d > 0; d >>= 1)
#pragma unroll
        for (int i = 0; i < N; ++i) { const int p = i ^ d; if (p > i) { const unsigned lo = a[i] < a[p] ? a[i] : a[p], hi = a[i] < a[p] ? a[p] : a[i]; a[i] = hi; a[p] = lo; } }
}
template <int N> __device__ __forceinline__ void bitonic_sort_desc(unsigned (&a)[N]) {
#pragma unroll
    for (int k = 2; k <= N; k <<= 1)
#pragma unroll
        for (int d = k >> 1; d > 0; d >>= 1)
#pragma unroll
            for (int i = 0; i < N; ++i) { const int p = i ^ d; if (p > i) { const bool desc = ((i & k) == 0) || (k == N); const unsigned lo = a[i] < a[p] ? a[i] : a[p], hi = a[i] < a[p] ? a[p] : a[i]; a[i] = desc ? hi : lo; a[p] = desc ? lo : hi; } }
}
__device__ __forceinline__ void tk_scores(unsigned char* ws, LAS float* S, int l, int u, int half, int kb0, int nkb, int lane) {
    const int tile = u >> 3, h = u & 7, r0 = tile * 64, r32 = lane & 31, hi = lane >> 5;
    const bf16_t* qp = (const bf16_t*)(ws + WS_QP) + (size_t)(r0 + r32) * DM + h * 256 + half * 128 + 8 * hi;
    bf16x8 q0[8], q1[8];
#pragma unroll
    for (int ks = 0; ks < 8; ++ks) { q0[ks] = *(const bf16x8*)(qp + ks * 16); q1[ks] = *(const bf16x8*)(qp + (size_t)32 * DM + ks * 16); }
    for (int kb = kb0; kb < kb0 + nkb; ++kb) {
        const bf16_t* kp = (const bf16_t*)(ws + WS_SUBK) + ((size_t)((l * 2 + half) * 8 + h) * 128 + kb * 32 + r32) * 128 + 8 * hi;
        f32x16 a0, a1;
#pragma unroll
        for (int r = 0; r < 16; ++r) { a0[r] = 0.f; a1[r] = 0.f; }
#pragma unroll
        for (int ks = 0; ks < 8; ++ks) { const bf16x8 kk = *(const bf16x8*)(kp + ks * 16);
            a0 = __builtin_amdgcn_mfma_f32_32x32x16_bf16(q0[ks], kk, a0, 0, 0, 0); a1 = __builtin_amdgcn_mfma_f32_32x32x16_bf16(q1[ks], kk, a1, 0, 0, 0); }
#pragma unroll
        for (int r = 0; r < 16; ++r) { S[crow(r, hi) * TK_SSTR + half * 128 + kb * 32 + r32] = a0[r]; S[(32 + crow(r, hi)) * TK_SSTR + half * 128 + kb * 32 + r32] = a1[r]; }
    }
}
__device__ __forceinline__ void peer_topk_phase(const Ptrs& A, LAS unsigned char* L, int l, int wave, int bid, int G) { asm volatile("" : "+s"(wave));
    unsigned char* ws = A.ws(); LAUNDER_G(ws);
    const int NU = (NTOK / 64) * 8;
    LAS float* TV = (LAS float*)(L + TK_TV); LAS int* TI = (LAS int*)(L + TK_TI); LAS int* TAB = (LAS int*)(L + TK_TAB);
    { const int lane = lane_id(); const int tid = wave * 64 + lane;
      if (bid < NU) tk_scores(ws, (LAS float*)(L + TK_S), l, bid, wave >> 2, wave & 3, 1, lane);
      if (tid < 50) { int row = 0;
#pragma unroll
          for (int i = 1; i < 16; ++i) row = tid >= TK_COFF[i] ? i : row;
          int base = 0;
#pragma unroll
          for (int i = 1; i < 16; ++i) base = row == i ? TK_COFF[i] : base;
          TAB[tid] = row * 16 + (tid - base); } }
    __syncthreads();
    int n = 0;
    for (int u = bid; u < NU; u += G, ++n) {
        const int lane = lane_id(); const int tid = wave * 64 + lane;
        const int tile = u >> 3, h = u & 7, r0 = tile * 64;
        LAS float* S = (LAS float*)(L + TK_S + (n & 1) * TK_SBYTES);
    {
        const int item = tid >> 2, q = tid & 3, tok = item & 63, half = item >> 6;
        unsigned k0[16], k1[16];
#pragma unroll
        for (int j = 0; j < 4; ++j) { const f32x4 x = *(const LAS f32x4*)(S + tok * TK_SSTR + half * 128 + q * 32 + j * 4), y = *(const LAS f32x4*)(S + tok * TK_SSTR + half * 128 + q * 32 + 16 + j * 4);
            const int ib = 127 - (q * 32 + 4 * j);
            k0[4 * j] = (f2mono(x.x) & ~127u) | (unsigned)ib; k0[4 * j + 1] = (f2mono(x.y) & ~127u) | (unsigned)(ib - 1); k0[4 * j + 2] = (f2mono(x.z) & ~127u) | (unsigned)(ib - 2); k0[4 * j + 3] = (f2mono(x.w) & ~127u) | (unsigned)(ib - 3);
            k1[4 * j] = (f2mono(y.x) & ~127u) | (unsigned)(ib - 16); k1[4 * j + 1] = (f2mono(y.y) & ~127u) | (unsigned)(ib - 17); k1[4 * j + 2] = (f2mono(y.z) & ~127u) | (unsigned)(ib - 18); k1[4 * j + 3] = (f2mono(y.w) & ~127u) | (unsigned)(ib - 19); }
        bitonic_sort_desc<16>(k0); bitonic_sort_desc<16>(k1);
#pragma unroll
        for (int i = 0; i < 16; ++i) k0[i] = k0[i] > k1[15 - i] ? k0[i] : k1[15 - i];
        bitonic_merge_desc<16>(k0);
#pragma unroll
        for (int o = 1; o < 4; o <<= 1) {
#pragma unroll
            for (int i = 0; i < 16; ++i) k1[i] = (unsigned)shx_i((int)k0[i], o);
#pragma unroll
            for (int i = 0; i < 16; ++i) k0[i] = k0[i] > k1[15 - i] ? k0[i] : k1[15 - i];
            bitonic_merge_desc<16>(k0); }
#pragma unroll
        for (int i = 0; i < 16; ++i) if ((i >> 2) == q) { const int idx = 127 - (int)(k0[i] & 127u); TI[(tok * 2 + half) * 16 + i] = idx; TV[(tok * 2 + half) * 16 + i] = S[tok * TK_SSTR + half * 128 + idx]; }
    }
    __syncthreads();
        if (wave >= 4) { if (u + G < NU) tk_scores(ws, (LAS float*)(L + TK_S + ((n + 1) & 1) * TK_SBYTES), l, u + G, (wave - 4) >> 1, ((wave - 4) & 1) * 2, 2, lane); }
        else
    {
        const int tok = tid >> 2, q = tid & 3;
        unsigned ck[13];
#pragma unroll
        for (int sl = 0; sl < 13; ++sl) { const int n = 4 * sl + q; unsigned key = 0u;
            if (n < 50) { const int code = TAB[n]; const float sum = TV[(tok * 2) * 16 + (code >> 4)] + TV[(tok * 2 + 1) * 16 + (code & 15)]; key = (f2mono(sum) & ~63u) | (unsigned)(63 - n); }
            ck[sl] = key; }
        unsigned win[4] = {0u, 0u, 0u, 0u};
#pragma unroll
        for (int pass = 0; pass < 16; ++pass) {
            unsigned best = ck[0];
#pragma unroll
            for (int sl = 1; sl < 13; ++sl) best = ck[sl] > best ? ck[sl] : best;
#pragma unroll
            for (int o = 1; o < 4; o <<= 1) { const unsigned ob = (unsigned)shx_i((int)best, o); best = ob > best ? ob : best; }
#pragma unroll
            for (int sl = 0; sl < 13; ++sl) ck[sl] = ck[sl] == best ? 0u : ck[sl];
            if ((pass >> 2) == q) win[pass & 3] = best;
        }
        float sm[4]; int ex_idx[4];
#pragma unroll
        for (int w = 0; w < 4; ++w) { const int n = 63 - (int)(win[w] & 63u); const int code = TAB[n]; const int i = code >> 4, j = code & 15;
            sm[w] = TV[(tok * 2) * 16 + i] + TV[(tok * 2 + 1) * 16 + j]; ex_idx[w] = TI[(tok * 2) * 16 + i] * 128 + TI[(tok * 2 + 1) * 16 + j]; }
        const float mx = DPP_F(sm[0], 0x00);
        float ex[4], den = 0.f;
#pragma unroll
        for (int w = 0; w < 4; ++w) { ex[w] = __expf(sm[w] - mx); den += ex[w]; }
        den += shx_f(den, 1); den += shx_f(den, 2);
        const float inv = 1.0f / den;
        int* IDX = (int*)(ws + WS_IDX) + (size_t)(r0 + tok) * 128 + h * 16 + 4 * q; float* GATE = (float*)(ws + WS_GATE) + (size_t)(r0 + tok) * 128 + h * 16 + 4 * q;
        *(u32x4*)IDX = (u32x4){(unsigned)ex_idx[0], (unsigned)ex_idx[1], (unsigned)ex_idx[2], (unsigned)ex_idx[3]};
        *(f32x4*)GATE = (f32x4){ex[0] * inv, ex[1] * inv, ex[2] * inv, ex[3] * inv};
    }
    __syncthreads();
    }
}

__device__ __forceinline__ float gelu_tanh(float x) { const float y = 0.7978845608028654f * (x + 0.044715f * x * x * x); const float t = 1.f - 2.f * __builtin_amdgcn_rcpf(__expf(2.f * y) + 1.f); return 0.5f * x * (1.f + t); }
#ifndef PEER_NEB
#define PEER_NEB 4
#endif
#ifndef PEER_NEC
#define PEER_NEC 4
#endif
typedef int i32x4 __attribute__((ext_vector_type(4)));
typedef int i32x8 __attribute__((ext_vector_type(8)));
constexpr int PEER_H4 = 0;
static_assert(PEER_H4 + NWAVES * 4096 <= LDS_CTL_OFF, "peer LDS map");
template <int NTK>
__device__ __forceinline__ void peer_tokens(const Ptrs& A, unsigned char* ws, LAS unsigned char* HL, const int (&rows)[NTK], int l, int lane) {
    constexpr int NE = PEER_NEB / NTK, NEC = PEER_NEC / NTK;
    const unsigned char* EU = ws + WS_EU + (size_t)l * NEXP * EROW; const unsigned char* EV = ws + WS_EV + (size_t)l * NEXP * EROW;
    const float* SU = (const float*)(ws + WS_SU) + (size_t)l * NEXP; const float* SV = (const float*)(ws + WS_SV) + (size_t)l * NEXP;
    const float* MOD = (const float*)(ws + WS_MOD);
    float out[NTK][32]; unsigned k_lo[NTK], k_hi[NTK]; float g_lo[NTK], g_hi[NTK], s_lo[NTK], s_hi[NTK];
    { const int lane = lane_id();
#pragma unroll
    for (int t = 0; t < NTK; ++t) { const int r = rows[t];
        const bf16_t* hrow = (const bf16_t*)(ws + WS_H) + (size_t)r * DM;
        u32x2 hb[8]; float am = 0.f;
#pragma unroll
        for (int i = 0; i < 8; ++i) { hb[i] = *(const u32x2*)(hrow + (lane + 64 * i) * 4);
            am = fmaxf(am, fmaxf(fmaxf(fabsf(bflo(hb[i].x)), fabsf(bfhi(hb[i].x))), fmaxf(fabsf(bflo(hb[i].y)), fabsf(bfhi(hb[i].y))))); }
        am = wave_max(am);
        const float hs = am > 0.f ? am * (1.0f / 6.0f) : 1.0f, hinv = 1.0f / hs;
        LAS unsigned char* H4 = HL + t * 2048;
#pragma unroll
        for (int i = 0; i < 8; ++i) { const float y0 = bflo(hb[i].x) * hinv, y1 = bfhi(hb[i].x) * hinv, y2 = bflo(hb[i].y) * hinv, y3 = bfhi(hb[i].y) * hinv;
            unsigned c1 = 0u; c1 = __builtin_amdgcn_cvt_scalef32_pk_fp4_f32(c1, y0, y1, 1.0f, 0); c1 = __builtin_amdgcn_cvt_scalef32_pk_fp4_f32(c1, y2, y3, 1.0f, 1);
            const f32x2 d01 = __builtin_amdgcn_cvt_scalef32_pk_f32_fp4(c1, 1.0f, 0), d23 = __builtin_amdgcn_cvt_scalef32_pk_f32_fp4(c1, 1.0f, 1);
            unsigned c2 = 0u; c2 = __builtin_amdgcn_cvt_scalef32_pk_fp4_f32(c2, 4.0f * (y0 - d01.x), 4.0f * (y1 - d01.y), 1.0f, 0); c2 = __builtin_amdgcn_cvt_scalef32_pk_fp4_f32(c2, 4.0f * (y2 - d23.x), 4.0f * (y3 - d23.y), 1.0f, 1);
            *(LAS unsigned short*)(H4 + (lane + 64 * i) * 2) = (unsigned short)c1; *(LAS unsigned short*)(H4 + 1024 + (lane + 64 * i) * 2) = (unsigned short)c2; }
        const int* ip = (const int*)(ws + WS_IDX) + (size_t)r * 128; const float* gp = (const float*)(ws + WS_GATE) + (size_t)r * 128;
        const int i_lo = ip[lane], i_hi = ip[64 + lane]; g_lo[t] = gp[lane] * SV[i_lo]; g_hi[t] = gp[64 + lane] * SV[i_hi]; s_lo[t] = SU[i_lo] * hs; s_hi[t] = SU[i_hi] * hs;
        unsigned kl = ((unsigned)i_lo << 7) | (unsigned)lane, kh = ((unsigned)i_hi << 7) | (unsigned)(64 + lane);
#pragma unroll
        for (int k = 2; k <= 128; k <<= 1)
#pragma unroll
            for (int d = k >> 1; d > 0; d >>= 1) {
                if (d == 64) { const unsigned a = kl < kh ? kl : kh, c = kl < kh ? kh : kl; kl = a; kh = c; }
                else { const unsigned o0 = (unsigned)shx_i((int)kl, d), o1 = (unsigned)shx_i((int)kh, d);
                    const bool up0 = k == 128 ? true : (k == 64 ? true : ((lane & k) == 0)), up1 = k == 128 ? true : (k == 64 ? false : ((lane & k) == 0));
                    const bool lowhalf = (lane & d) == 0;
                    const unsigned mn0 = kl < o0 ? kl : o0, mx0 = kl < o0 ? o0 : kl, mn1 = kh < o1 ? kh : o1, mx1 = kh < o1 ? o1 : kh;
                    kl = (lowhalf == up0) ? mn0 : mx0; kh = (lowhalf == up1) ? mn1 : mx1; } }
        k_lo[t] = kl; k_hi[t] = kh;
#pragma unroll
        for (int jj = 0; jj < 32; ++jj) out[t][jj] = 0.f;
    }
    }
    const unsigned l16 = (unsigned)lane_id() * 16u;
    float a_lo[NTK], a_hi[NTK];
    {
        int sa_lo[NTK], sa_hi[NTK];
#pragma unroll
        for (int t = 0; t < NTK; ++t) { sa_lo[t] = 0; sa_hi[t] = 0; }
#pragma unroll 1
        for (int grp = 0; grp < 8; ++grp) {
#pragma unroll
            for (int t = 0; t < NTK; ++t) { const int ln = lane_id();
                const unsigned kreg = grp < 4 ? k_lo[t] : k_hi[t];
                const int e_m = (int)((unsigned)__builtin_amdgcn_ds_bpermute((16 * (grp & 3) + (ln & 15)) << 2, (int)kreg) >> 7);
                const unsigned char* up = EU + (size_t)e_m * EROW + (ln >> 4) * 16;
                i32x4 ua[16];
#pragma unroll
                for (int ks = 0; ks < 16; ++ks) ua[ks] = *(const i32x4*)(up + ks * 64);
                f32x4 acc = {0.f, 0.f, 0.f, 0.f};
#pragma unroll
                for (int ks = 0; ks < 16; ++ks) { if ((ks & 1) == 0) __builtin_amdgcn_sched_barrier(0);
                    const LAS unsigned char* hp = HL + t * 2048 + ks * 64 + (ln >> 4) * 16; const i32x4 b1 = *(const LAS i32x4*)hp, b2 = *(const LAS i32x4*)(hp + 1024);
                    const i32x8 Aop = {ua[ks].x, ua[ks].y, ua[ks].z, ua[ks].w, 0, 0, 0, 0}, B1 = {b1.x, b1.y, b1.z, b1.w, 0, 0, 0, 0}, B2 = {b2.x, b2.y, b2.z, b2.w, 0, 0, 0, 0};
                    acc = __builtin_amdgcn_mfma_scale_f32_16x16x128_f8f6f4(Aop, B1, acc, 4, 4, 0, 0x7F7F7F7F, 0, 0x7F7F7F7F);
                    acc = __builtin_amdgcn_mfma_scale_f32_16x16x128_f8f6f4(Aop, B2, acc, 4, 4, 0, 0x7F7F7F7F, 0, 0x7D7D7D7D); }
                __builtin_amdgcn_sched_barrier(0);
                const float af[4] = {acc[0], acc[1], acc[2], acc[3]};
#pragma unroll
                for (int m = 0; m < 16; ++m) { const int tot = __builtin_amdgcn_readlane(__builtin_bit_cast(int, af[m & 3]), 16 * (m >> 2)); const int wl = 16 * (grp & 3) + m; unsigned keep;
                    if (grp < 4) asm volatile("s_mov_b32 %1, m0\n\ts_mov_b32 m0, %3\n\tv_writelane_b32 %0, %2, m0\n\ts_mov_b32 m0, %1" : "+v"(sa_lo[t]), "=&s"(keep) : "s"(tot), "s"(wl));
                    else asm volatile("s_mov_b32 %1, m0\n\ts_mov_b32 m0, %3\n\tv_writelane_b32 %0, %2, m0\n\ts_mov_b32 m0, %1" : "+v"(sa_hi[t]), "=&s"(keep) : "s"(tot), "s"(wl)); }
            }
        }
        const int lane = lane_id();
#pragma unroll
        for (int t = 0; t < NTK; ++t) {
            const int ps_lo = (int)(k_lo[t] & 127u), ps_hi = (int)(k_hi[t] & 127u);
#define BPF(idx, v) __builtin_bit_cast(float, __builtin_amdgcn_ds_bpermute(((idx) & 63) << 2, __builtin_bit_cast(int, (v))))
            const float su_l0 = BPF(ps_lo, s_lo[t]), su_l1 = BPF(ps_lo, s_hi[t]), su_h0 = BPF(ps_hi, s_lo[t]), su_h1 = BPF(ps_hi, s_hi[t]);
            const float gt_l0 = BPF(ps_lo, g_lo[t]), gt_l1 = BPF(ps_lo, g_hi[t]), gt_h0 = BPF(ps_hi, g_lo[t]), gt_h1 = BPF(ps_hi, g_hi[t]);
#undef BPF
            const float su_l = ps_lo < 64 ? su_l0 : su_l1, su_h = ps_hi < 64 ? su_h0 : su_h1, gt_l = ps_lo < 64 ? gt_l0 : gt_l1, gt_h = ps_hi < 64 ? gt_h0 : gt_h1;
            a_lo[t] = gelu_tanh(__builtin_bit_cast(float, sa_lo[t]) * su_l) * gt_l;
            a_hi[t] = gelu_tanh(__builtin_bit_cast(float, sa_hi[t]) * su_h) * gt_h; }
        (void)lane;
    }
    {
        constexpr int NV = 4 / NTK;
        u32x4 vaA[NTK][NV], vaB[NTK][NV];
        auto vload = [&](int k0, u32x4 (&va)[NTK][NV]) {
#pragma unroll
            for (int t = 0; t < NTK; ++t)
#pragma unroll
                for (int k = 0; k < NV; ++k) { const int kk = k0 + k;
                    const int e = (int)((unsigned)__builtin_amdgcn_readlane((int)(kk < 64 ? k_lo[t] : k_hi[t]), kk & 63) >> 7);
                    va[t][k] = *(const u32x4*)((EV + (size_t)e * EROW) + l16); } };
        auto vcomp = [&](int k0, const u32x4 (&va)[NTK][NV]) {
#pragma unroll
            for (int t = 0; t < NTK; ++t)
#pragma unroll
                for (int k = 0; k < NV; ++k) { const int kk = k0 + k;
                    const float act = __builtin_bit_cast(float, __builtin_amdgcn_readlane(__builtin_bit_cast(int, kk < 64 ? a_lo[t] : a_hi[t]), kk & 63));
                    const u32x4 pa = va[t][k]; const unsigned pw[4] = {pa.x, pa.y, pa.z, pa.w};
#pragma unroll
                    for (int w = 0; w < 4; ++w) {
                        const f32x2 f0 = __builtin_amdgcn_cvt_scalef32_pk_f32_fp4(pw[w], 1.0f, 0), f1 = __builtin_amdgcn_cvt_scalef32_pk_f32_fp4(pw[w], 1.0f, 1), f2 = __builtin_amdgcn_cvt_scalef32_pk_f32_fp4(pw[w], 1.0f, 2), f3 = __builtin_amdgcn_cvt_scalef32_pk_f32_fp4(pw[w], 1.0f, 3);
                        out[t][8 * w + 0] = fmaf(act, f0.x, out[t][8 * w + 0]); out[t][8 * w + 1] = fmaf(act, f0.y, out[t][8 * w + 1]); out[t][8 * w + 2] = fmaf(act, f1.x, out[t][8 * w + 2]); out[t][8 * w + 3] = fmaf(act, f1.y, out[t][8 * w + 3]);
                        out[t][8 * w + 4] = fmaf(act, f2.x, out[t][8 * w + 4]); out[t][8 * w + 5] = fmaf(act, f2.y, out[t][8 * w + 5]); out[t][8 * w + 6] = fmaf(act, f3.x, out[t][8 * w + 6]); out[t][8 * w + 7] = fmaf(act, f3.y, out[t][8 * w + 7]); } }
            __builtin_amdgcn_sched_barrier(0); };
        vload(0, vaA);
#pragma unroll 1
        for (int k0 = 0; k0 < 128; k0 += 2 * NV) {
            vload(k0 + NV, vaB); __builtin_amdgcn_sched_barrier(0); vcomp(k0, vaA);
            if (k0 + 2 * NV < 128) vload(k0 + 2 * NV, vaA);
            __builtin_amdgcn_sched_barrier(0); vcomp(k0 + NV, vaB);
        }
    }
    const int lane_e = lane_id();
#pragma unroll
    for (int t = 0; t < NTK; ++t) { const int r = rows[t]; const int b = r / RPB, j = r - b * RPB; const bool isctx = j < CTX;
        float* xrow = (float*)(ws + WS_XRES) + (size_t)r * DM; const int mr = isctx ? 4 : b;
        const float* gf = MOD + ((size_t)l * 5 + mr) * NMOD + 5 * DM;
        float ss = 0.f;
#pragma unroll
        for (int i = 0; i < 8; ++i) { const int col = (lane_e + 64 * i) * 4; const f32x4 g4 = *(const f32x4*)(gf + col); f32x4 x4 = *(const f32x4*)(xrow + col);
            x4.x += g4.x * out[t][4 * i]; x4.y += g4.y * out[t][4 * i + 1]; x4.z += g4.z * out[t][4 * i + 2]; x4.w += g4.w * out[t][4 * i + 3];
            out[t][4 * i] = x4.x; out[t][4 * i + 1] = x4.y; out[t][4 * i + 2] = x4.z; out[t][4 * i + 3] = x4.w;
            ss += (x4.x * x4.x + x4.y * x4.y) + (x4.z * x4.z + x4.w * x4.w); }
        ss = wave_sum(ss); const float rstd = 1.0f / sqrtf(ss * (1.0f / DM) + EPS);
        if (l < DEPTH - 1) {
            const float* mp = MOD + ((size_t)(l + 1) * 5 + mr) * NMOD; const float* gn = A.in(6) + (l + 1) * DM; bf16_t* hw = (bf16_t*)(ws + WS_H) + (size_t)r * DM;
#pragma unroll
            for (int i = 0; i < 8; ++i) { const int col = (lane_e + 64 * i) * 4;
                *(f32x4*)(xrow + col) = (f32x4){out[t][4 * i], out[t][4 * i + 1], out[t][4 * i + 2], out[t][4 * i + 3]};
                const f32x4 g4 = *(const f32x4*)(gn + col), sh = *(const f32x4*)(mp + col), sc = *(const f32x4*)(mp + DM + col);
                *(u32x2*)(hw + col) = (u32x2){cvt_pk((out[t][4 * i] * rstd * g4.x) * (1.f + sc.x) + sh.x, (out[t][4 * i + 1] * rstd * g4.y) * (1.f + sc.y) + sh.y),
                                              cvt_pk((out[t][4 * i + 2] * rstd * g4.z) * (1.f + sc.z) + sh.z, (out[t][4 * i + 3] * rstd * g4.w) * (1.f + sc.w) + sh.w)}; }
        } else {
            float* orow = A.out() + ((size_t)b * SEQ + (j - CTX)) * DM; const float* fg = A.in(21);
#pragma unroll
            for (int i = 0; i < 8; ++i) { const int col = (lane_e + 64 * i) * 4; const f32x4 g4 = *(const f32x4*)(fg + col);
                *(f32x4*)(orow + col) = (f32x4){out[t][4 * i] * rstd * g4.x, out[t][4 * i + 1] * rstd * g4.y, out[t][4 * i + 2] * rstd * g4.z, out[t][4 * i + 3] * rstd * g4.w}; }
        }
    }
}
#ifndef PEER_NTK
#define PEER_NTK 2
#endif
__device__ __forceinline__ void peer_rows(const Ptrs& A, LAS unsigned char* L, unsigned xcc, int l, int wave, int bid, int G) { asm volatile("" : "+s"(wave));
    unsigned char* ws = A.ws(); LAUNDER_G(ws); const int gw = bid + G * wave, NGW = G * NWAVES;
    for (int r = gw; r < NTOK; ) {
        const int lane = lane_id();
        int rr[3] = {-1, -1, -1}; int n = 0;
#pragma unroll
        for (int t = 0; t < PEER_NTK; ++t) { while (r < NTOK && rr[t] < 0) { if (!(l == DEPTH - 1 && (r % RPB) < CTX)) { rr[t] = r; ++n; } r += NGW; } }
        if (n == 0) break;
        LAS unsigned char* HL = L + PEER_H4 + wave * 4096;
        if (n >= 2) { const int rows[2] = {rr[0], rr[1]}; peer_tokens<2>(A, ws, HL, rows, l, lane); }
        else { const int rows[1] = {rr[0]}; peer_tokens<1>(A, ws, HL, rows, l, lane); }
    }
}

__device__ __forceinline__ void norm2_rows(const Ptrs& A, int l, int wave, int bid, int G) { asm volatile("" : "+s"(wave)); const int lane = lane_id();
    unsigned char* ws = A.ws(); LAUNDER_G(ws); const int gw = bid + G * wave, NGW = G * NWAVES; const float* MOD = (const float*)(ws + WS_MOD);
    for (int r = gw; r < NTOK; r += NGW) {
        float v[4][8]; row_load_f32((const float*)(ws + WS_XRES) + (size_t)r * DM, lane, v);
        const float rstd = row_rstd(v); const float* mp = MOD + ((size_t)l * 5 + modrow(r)) * NMOD;
        norm_mod_store(v, rstd, A.in(7) + l * DM, mp + 3 * DM, mp + 4 * DM, (bf16_t*)(ws + WS_H) + (size_t)r * DM, lane);
    }
}

constexpr int PH_P0A = 0, PH_P0B = 1, PH_L0 = 2, NPL = 9, N_PHASES = PH_L0 + DEPTH * NPL;
__global__ void __launch_bounds__(NTHR, 2) mk_fwd(Args args) {
    extern __shared__ __attribute__((aligned(16))) unsigned char lds_raw[];
    LAS unsigned char* L = (LAS unsigned char*)lds_raw;
    const int wave = __builtin_amdgcn_readfirstlane(threadIdx.x >> 6), bid = blockIdx.x, G = gridDim.x;
    if (wave == 0) { const int ln = lane_id(); if (ln < 16) ((LAS unsigned*)(L + LDS_CTL_OFF))[ln] = 0u;
        if (ln == 0) { LAS unsigned long long* pt = (LAS unsigned long long*)(L + LDS_CTL_OFF + 64);
#pragma unroll
            for (int i = 0; i < 22; ++i) pt[i] = (unsigned long long)(uintptr_t)args.in[i];
            pt[22] = (unsigned long long)(uintptr_t)args.out; pt[23] = (unsigned long long)(uintptr_t)args.ws; } }
    __syncthreads();
    const Ptrs PT{L};
    unsigned* ctl = (unsigned*)(PT.ws() + WS_CTL);
    XcdBarrier bar; bar.bar = ctl + CW_BAR; bar.x = 0; bar.st = nullptr; bar.wv = (unsigned)wave;
#if !MK_MULTI
    bar = xcd_barrier_post(ctl + CW_BAR, (volatile LAS unsigned*)(L + LDS_CTL_OFF) + 8);
    bar.wv = (unsigned)wave;
#endif
    const int lo = args.ph_lo, hi = args.ph_hi;
#ifndef PH_MASK
#define PH_MASK 0x7ff
#endif
#define PHSEL(n) (((PH_MASK) >> (n)) & 1)
#define IN(k) (lo <= (k) && (k) < hi)
#if MK_MULTI
#define SEAM(k) do { } while (0)
#else
#define SEAM(k) do { if (IN(k) && IN((k) + 1)) xcd_barrier(bar); } while (0)
#endif
    if (PHSEL(0) && IN(PH_P0A)) p0a(PT, L, wave, bid, G);
    SEAM(PH_P0A);
    if (PHSEL(1) && IN(PH_P0B)) p0b(PT, wave, bid, G);
    SEAM(PH_P0B);
    for (int l = 0; l < DEPTH; ++l) {
        const int pb = PH_L0 + l * NPL;
        if (PHSEL(2) && IN(pb + 0)) {
            unsigned char* ws = PT.ws(); LAUNDER_G(ws);
            pg8::Gemm g{(const bf16_t*)(ws + WS_H), (const bf16_t*)(ws + WS_WIN) + (size_t)l * PW * DM, NTOK, PW, DM, DM, DM};
            pg8::StaticOrder S; S.init(NTOK, PW, G, bid);
            pg8::EpiBf16<0> E{(bf16_t*)(ws + WS_P), PW, nullptr, 0, 0, 1.f};
#ifndef DBL_GIN
#define DBL_GIN 1
#endif
            for (int rep = 0; rep < DBL_GIN; ++rep)
            pg8::gemm_phase<pg8::EpiBf16<0>, pg8::StaticOrder, true, true>(L, g, S, E, wave);
#ifndef DBL_SIDE
#define DBL_SIDE 1
#endif
            for (int rep = 0; rep < DBL_SIDE; ++rep)
            side_gemm(PT, L, l, wave, bid, G);
        }
        SEAM(pb + 0);
        if (PHSEL(3) && IN(pb + 1)) {
            unsigned char* ws = PT.ws(); LAUNDER_G(ws);
#ifndef NO_THIN
            thin_rows(PT, l, wave, bid, G);
#endif
#ifndef NO_G1
#ifndef DBL_GLA
#define DBL_GLA 1
#endif
#ifndef DBL_G1
#define DBL_G1 DBL_GLA
#endif
            for (int rep = 0; rep < DBL_G1; ++rep)
            for (int u = bid; u < NGU; u += G) gla_g1(PT, L, l, u, wave);
#endif
        }
        SEAM(pb + 1);
        if (PHSEL(4) && IN(pb + 2)) {
            unsigned char* ws = PT.ws(); LAUNDER_G(ws);
#ifndef NO_UQ
            { pg8::Gemm g{(const bf16_t*)(ws + WS_P) + P_CQ, (const bf16_t*)(ws + WS_WUQ) + (size_t)l * 1536 * 512, NTOK, 1536, 512, PW, 512};
              pg8::StaticOrder S; S.init(NTOK, 1536, G, bid);
              pg8::EpiQRope E{(bf16_t*)(ws + WS_Q), (const float*)(ws + WS_ROPE), (const float*)(ws + WS_ROPE) + SEQ * 32};
              pg8::gemm_phase<pg8::EpiQRope, pg8::StaticOrder, true, true>(L, g, S, E, wave); }
#endif
#ifndef NO_UKV
            { pg8::Gemm g{(const bf16_t*)(ws + WS_P) + P_CKV, (const bf16_t*)(ws + WS_WUKV) + (size_t)l * 2048 * 256, NTOK, 2048, 256, PW, 256};
              pg8::LatentOrder S; S.init(2048, G, bid);
              pg8::EpiBf16<0> E{(bf16_t*)(ws + WS_KV), 2048, nullptr, 0, 0, 1.f};
              pg8::gemm_phase<pg8::EpiBf16<0>, pg8::LatentOrder, true, true>(L, g, S, E, wave);
              bf16_t* KVo = (bf16_t*)(ws + WS_KV);
              ctx_gemm(L, (const bf16_t*)(ws + WS_P) + P_CKV, PW, (const bf16_t*)(ws + WS_WUKV) + (size_t)l * 2048 * 256, 256, 2048, 256, wave, bid, G, [=](int row, int col, float v) { KVo[(size_t)row * 2048 + col] = f2bf_safe(v); }); }
#endif
#ifndef NO_G2
#ifndef DBL_G2
#define DBL_G2 DBL_GLA
#endif
            for (int rep = 0; rep < DBL_G2; ++rep) gla_g2(PT, wave, bid, G);
#endif
        }
        SEAM(pb + 2);
        if (PHSEL(5) && IN(pb + 3)) {
            unsigned char* ws = PT.ws(); LAUNDER_G(ws);
            const bf16_t* Q = (const bf16_t*)(ws + WS_Q); const bf16_t* KV = (const bf16_t*)(ws + WS_KV); const bf16_t* KR = (const bf16_t*)(ws + WS_KR); bf16_t* MIX = (bf16_t*)(ws + WS_MIX);
            const int nau = NB * 8 * 16 + (l < DEPTH - 1 ? NB * 8 : 0);
#ifndef DBL_ATT
#define DBL_ATT 1
#endif
#ifndef DBL_G3
#define DBL_G3 DBL_GLA
#endif
            const bool g3first = ((bid >> 3) & 1) != 0;
            for (int step = 0; step < 2; ++step) {
                if ((step == 0) == g3first) {
            for (int rep = 0; rep < DBL_G3; ++rep)
            for (int u = G - 1 - bid; u < NGU; u += G) gla_g3(PT, L, l, u, wave);
                } else {
            for (int rep = 0; rep < DBL_ATT; ++rep)
            for (int u = bid; u < nau; u += G) {
                int b, h, q0, nk;
                if (u < NB * 8 * 16) {
                    int uu = u; if ((G & 7) == 0 && G * 2 == NB * 8 * 16) { const int xcd = bid & 7, idx = (bid >> 3) + (G >> 3) * (u / G); uu = (4 * xcd + (idx >> 4)) * 16 + (idx & 15); }
                    b = uu >> 7; h = (uu >> 4) & 7; q0 = b * RPB + CTX + (uu & 15) * 256; nk = RPB; }
                else { const int v = u - NB * 8 * 16; b = v >> 3; h = v & 7; q0 = b * RPB; nk = CTX; }
                att::attn_unit(Q + (size_t)q0 * 1536 + h * 192, KV + (size_t)b * RPB * 2048 + h * 256, KR + (size_t)b * RPB * 64, KV + (size_t)b * RPB * 2048 + h * 256 + 128,
                               MIX + (size_t)q0 * DM + h * 128, nk, L, wave);
            }
                }
            }
        }
        SEAM(pb + 3);
        if (PHSEL(6) && IN(pb + 4)) {
            unsigned char* ws = PT.ws(); LAUNDER_G(ws);
            pg8::Gemm g{(const bf16_t*)(ws + WS_MIX), (const bf16_t*)(ws + WS_WOUT) + (size_t)l * DM * DM, NTOK, DM, DM, DM, DM};
            pg8::LatentOrder S; S.init(DM, G, bid);
            pg8::EpiResid E{(float*)(ws + WS_XRES), (const float*)(ws + WS_MOD) + (size_t)l * 5 * NMOD + 2 * DM};
            const bool cfirst = ((bid >> 3) & 1) != 0 && (l < DEPTH - 1);
            float* X = (float*)(ws + WS_XRES); const float* gate = (const float*)(ws + WS_MOD) + ((size_t)l * 5 + 4) * NMOD + 2 * DM;
            for (int step = 0; step < 2; ++step) {
                if ((step == 0) != cfirst) pg8::gemm_phase<pg8::EpiResid, pg8::LatentOrder, true, true>(L, g, S, E, wave);
                else if (l < DEPTH - 1) {
                ctx_gemm(L, (const bf16_t*)(ws + WS_MIX), DM, (const bf16_t*)(ws + WS_WOUT) + (size_t)l * DM * DM, DM, DM, DM, wave, bid, G, [=](int row, int col, float v) { X[(size_t)row * DM + col] += gate[col] * v; });
                }
            }
        }
        SEAM(pb + 4);
        if (PHSEL(7) && IN(pb + 5)) norm2_rows(PT, l, wave, bid, G);
        SEAM(pb + 5);
        if (PHSEL(8) && IN(pb + 6)) {
            unsigned char* ws = PT.ws(); LAUNDER_G(ws);
            pg8::Gemm g{(const bf16_t*)(ws + WS_H), (const bf16_t*)(ws + WS_WQRY) + (size_t)l * DM * DM, NTOK, DM, DM, DM, DM};
            pg8::LatentOrder S; S.init(DM, G, bid);
            pg8::EpiBf16<0> E{(bf16_t*)(ws + WS_QP), DM, nullptr, 0, 0, 1.f};
            pg8::gemm_phase<pg8::EpiBf16<0>, pg8::LatentOrder, true, true>(L, g, S, E, wave);
            if (l < DEPTH - 1) { bf16_t* QPo = (bf16_t*)(ws + WS_QP);
                ctx_gemm(L, (const bf16_t*)(ws + WS_H), DM, (const bf16_t*)(ws + WS_WQRY) + (size_t)l * DM * DM, DM, DM, DM, wave, bid, G, [=](int row, int col, float v) { QPo[(size_t)row * DM + col] = f2bf_safe(v); }); }
        }
        SEAM(pb + 6);
#ifndef DBL_TOPK
#define DBL_TOPK 1
#endif
        if (PHSEL(9) && IN(pb + 7)) { for (int rep = 0; rep < DBL_TOPK; ++rep) { peer_topk_phase(PT, L, l, wave, bid, G); __syncthreads(); } }
        SEAM(pb + 7);
        if (PHSEL(10) && IN(pb + 8)) peer_rows(PT, L, bar.x, l, wave, bid, G);
        SEAM(pb + 8);
    }
}

extern "C" void kernel_launch(void* const* d_in, const int* in_sizes, int n_in, void* d_out, int out_size, void* d_ws, size_t ws_size, hipStream_t stream) {
    static int grid = 0;
    if (grid == 0) {
        if (n_in != 22 || out_size != NB * SEQ * DM || ws_size < WS_END) { fprintf(stderr, "kernel_launch: unexpected shapes: n_in %d out %d ws %zu (need %zu)\n", n_in, out_size, ws_size, (size_t)WS_END); grid = -1; return; }
        int dev = 0, cus = 0, per_cu = 0;
        if (hipGetDevice(&dev) != hipSuccess || hipDeviceGetAttribute(&cus, hipDeviceAttributeMultiprocessorCount, dev) != hipSuccess) { grid = -1; return; }
        if (hipFuncSetAttribute((const void*)mk_fwd, hipFuncAttributeMaxDynamicSharedMemorySize, LDS_BYTES) != hipSuccess) { fprintf(stderr, "kernel_launch: hipFuncSetAttribute failed\n"); grid = -1; return; }
        if (hipOccupancyMaxActiveBlocksPerMultiprocessor(&per_cu, mk_fwd, NTHR, LDS_BYTES) != hipSuccess || per_cu < 1) { fprintf(stderr, "kernel_launch: occupancy query says %d\n", per_cu); grid = -1; return; }
        grid = cus;
    }
    if (grid < 0) return;
    (void)hipMemsetAsync((char*)d_ws + WS_CTL, 0, CTL_BYTES, stream);
    Args a{};
    for (int i = 0; i < 22; ++i) a.in[i] = (const float*)d_in[i];
    a.out = (float*)d_out; a.ws = (unsigned char*)d_ws;
#if MK_MULTI
    for (int p = 0; p < N_PHASES; ++p) { a.ph_lo = p; a.ph_hi = p + 1; hipLaunchKernelGGL(mk_fwd, dim3(grid), dim3(NTHR), LDS_BYTES, stream, a); }
#else
    a.ph_lo = 0; a.ph_hi = N_PHASES;
    hipLaunchKernelGGL(mk_fwd, dim3(grid), dim3(NTHR), LDS_BYTES, stream, a);
#endif
    const hipError_t le = hipPeekAtLastError();
    if (le != hipSuccess) fprintf(stderr, "kernel_launch: launch failed: %s\n", hipGetErrorName(le));
}
```
